# Optimizing an MI355X kernel written in HIP

```python
import math
import jax, jax.numpy as jnp
from jax import lax
import numpy as np

D_MODEL = 2048
BATCH = 4
SEQ = 4096
DEPTH = 4

N_MIXERS = 4
MEM_LEN = 256
RMS_EPS = 1e-6
NEG = -1e30
BIG = 1e30

SSD_EXPAND = 2
SSD_D_INNER = SSD_EXPAND * D_MODEL
SSD_HEAD_DIM = 64
SSD_N_HEADS = SSD_D_INNER // SSD_HEAD_DIM
SSD_N_GROUPS = 8
SSD_HPG = SSD_N_HEADS // SSD_N_GROUPS
SSD_D_STATE = 128
SSD_CONV = 4
SSD_CHUNK = 128
SSD_CONV_DIM = SSD_D_INNER + 2 * SSD_N_GROUPS * SSD_D_STATE
SSD_IN_DIM = SSD_D_INNER + SSD_CONV_DIM + SSD_N_HEADS

NSA_HEAD_DIM = 128
NSA_N_HEADS = D_MODEL // NSA_HEAD_DIM
NSA_KV_GROUPS = 4
NSA_HPG = NSA_N_HEADS // NSA_KV_GROUPS
NSA_KV_DIM = NSA_KV_GROUPS * NSA_HEAD_DIM
NSA_CMP_BLOCK = 32
NSA_CMP_STRIDE = 16
NSA_CMP_HIDDEN = 256
NSA_SLC_BLOCK = 64
NSA_TOPK = 16
NSA_N_LOCAL = 2
NSA_WINDOW = 512
NSA_Q_BLOCK = 64
NSA_WIN_Q_BLOCK = 128
NSA_IN_DIM = NSA_N_HEADS * NSA_HEAD_DIM + 6 * NSA_KV_DIM + 3 * NSA_N_HEADS

SGU_CHUNK = 128
SGU_WIDTH = 2 * D_MODEL
SGU_GROUPS = 8
SGU_GROUP_DIM = SGU_WIDTH // SGU_GROUPS

POOL_WINDOWS = (2, 4, 8, 16)
POOL_GROUPS = len(POOL_WINDOWS)
POOL_GROUP_DIM = D_MODEL // POOL_GROUPS

XA_HEADS = 4
XA_HEAD_DIM = 128
XA_DIM = XA_HEADS * XA_HEAD_DIM

FFN_HIDDEN = 5632
FFN_CONV = 3

kernel_name = "hybrid_interleaved_ssd_nsa_sgu_pool_decoder"


def _rmsnorm(x, g):
    xf = x.astype(jnp.float32)
    y = xf * lax.rsqrt(jnp.mean(xf * xf, axis=-1, keepdims=True) + RMS_EPS)
    return (y * g.astype(jnp.float32)).astype(x.dtype)


def _layernorm(x, g):
    xf = x.astype(jnp.float32)
    mu = jnp.mean(xf, axis=-1, keepdims=True)
    xc = xf - mu
    y = xc * lax.rsqrt(jnp.mean(xc * xc, axis=-1, keepdims=True) + RMS_EPS)
    return (y * g.astype(jnp.float32)).astype(x.dtype)


def _causal_dwconv(x, w, b):
    k_w, L = w.shape[0], x.shape[1]
    xp = jnp.pad(x, ((0, 0), (k_w - 1, 0), (0, 0)))
    y = b + xp[:, 0:L] * w[0]
    for k in range(1, k_w):
        y = y + xp[:, k:k + L] * w[k]
    return y


def _ssd_mixer(h, w_in, conv_w, conv_b, dt_bias, a_log, d_skip, norm_g, w_out):
    f32 = jnp.float32
    bsz, L, _ = h.shape
    G, J, P, N, Q = SSD_N_GROUPS, SSD_HPG, SSD_HEAD_DIM, SSD_D_STATE, SSD_CHUNK
    nc = L // Q
    proj = h @ w_in
    z, xbc, dt = jnp.split(proj, [SSD_D_INNER, SSD_D_INNER + SSD_CONV_DIM], axis=-1)
    xbc = jax.nn.silu(_causal_dwconv(xbc, conv_w, conv_b)).astype(f32)
    xs, bm, cm = jnp.split(xbc, [SSD_D_INNER, SSD_D_INNER + G * N], axis=-1)
    xs = xs.reshape(bsz, nc, Q, G, J, P)
    bm = bm.reshape(bsz, nc, Q, G, N)
    cm = cm.reshape(bsz, nc, Q, G, N)
    dt = jax.nn.softplus(dt.astype(f32) + dt_bias.astype(f32)).reshape(bsz, nc, Q, G, J)
    a = dt * (-jnp.exp(a_log.astype(f32))).reshape(G, J)
    a_cs = jnp.cumsum(a.transpose(0, 3, 4, 1, 2), axis=-1)
    xdt = xs * dt[..., None]
    causal = jnp.tril(jnp.ones((Q, Q), dtype=bool))
    decay = jnp.exp(jnp.where(causal, a_cs[..., :, None] - a_cs[..., None, :], -jnp.inf))
    cb = jnp.einsum('bclgn,bcsgn->bgcls', cm, bm)
    y_diag = jnp.einsum('bgjcls,bcsgjp->bclgjp', cb[:, :, None] * decay, xdt)
    decay_to_end = jnp.exp(a_cs[..., -1:] - a_cs)
    states = jnp.einsum('bcsgn,bgjcs,bcsgjp->bcgjpn', bm, decay_to_end, xdt)
    chunk_decay = jnp.exp(a_cs[..., -1])

    def step(carry, inp):
        st, dec = inp
        return carry * dec[..., None, None] + st, carry

    init = jnp.zeros((bsz, G, J, P, N), f32)
    _, prev = lax.scan(step, init, (jnp.moveaxis(states, 1, 0), jnp.moveaxis(chunk_decay, 3, 0)))
    y_off = jnp.einsum('bclgn,cbgjpn,bgjcl->bclgjp', cm, prev, jnp.exp(a_cs))
    y = y_diag + y_off + xs * d_skip.astype(f32).reshape(G, J)[:, :, None]
    y = y.reshape(bsz, L, SSD_D_INNER)
    y = _rmsnorm(y * jax.nn.silu(z.astype(f32)), norm_g)
    return y.astype(h.dtype) @ w_out


def _nsa_mixer(h, w_in, cmp_pos, cmp_w1, cmp_w2, w_out):
    f32 = jnp.float32
    bsz, L, _ = h.shape
    G, J, Dh = NSA_KV_GROUPS, NSA_HPG, NSA_HEAD_DIM
    scale = Dh ** -0.5
    proj = h @ w_in
    offs = np.cumsum([NSA_N_HEADS * Dh] + [NSA_KV_DIM] * 6).tolist()
    q, kc_in, vc_in, ks, vs, kw, vw, gate_logits = jnp.split(proj, offs, axis=-1)
    q = q.reshape(bsz, L, G, J, Dh)
    kc_in, vc_in, ks, vs, kw, vw = [t.reshape(bsz, L, G, Dh) for t in (kc_in, vc_in, ks, vs, kw, vw)]
    gates = jax.nn.sigmoid(gate_logits.astype(f32)).reshape(bsz, L, G, J, 3).astype(h.dtype)
    t_pos = jnp.arange(L)

    ncmp = (L - NSA_CMP_BLOCK) // NSA_CMP_STRIDE + 1
    cmp_idx = np.arange(ncmp)[:, None] * NSA_CMP_STRIDE + np.arange(NSA_CMP_BLOCK)[None, :]

    def compress(t, pos, w1, w2):
        blk = t[:, cmp_idx] + pos[None, None, :, None, :]
        flat = blk.transpose(0, 1, 3, 2, 4).reshape(bsz, ncmp, G, NSA_CMP_BLOCK * Dh)
        return jax.nn.gelu(flat @ w1) @ w2

    kc = compress(kc_in, cmp_pos[0], cmp_w1[0], cmp_w2[0])
    vc = compress(vc_in, cmp_pos[1], cmp_w1[1], cmp_w2[1])
    s_c = jnp.einsum('btgjd,bigd->bgjti', q, kc).astype(f32) * scale
    cmp_end = jnp.arange(ncmp) * NSA_CMP_STRIDE + NSA_CMP_BLOCK - 1
    valid_c = cmp_end[None, :] <= t_pos[:, None]
    p_c = jnp.where(valid_c, jax.nn.softmax(jnp.where(valid_c, s_c, NEG), axis=-1), 0.0)
    o_cmp = jnp.einsum('bgjti,bigd->btgjd', p_c.astype(vc.dtype), vc)

    nslc = L // NSA_SLC_BLOCK
    ci = np.arange(ncmp)[:, None] * NSA_CMP_STRIDE
    sj = np.arange(nslc)[None, :] * NSA_SLC_BLOCK
    cover = jnp.asarray(((ci <= sj + NSA_SLC_BLOCK - 1) & (ci + NSA_CMP_BLOCK - 1 >= sj)).astype(np.float32))
    imp = jnp.einsum('bgjti,ik->bgtk', p_c, cover)
    blk = jnp.arange(nslc)[None, :]
    cur = (t_pos // NSA_SLC_BLOCK)[:, None]
    forced = (blk == 0) | ((blk <= cur) & (blk > cur - 1 - NSA_N_LOCAL))
    future = blk * NSA_SLC_BLOCK > t_pos[:, None]
    sel_score = jnp.where(forced, BIG, jnp.where(future, NEG, imp))
    topk = min(NSA_TOPK, nslc)
    _, sel_idx = lax.top_k(sel_score, topk)

    ks_blk = ks.reshape(bsz, nslc, NSA_SLC_BLOCK, G, Dh).transpose(0, 3, 1, 2, 4)
    vs_blk = vs.reshape(bsz, nslc, NSA_SLC_BLOCK, G, Dh).transpose(0, 3, 1, 2, 4)
    nqb = L // NSA_Q_BLOCK
    q_blocks = q.reshape(bsz, nqb, NSA_Q_BLOCK, G, J, Dh).transpose(1, 0, 2, 3, 4, 5)
    idx_blocks = sel_idx.reshape(bsz, G, nqb, NSA_Q_BLOCK, topk).transpose(2, 0, 1, 3, 4)
    starts = jnp.arange(nqb, dtype=jnp.int32) * NSA_Q_BLOCK
    b_i = jnp.arange(bsz)[:, None, None, None]
    g_i = jnp.arange(G)[None, :, None, None]
    in_blk = jnp.arange(NSA_SLC_BLOCK)

    def sel_block(args):
        qb, ib, t0 = args
        kg = ks_blk[b_i, g_i, ib]
        vg = vs_blk[b_i, g_i, ib]
        s = jnp.einsum('bqgjd,bgqksd->bgjqks', qb, kg).astype(f32) * scale
        pos = ib[..., None] * NSA_SLC_BLOCK + in_blk
        tq = t0 + jnp.arange(NSA_Q_BLOCK)
        valid = (pos <= tq[None, None, :, None, None])[:, :, None]
        p = jax.nn.softmax(jnp.where(valid, s, NEG), axis=(-2, -1))
        return jnp.einsum('bgjqks,bgqksd->bqgjd', p.astype(vg.dtype), vg)

    o_slc = lax.map(sel_block, (q_blocks, idx_blocks, starts))
    o_slc = o_slc.transpose(1, 0, 2, 3, 4, 5).reshape(bsz, L, G, J, Dh)

    WB = NSA_WIN_Q_BLOCK
    nb = L // WB
    nslab = NSA_WINDOW // WB + 1
    slab_len = nslab * WB
    slab_idx = np.arange(nb)[:, None] + np.arange(nslab)[None, :]
    kp = jnp.pad(kw, ((0, 0), (NSA_WINDOW, 0), (0, 0), (0, 0))).reshape(bsz, nb + nslab - 1, WB, G, Dh)
    vp = jnp.pad(vw, ((0, 0), (NSA_WINDOW, 0), (0, 0), (0, 0))).reshape(bsz, nb + nslab - 1, WB, G, Dh)
    k_slab = kp[:, slab_idx].reshape(bsz, nb, slab_len, G, Dh)
    v_slab = vp[:, slab_idx].reshape(bsz, nb, slab_len, G, Dh)
    qw = q.reshape(bsz, nb, WB, G, J, Dh)
    s_w = jnp.einsum('bnqgjd,bnkgd->bgjnqk', qw, k_slab).astype(f32) * scale
    spos = jnp.arange(nb)[:, None] * WB - NSA_WINDOW + jnp.arange(slab_len)[None, :]
    tpos = jnp.arange(nb)[:, None] * WB + jnp.arange(WB)[None, :]
    diff = tpos[:, :, None] - spos[:, None, :]
    valid_w = (spos[:, None, :] >= 0) & (diff >= 0) & (diff < NSA_WINDOW)
    p_w = jax.nn.softmax(jnp.where(valid_w, s_w, NEG), axis=-1)
    o_win = jnp.einsum('bgjnqk,bnkgd->bnqgjd', p_w.astype(v_slab.dtype), v_slab).reshape(bsz, L, G, J, Dh)

    o = gates[..., 0:1] * o_cmp + gates[..., 1:2] * o_slc + gates[..., 2:3] * o_win
    return o.reshape(bsz, L, NSA_N_HEADS * Dh) @ w_out


def _sgu_mixer(h, w_in, b_in, ln_g, w_spatial, b_spatial, w_out):
    bsz, L, _ = h.shape
    nc = L // SGU_CHUNK
    proj = jax.nn.gelu(h @ w_in + b_in)
    u, v = jnp.split(proj, 2, axis=-1)
    v = _layernorm(v, ln_g).reshape(bsz, nc, SGU_CHUNK, SGU_GROUPS, SGU_GROUP_DIM)
    tri = jnp.tril(jnp.ones((SGU_CHUNK, SGU_CHUNK), dtype=bool))
    w_m = jnp.where(tri[None], w_spatial, 0.0).astype(v.dtype)
    sv = jnp.einsum('gts,bcsgd->bctgd', w_m, v) + b_spatial.T[:, :, None]
    return (u * sv.reshape(bsz, L, SGU_WIDTH)) @ w_out


def _pool_mixer(h, w_in, w_group, scale, w_out):
    bsz, L, _ = h.shape
    z = (h @ w_in).reshape(bsz, L, POOL_GROUPS, POOL_GROUP_DIM).astype(jnp.float32)
    cs0 = jnp.concatenate([jnp.zeros_like(z[:, :1]), jnp.cumsum(z, axis=1)], axis=1)
    t_pos = jnp.arange(L)
    outs = []
    for gi, win in enumerate(POOL_WINDOWS):
        c = cs0[:, :, gi]
        lower = jnp.concatenate([jnp.zeros_like(c[:, :win - 1]), c[:, :L + 1 - win]], axis=1)
        count = jnp.minimum(t_pos + 1, win).astype(jnp.float32)[None, :, None]
        outs.append((c[:, 1:] - lower) / count - z[:, :, gi])
    pooled = jnp.stack(outs, axis=2).astype(h.dtype)
    y = jnp.einsum('blgd,gde->blge', pooled, w_group) * scale
    return y.reshape(bsz, L, D_MODEL) @ w_out


def _memory_cross_attention(h, mem_n, w_q, w_kv, w_o):
    bsz, L, _ = h.shape
    q = (h @ w_q).reshape(bsz, L, XA_HEADS, XA_HEAD_DIM)
    k, v = jnp.split(mem_n @ w_kv, 2, axis=-1)
    k = k.reshape(bsz, -1, XA_HEADS, XA_HEAD_DIM)
    v = v.reshape(bsz, -1, XA_HEADS, XA_HEAD_DIM)
    s = jnp.einsum('bthd,bmhd->bhtm', q, k).astype(jnp.float32) * (XA_HEAD_DIM ** -0.5)
    p = jax.nn.softmax(s, axis=-1).astype(v.dtype)
    o = jnp.einsum('bhtm,bmhd->bthd', p, v).reshape(bsz, L, XA_DIM)
    return o @ w_o


def _conv_ffn(h, w_up, conv_w, conv_b, w_down):
    u = _causal_dwconv(h @ w_up, conv_w, conv_b)
    gate, val = jnp.split(u, 2, axis=-1)
    return (jax.nn.silu(gate) * val) @ w_down


def setup_inputs(seed: int = 0) -> dict:
    key = jax.random.key(seed)
    keys = iter(jax.random.split(key, 64))
    f32 = jnp.float32

    def nrm(shape, fan_in):
        return jax.random.normal(next(keys), shape, f32) * (fan_in ** -0.5)

    def gain(shape):
        return 1.0 + 0.05 * jax.random.normal(next(keys), shape, f32)

    def small(shape, s=0.02):
        return s * jax.random.normal(next(keys), shape, f32)

    n_a, n_b, n_c, n_d = [len(range(m, DEPTH, N_MIXERS)) for m in range(N_MIXERS)]
    x = jax.random.normal(next(keys), (BATCH, SEQ, D_MODEL), f32)
    mem = jax.random.normal(next(keys), (BATCH, MEM_LEN, D_MODEL), f32)
    norm_pre = gain((DEPTH, 3, D_MODEL))
    norm_post = gain((DEPTH, 3, D_MODEL))
    norm_mem = gain((DEPTH, D_MODEL))
    ssd_w_in = nrm((n_a, D_MODEL, SSD_IN_DIM), D_MODEL)
    ssd_conv_w = nrm((n_a, SSD_CONV, SSD_CONV_DIM), SSD_CONV)
    ssd_conv_b = small((n_a, SSD_CONV_DIM))
    dt0 = jnp.exp(jax.random.uniform(next(keys), (n_a, SSD_N_HEADS), f32, math.log(1e-3), math.log(1e-1)))
    ssd_dt_bias = dt0 + jnp.log(-jnp.expm1(-dt0))
    ssd_a_log = jnp.log(jax.random.uniform(next(keys), (n_a, SSD_N_HEADS), f32, 1.0, 16.0))
    ssd_d = gain((n_a, SSD_N_HEADS))
    ssd_norm_g = gain((n_a, SSD_D_INNER))
    ssd_w_out = nrm((n_a, SSD_D_INNER, D_MODEL), SSD_D_INNER)
    nsa_w_in = nrm((n_b, D_MODEL, NSA_IN_DIM), D_MODEL)
    nsa_cmp_pos = small((n_b, 2, NSA_CMP_BLOCK, NSA_HEAD_DIM), 0.1)
    nsa_cmp_w1 = nrm((n_b, 2, NSA_CMP_BLOCK * NSA_HEAD_DIM, NSA_CMP_HIDDEN), NSA_CMP_BLOCK * NSA_HEAD_DIM)
    nsa_cmp_w2 = nrm((n_b, 2, NSA_CMP_HIDDEN, NSA_HEAD_DIM), NSA_CMP_HIDDEN)
    nsa_w_out = nrm((n_b, NSA_N_HEADS * NSA_HEAD_DIM, D_MODEL), NSA_N_HEADS * NSA_HEAD_DIM)
    sgu_w_in = nrm((n_c, D_MODEL, 2 * SGU_WIDTH), D_MODEL)
    sgu_b_in = small((n_c, 2 * SGU_WIDTH))
    sgu_ln_g = gain((n_c, SGU_WIDTH))
    sgu_w_spatial = nrm((n_c, SGU_GROUPS, SGU_CHUNK, SGU_CHUNK), SGU_CHUNK)
    sgu_b_spatial = 1.0 + small((n_c, SGU_GROUPS, SGU_CHUNK), 0.1)
    sgu_w_out = nrm((n_c, SGU_WIDTH, D_MODEL), SGU_WIDTH)
    pool_w_in = nrm((n_d, D_MODEL, D_MODEL), D_MODEL)
    pool_w_group = nrm((n_d, POOL_GROUPS, POOL_GROUP_DIM, POOL_GROUP_DIM), POOL_GROUP_DIM)
    pool_scale = 1.0 + small((n_d, POOL_GROUPS, POOL_GROUP_DIM), 0.1)
    pool_w_out = nrm((n_d, D_MODEL, D_MODEL), D_MODEL)
    xa_w_q = nrm((DEPTH, D_MODEL, XA_DIM), D_MODEL)
    xa_w_kv = nrm((DEPTH, D_MODEL, 2 * XA_DIM), D_MODEL)
    xa_w_o = nrm((DEPTH, XA_DIM, D_MODEL), XA_DIM)
    ffn_w_up = nrm((DEPTH, D_MODEL, 2 * FFN_HIDDEN), D_MODEL)
    ffn_conv_w = nrm((DEPTH, FFN_CONV, 2 * FFN_HIDDEN), FFN_CONV)
    ffn_conv_b = small((DEPTH, 2 * FFN_HIDDEN))
    ffn_w_down = nrm((DEPTH, FFN_HIDDEN, D_MODEL), FFN_HIDDEN)
    return {
        "x": x, "mem": mem,
        "norm_pre": norm_pre, "norm_post": norm_post, "norm_mem": norm_mem,
        "ssd_w_in": ssd_w_in, "ssd_conv_w": ssd_conv_w, "ssd_conv_b": ssd_conv_b,
        "ssd_dt_bias": ssd_dt_bias, "ssd_a_log": ssd_a_log, "ssd_d": ssd_d,
        "ssd_norm_g": ssd_norm_g, "ssd_w_out": ssd_w_out,
        "nsa_w_in": nsa_w_in, "nsa_cmp_pos": nsa_cmp_pos, "nsa_cmp_w1": nsa_cmp_w1,
        "nsa_cmp_w2": nsa_cmp_w2, "nsa_w_out": nsa_w_out,
        "sgu_w_in": sgu_w_in, "sgu_b_in": sgu_b_in, "sgu_ln_g": sgu_ln_g,
        "sgu_w_spatial": sgu_w_spatial, "sgu_b_spatial": sgu_b_spatial, "sgu_w_out": sgu_w_out,
        "pool_w_in": pool_w_in, "pool_w_group": pool_w_group, "pool_scale": pool_scale,
        "pool_w_out": pool_w_out,
        "xa_w_q": xa_w_q, "xa_w_kv": xa_w_kv, "xa_w_o": xa_w_o,
        "ffn_w_up": ffn_w_up, "ffn_conv_w": ffn_conv_w, "ffn_conv_b": ffn_conv_b,
        "ffn_w_down": ffn_w_down,
    }


def reference(x, mem, norm_pre, norm_post, norm_mem,
              ssd_w_in, ssd_conv_w, ssd_conv_b, ssd_dt_bias, ssd_a_log, ssd_d, ssd_norm_g, ssd_w_out,
              nsa_w_in, nsa_cmp_pos, nsa_cmp_w1, nsa_cmp_w2, nsa_w_out,
              sgu_w_in, sgu_b_in, sgu_ln_g, sgu_w_spatial, sgu_b_spatial, sgu_w_out,
              pool_w_in, pool_w_group, pool_scale, pool_w_out,
              xa_w_q, xa_w_kv, xa_w_o,
              ffn_w_up, ffn_conv_w, ffn_conv_b, ffn_w_down):
    for i in range(DEPTH):
        kind, j = i % N_MIXERS, i // N_MIXERS
        h = _rmsnorm(x, norm_pre[i, 0])
        if kind == 0:
            m = _ssd_mixer(h, ssd_w_in[j], ssd_conv_w[j], ssd_conv_b[j], ssd_dt_bias[j],
                           ssd_a_log[j], ssd_d[j], ssd_norm_g[j], ssd_w_out[j])
        elif kind == 1:
            m = _nsa_mixer(h, nsa_w_in[j], nsa_cmp_pos[j], nsa_cmp_w1[j], nsa_cmp_w2[j], nsa_w_out[j])
        elif kind == 2:
            m = _sgu_mixer(h, sgu_w_in[j], sgu_b_in[j], sgu_ln_g[j], sgu_w_spatial[j],
                           sgu_b_spatial[j], sgu_w_out[j])
        else:
            m = _pool_mixer(h, pool_w_in[j], pool_w_group[j], pool_scale[j], pool_w_out[j])
        x = x + _rmsnorm(m, norm_post[i, 0])
        h = _rmsnorm(x, norm_pre[i, 1])
        a = _memory_cross_attention(h, _rmsnorm(mem, norm_mem[i]), xa_w_q[i], xa_w_kv[i], xa_w_o[i])
        x = x + _rmsnorm(a, norm_post[i, 1])
        h = _rmsnorm(x, norm_pre[i, 2])
        f = _conv_ffn(h, ffn_w_up[i], ffn_conv_w[i], ffn_conv_b[i], ffn_w_down[i])
        x = x + _rmsnorm(f, norm_post[i, 2])
    return x
```

```cpp
#include <hip/hip_runtime.h>
#include <cstdio>
#include <cstdint>

#ifndef MK_MULTI
#define MK_MULTI 0
#endif
#ifndef PROBE
#define PROBE 0
#endif

#define GAS __attribute__((address_space(1)))
#define LAS __attribute__((address_space(3)))
typedef unsigned short bf16;
typedef unsigned v4u __attribute__((ext_vector_type(4)));
typedef unsigned v2u __attribute__((ext_vector_type(2)));
typedef float f32x4 __attribute__((ext_vector_type(4)));
typedef float f32x2 __attribute__((ext_vector_type(2)));
typedef short bf16x8 __attribute__((ext_vector_type(8)));
typedef short s16x4 __attribute__((ext_vector_type(4)));
#define LDS_WAIT() asm volatile("s_waitcnt lgkmcnt(0)" ::: "memory")

constexpr int DM = 2048, NB = 4, SEQ = 4096, MT = NB * SEQ;
constexpr int SSD_NP = 10496, SSD_IN = 10304;
constexpr int NSA_NP = 5376, NSA_IN = 5168;
constexpr int FFH = 5632, FF2 = 11264;
constexpr float EPS = 1e-6f;

constexpr size_t MiB = 1u << 20;
constexpr size_t WS_CTL = 0, CTL_ZERO_BYTES = 64 * 1024;
constexpr size_t WS_W = 1 * MiB;
constexpr size_t W_MIX_IN = WS_W + 0, W_MIX_OUT = WS_W + 44 * MiB, W_MIX_X = WS_W + 62 * MiB;
constexpr size_t W_XQ = WS_W + 68 * MiB, W_XKV = WS_W + 71 * MiB, W_XO = WS_W + 76 * MiB, W_UP = WS_W + 79 * MiB, W_DOWN = WS_W + 123 * MiB;
constexpr size_t WS_H = 148 * MiB;
constexpr size_t WS_PROJ = 212 * MiB;
constexpr size_t WS_ACT = 564 * MiB;
constexpr size_t WS_Q = 756 * MiB, WS_O = 772 * MiB, WS_KV = 788 * MiB, WS_MEMN = 790 * MiB, WS_DT = 794 * MiB, WS_PB = 798 * MiB;
constexpr size_t WS_SXT = 800 * MiB;
constexpr size_t WS_SBT = 928 * MiB;
constexpr size_t WS_END = 960 * MiB;
constexpr size_t WS_NQ = WS_PROJ + 128 * MiB;
constexpr size_t WS_NT = WS_NQ + 64 * MiB;
constexpr size_t NT_STRIDE = (size_t)16 * 4096 * 128;
constexpr size_t WS_NHID = WS_NT + 97 * MiB;
constexpr size_t WS_NKC = WS_NHID + 4 * MiB;
constexpr size_t WS_NG = WS_NKC + 4 * MiB;
constexpr size_t WS_NVT = WS_NG + 3 * MiB;
static_assert(WS_NVT + 32 * MiB <= WS_ACT, "nsa map");
constexpr size_t WS_XVT = 799 * MiB;
constexpr int CW_BAR = 4096;

constexpr int LDS_BYTES = 159744;
constexpr int MISC_OFF = LDS_BYTES - 256;

__device__ __forceinline__ unsigned f2bf(float f) { unsigned u = __builtin_bit_cast(unsigned, f); return (u + 0x7fffu + ((u >> 16) & 1u)) >> 16; }
__device__ __forceinline__ unsigned pk2(float lo, float hi) { return f2bf(lo) | (f2bf(hi) << 16); }
__device__ __forceinline__ float bflo(unsigned u) { return __builtin_bit_cast(float, u << 16); }
__device__ __forceinline__ float bfhi(unsigned u) { return __builtin_bit_cast(float, u & 0xffff0000u); }
__device__ __forceinline__ float wave_sum(float v) {
#pragma unroll
    for (int o = 1; o < 64; o <<= 1) v += __shfl_xor(v, o);
    return v;
}
__device__ __forceinline__ float wave_max(float v) {
#pragma unroll
    for (int o = 1; o < 64; o <<= 1) v = fmaxf(v, __shfl_xor(v, o));
    return v;
}
__device__ __forceinline__ float sigmoidf_(float x) { return 1.f / (1.f + __expf(-x)); }
__device__ __forceinline__ float silu_fast(float x) { return x * __builtin_amdgcn_rcpf(1.f + __builtin_amdgcn_exp2f(-1.4426950408889634f * x)); }
__device__ __forceinline__ float siluf_(float x) { return x * sigmoidf_(x); }
__device__ __forceinline__ float gelu_tanh(float x) { return x * __builtin_amdgcn_rcpf(1.f + __builtin_amdgcn_exp2f(x * __builtin_fmaf(-1.029432396e-01f, x * x, -2.302208198e+00f))); }

#define XB_TMO      128
#define XB_XCNT(j)  (256  + 64 * (j))
#define XB_XSUB(j)  (1280 + 64 * (j))
#define XB_XGEN(j)  (2304 + 64 * (j))
#define XB_TOP      3328
#define XB_TOPGEN   3392
#define XCD_BAR_WORDS 3456
#define XB_SPIN_CAP (1u << 22)

__device__ __forceinline__ unsigned xb_ld(unsigned* p)              { return __hip_atomic_load(p, __ATOMIC_RELAXED, __HIP_MEMORY_SCOPE_AGENT); }
__device__ __forceinline__ unsigned xb_add(unsigned* p, unsigned v) { return __hip_atomic_fetch_add(p, v, __ATOMIC_RELAXED, __HIP_MEMORY_SCOPE_AGENT); }
__device__ __forceinline__ unsigned xb_xcc_id() { return (unsigned)__builtin_amdgcn_s_getreg((3 << 11) | 20) & 0xFu; }
#define XB_SPIN(cond, bar) do { unsigned _sp = 0; while (cond) { __builtin_amdgcn_s_sleep(1); \
    if ((++_sp & 255u) == 0u) { if (xb_ld(&(bar)[XB_TMO])) break; if (_sp > XB_SPIN_CAP) { atomicAdd(&(bar)[XB_TMO], 1u); break; } } } } while (0)

struct XcdBarrier { unsigned* bar; unsigned x; volatile LAS unsigned* st; };

__device__ __forceinline__ XcdBarrier xcd_barrier_post(unsigned* bar, volatile LAS unsigned* st) {
    XcdBarrier b; b.bar = bar; b.x = xb_xcc_id(); b.st = st;
    if (threadIdx.x == 0) (void)xb_add(&bar[XB_XCNT(b.x)], 1u);
    return b;
}
__device__ __forceinline__ void xcd_barrier_complete(unsigned* bar, unsigned x, unsigned& nloc, unsigned& nx) {
    const unsigned G = gridDim.x * gridDim.y * gridDim.z;
    unsigned sum, cnt, mine, sp = 0u;
    for (;;) {
        sum = 0u; cnt = 0u; mine = 0u;
#pragma unroll
        for (unsigned j = 0; j < 16; ++j) { const unsigned c = xb_ld(&bar[XB_XCNT(j)]); sum += c; cnt += (c > 0u) ? 1u : 0u; mine = (j == x) ? c : mine; }
        if (sum == G) break;
        __builtin_amdgcn_s_sleep(1);
        if ((++sp & 255u) == 0u) { if (xb_ld(&bar[XB_TMO])) break; if (sp > XB_SPIN_CAP) { atomicAdd(&bar[XB_TMO], 1u); break; } }
    }
    nloc = mine > 0u ? mine : 1u; nx = cnt > 0u ? cnt : 1u;
}
__device__ __forceinline__ void xcd_barrier(const XcdBarrier& b) {
    asm volatile("s_waitcnt vmcnt(0)" ::: "memory");
    __syncthreads();
    if (threadIdx.x == 0) {
        unsigned* bar = b.bar;
        __builtin_amdgcn_s_waitcnt(0);
        unsigned nloc = b.st[0], nx = b.st[1];
        if (nloc == 0u) { xcd_barrier_complete(bar, b.x, nloc, nx); b.st[0] = nloc; b.st[1] = nx; }
        const unsigned old = xb_add(&bar[XB_XSUB(b.x)], 1u);
        const unsigned gen = old / nloc;
        if (old + 1u == (gen + 1u) * nloc) {
            __builtin_amdgcn_fence(__ATOMIC_RELEASE, "agent");
            asm volatile("s_waitcnt vmcnt(0)" ::: "memory");
            const unsigned og = xb_add(&bar[XB_TOP], 1u);
            const unsigned tg = og / nx;
            if (og + 1u == (tg + 1u) * nx) xb_add(&bar[XB_TOPGEN], 1u);
            else XB_SPIN(xb_ld(&bar[XB_TOPGEN]) == tg, bar);
            __builtin_amdgcn_fence(__ATOMIC_ACQUIRE, "agent");
            xb_add(&bar[XB_XGEN(b.x)], 1u);
            asm volatile("s_waitcnt vmcnt(0)" ::: "memory");
        } else {
            XB_SPIN(xb_ld(&bar[XB_XGEN(b.x)]) == gen, bar);
            __builtin_amdgcn_fence(__ATOMIC_ACQUIRE, "agent");
            asm volatile("s_waitcnt vmcnt(0)" ::: "memory");
        }
    }
    __syncthreads();
}

namespace pg8 {
constexpr int BM = 256, BK = 64, HALF = 128, HTB = HALF * BK * 2, STAGE_BYTES = 8 * HTB, NXCD = 8, WGM = 8;
__device__ __forceinline__ int lds_byte(int r, int c) { const int st = (r >> 4) * 2 + (c >> 5), rr = r & 15, cc = c & 31, ob = rr * 64 + cc * 2; return st * 1024 + (ob ^ (((ob >> 9) & 1) << 5)); }
__device__ __forceinline__ void stage_rc(int b, int& R, int& C) { const int st = b / 1024, sb = b % 1024, swz = sb ^ (((sb >> 9) & 1) << 5); R = (st >> 1) * 16 + swz / 64; C = (st & 1) * 32 + (swz % 64) / 2; }
__device__ __forceinline__ int perm32(int rho) { const int n = rho >> 4, i = rho & 15; return 8 * (i >> 2) + 4 * n + (i & 3); }
struct Unit { int pm, pn; };
struct Prob {
    static constexpr bool ROWPERM = false;
    const bf16* A; const bf16* Bt; int lda, ldb, K, nM, nN, G, c; int a_group_shift, a_group_cols;
    size_t a_tile_stride, b_tile_stride;
    __device__ __forceinline__ void init(const bf16* A_, const bf16* Bt_, int lda_, int ldb_, int K_, int nM_, int nN_, int G_, int c_) {
        A = A_; Bt = Bt_; lda = lda_; ldb = ldb_; K = K_; nM = nM_; nN = nN_; G = G_; c = c_; a_group_shift = 0; a_group_cols = 0; a_tile_stride = (size_t)256 * lda_; b_tile_stride = (size_t)256 * ldb_; }
    __device__ __forceinline__ bool next(int i, Unit& u) const {
        const int nwg = nM * nN; const long L = (long)i * G + c; if (L >= nwg) return false;
        int wgid = (int)L; { const int q = nwg / NXCD, r = nwg % NXCD, xcd = wgid % NXCD, off = wgid / NXCD; wgid = (xcd < r ? xcd * (q + 1) : r * (q + 1) + (xcd - r) * q) + off; }
        const int nig = WGM * nN, gid = wgid / nig, fm = gid * WGM, gsz = (nM - fm) < WGM ? (nM - fm) : WGM;
        u.pm = fm + ((wgid % nig) % gsz); u.pn = (wgid % nig) / gsz; return true;
    }
    __device__ __forceinline__ const char* pa(const Unit& u) const { return (const char*)(A + (size_t)u.pm * a_tile_stride + (size_t)((u.pn >> a_group_shift) * a_group_cols)); }
    __device__ __forceinline__ const char* pb(const Unit& u) const { return (const char*)(Bt + (size_t)u.pn * b_tile_stride); }
};
struct ProbR : Prob { static constexpr bool ROWPERM = true; };
struct ProbSplit : Prob { int nA, nB;
    __device__ __forceinline__ bool next(int i, Unit& u) const {
        const int nwg = nM * nN, a = (c & 7) | ((c >> 4) << 3), grp = (c >> 3) & 1;
        if (i >= (grp ? nB : nA)) return false;
        const int L = (grp ? 128 * nA : 0) + i * 128 + a; if (L >= nwg) return false;
        int wgid = L; { const int q = nwg / NXCD, r = nwg % NXCD, xcd = wgid % NXCD, off = wgid / NXCD; wgid = (xcd < r ? xcd * (q + 1) : r * (q + 1) + (xcd - r) * q) + off; }
        const int nig = WGM * nN, gid = wgid / nig, fm = gid * WGM, gsz = (nM - fm) < WGM ? (nM - fm) : WGM;
        u.pm = fm + ((wgid % nig) % gsz); u.pn = (wgid % nig) / gsz; return true;
    } };
struct ProbC : Prob {
    __device__ __forceinline__ const char* pa(const Unit& u) const { return (const char*)(A + (size_t)u.pm * a_tile_stride + (size_t)u.pn * 512); }
    __device__ __forceinline__ const char* pb(const Unit& u) const { return (const char*)(Bt + (size_t)(u.pm >> 4) * 256 * 4096 + (size_t)u.pn * 512); } };
__device__ __forceinline__ unsigned cvt_pk_bf16(float lo, float hi) { unsigned r; asm volatile("v_cvt_pk_bf16_f32 %0, %1, %2" : "=v"(r) : "v"(lo), "v"(hi)); return r; }

template <class F> struct EpiP {
    static constexpr bool PERM = true; F f; const float* rowscale;
    __device__ __forceinline__ void operator()(const f32x4 (&acc)[2][2][4][2], const Unit& u, int wr, int wc, int fr, int fq) const {
        const int row0 = u.pm * BM + wr * 64 + fr, col0 = u.pn * BM + wc * 32 + 8 * fq;
#pragma unroll
        for (int ai = 0; ai < 2; ++ai)
#pragma unroll
            for (int m = 0; m < 4; ++m) { const int row = row0 + ai * HALF + m * 16; const float rs = rowscale ? rowscale[row] : 1.f;
#pragma unroll
                for (int bj = 0; bj < 2; ++bj) f(row, col0 + bj * HALF, acc[ai][bj][m][0] * rs, acc[ai][bj][m][1] * rs); }
    }
};
template <class F> struct EpiN {
    static constexpr bool PERM = false; F f; const float* rowscale;
    __device__ __forceinline__ void operator()(const f32x4 (&acc)[2][2][4][2], const Unit& u, int wr, int wc, int fr, int fq) const {
        const int row0 = u.pm * BM + wr * 64 + fr, col0 = u.pn * BM + wc * 32 + 4 * fq;
#pragma unroll
        for (int ai = 0; ai < 2; ++ai)
#pragma unroll
            for (int m = 0; m < 4; ++m) { const int row = row0 + ai * HALF + m * 16; const float rs = rowscale ? rowscale[row] : 1.f;
#pragma unroll
                for (int bj = 0; bj < 2; ++bj)
#pragma unroll
                    for (int n = 0; n < 2; ++n) f(row, col0 + bj * HALF + n * 16, acc[ai][bj][m][n] * rs); }
    }
};

#ifndef GEMM_REP
#define GEMM_REP 1
#endif
template <class PT, class Epi> __device__ __forceinline__ void gemm_phase_once(LAS unsigned char* lds, const PT& S, const Epi& E, bool epi_on);
template <class PT, class Epi>
__device__ __forceinline__ void gemm_phase(LAS unsigned char* lds, const PT& S, const Epi& E) {
    gemm_phase_once(lds, S, E, true);
}
template <class PT, class Epi>
__device__ __forceinline__ void gemm_phase_once(LAS unsigned char* lds, const PT& S, const Epi& E, bool epi_on) {
    int tid_ = threadIdx.x; asm volatile("" : "+v"(tid_)); tid_ &= 511;
    const int tid = tid_, wid = __builtin_amdgcn_readfirstlane(tid >> 6), lane = tid & 63, wr = wid >> 2, wc = wid & 3, fr = lane & 15, fq = lane >> 4;
    const int K = S.K, nt = K / BK, lda = S.lda, ldb = S.ldb;
    unsigned voffA[2], voffB[2];
#pragma unroll
    for (int i = 0; i < 2; ++i) { int R, C; stage_rc(tid * 16 + i * 8192, R, C); const int Rb = Epi::PERM ? ((R & ~31) + perm32(R & 31)) : R;
        const int Ra = PT::ROWPERM ? (128 * (R >> 6) + 8 * (R & 15) + ((R >> 4) & 3)) : R;
        voffA[i] = (unsigned)(Ra * lda + C) * 2u; voffB[i] = (unsigned)(Rb * ldb + C) * 2u; }
    const size_t kstep = (size_t)(BK * 2);
    const size_t hstepA = (size_t)(PT::ROWPERM ? 4 : HALF) * lda * 2, hstepB = (size_t)HALF * ldb * 2;
    const unsigned ldsw = (unsigned)wid * 1024u;
    const int aoff = lds_byte(wr * 64 + fr, fq * 8), boff = lds_byte(wc * 32 + fr, fq * 8);
#define PG8_SA(b, h) (((b) * 2 + (h)) * HTB)
#define PG8_SB(b, h) ((4 + (b) * 2 + (h)) * HTB)
#define PG8_STAGE(bufoff, gbase, voff) do { _Pragma("unroll") for (int _i = 0; _i < 2; ++_i) \
        __builtin_amdgcn_global_load_lds((const unsigned*)((const char*)(gbase) + (voff)[_i]), (LAS unsigned*)(lds + (bufoff) + ldsw + _i * 8192), 16, 0, 0); } while (0)
#define PG8_LDA(dst, b, h) do { _Pragma("unroll") for (int m = 0; m < 4; ++m) _Pragma("unroll") for (int k = 0; k < 2; ++k) dst[m][k] = *(const LAS bf16x8*)(lds + PG8_SA(b, h) + aoff + m * 2048 + k * 1024); } while (0)
#define PG8_LDB(dst, b, h) do { _Pragma("unroll") for (int n = 0; n < 2; ++n) _Pragma("unroll") for (int k = 0; k < 2; ++k) dst[n][k] = *(const LAS bf16x8*)(lds + PG8_SB(b, h) + boff + n * 2048 + k * 1024); } while (0)
#define PG8_MMA(ai, bj, At, Bt) do { __builtin_amdgcn_s_setprio(1); _Pragma("unroll") for (int m = 0; m < 4; ++m) _Pragma("unroll") for (int n = 0; n < 2; ++n) _Pragma("unroll") for (int k = 0; k < 2; ++k) \
        acc[ai][bj][m][n] = __builtin_amdgcn_mfma_f32_16x16x32_bf16(Bt[n][k], At[m][k], acc[ai][bj][m][n], 0, 0, 0); __builtin_amdgcn_s_setprio(0); } while (0)
#define PG8_WAIT_V(n) asm volatile("s_waitcnt vmcnt(" #n ")" ::: "memory")
#define PG8_WAIT_L(n) asm volatile("s_waitcnt lgkmcnt(" #n ")" ::: "memory")
#define PG8_BAR __builtin_amdgcn_s_barrier()
#define PG8_SCHED __builtin_amdgcn_sched_barrier(0)
    Unit cur, nxt; int ui = 0;
    if (!S.next(0, cur)) return;
    f32x4 acc[2][2][4][2];
#pragma unroll
    for (int a = 0; a < 2; ++a)
#pragma unroll
        for (int b = 0; b < 2; ++b)
#pragma unroll
            for (int m = 0; m < 4; ++m)
#pragma unroll
                for (int n = 0; n < 2; ++n) acc[a][b][m][n] = (f32x4){0.f, 0.f, 0.f, 0.f};
    bf16x8 At[4][2], B0[2][2], B1[2][2];
    const char* cA = S.pa(cur); const char* cB = S.pb(cur);
    PG8_STAGE(PG8_SB(0, 0), cB, voffB); PG8_STAGE(PG8_SA(0, 0), cA, voffA); PG8_STAGE(PG8_SB(0, 1), cB + hstepB, voffB); PG8_STAGE(PG8_SA(0, 1), cA + hstepA, voffA);
    if (wr == 1) PG8_BAR;
    PG8_WAIT_V(4); PG8_BAR;
    PG8_STAGE(PG8_SB(1, 0), cB + kstep, voffB); PG8_STAGE(PG8_SA(1, 0), cA + kstep, voffA); PG8_STAGE(PG8_SB(1, 1), cB + hstepB + kstep, voffB);
    PG8_WAIT_V(6); PG8_BAR;
    for (;;) {
        const bool has_next = S.next(ui + 1, nxt);
        const char* nA = has_next ? S.pa(nxt) : cA; const char* nB = has_next ? S.pb(nxt) : cB;
        for (int t = 0; t < nt; t += 2) {
            const bool last = (t == nt - 2);
            const char* a1 = cA + (size_t)(t + 1) * kstep;
            const char* a2 = last ? nA : cA + (size_t)(t + 2) * kstep; const char* b2 = last ? nB : cB + (size_t)(t + 2) * kstep;
            const char* a3 = a2 + kstep; const char* b3 = b2 + kstep;
            PG8_LDB(B0, 0, 0); PG8_SCHED; PG8_LDA(At, 0, 0); PG8_STAGE(PG8_SA(1, 1), a1 + hstepA, voffA);
            PG8_WAIT_L(8); PG8_BAR; PG8_WAIT_L(0); PG8_MMA(0, 0, At, B0); PG8_BAR; PG8_SCHED;
            PG8_LDB(B1, 0, 1); PG8_STAGE(PG8_SB(0, 0), b2, voffB);
            PG8_BAR; PG8_WAIT_L(0); PG8_MMA(0, 1, At, B1); PG8_BAR;
            PG8_LDA(At, 0, 1); PG8_STAGE(PG8_SA(0, 0), a2, voffA);
            PG8_BAR; PG8_WAIT_L(0); PG8_MMA(1, 0, At, B0); PG8_BAR; PG8_SCHED;
            PG8_STAGE(PG8_SB(0, 1), b2 + hstepB, voffB);
            PG8_WAIT_V(6); PG8_BAR; PG8_MMA(1, 1, At, B1); PG8_BAR;
            PG8_LDB(B0, 1, 0); PG8_SCHED; PG8_LDA(At, 1, 0); PG8_STAGE(PG8_SA(0, 1), a2 + hstepA, voffA);
            PG8_WAIT_L(8); PG8_BAR; PG8_WAIT_L(0); PG8_MMA(0, 0, At, B0); PG8_BAR; PG8_SCHED;
            PG8_LDB(B1, 1, 1); PG8_STAGE(PG8_SB(1, 0), b3, voffB);
            PG8_BAR; PG8_WAIT_L(0); PG8_MMA(0, 1, At, B1); PG8_BAR;
            PG8_LDA(At, 1, 1); PG8_STAGE(PG8_SA(1, 0), a3, voffA);
            PG8_BAR; PG8_WAIT_L(0); PG8_MMA(1, 0, At, B0); PG8_BAR; PG8_SCHED;
            PG8_STAGE(PG8_SB(1, 1), b3 + hstepB, voffB);
            PG8_WAIT_V(6); PG8_BAR; PG8_MMA(1, 1, At, B1); PG8_BAR;
        }
        if (epi_on) E(acc, cur, wr, wc, fr, fq);
        if (!has_next) break;
#pragma unroll
        for (int a = 0; a < 2; ++a)
#pragma unroll
            for (int b = 0; b < 2; ++b)
#pragma unroll
                for (int m = 0; m < 4; ++m)
#pragma unroll
                    for (int n = 0; n < 2; ++n) acc[a][b][m][n] = (f32x4){0.f, 0.f, 0.f, 0.f};
        cur = nxt; cA = nA; cB = nB; ++ui;
    }
    PG8_WAIT_V(0);
    if (wr == 0) PG8_BAR;
    PG8_BAR;
#undef PG8_SA
#undef PG8_SB
#undef PG8_STAGE
#undef PG8_LDA
#undef PG8_LDB
#undef PG8_MMA
#undef PG8_WAIT_V
#undef PG8_WAIT_L
#undef PG8_BAR
#undef PG8_SCHED
}
}

struct StBf16 { bf16* O; int ldc;
    __device__ __forceinline__ void operator()(int row, int col, f32x4 v0, f32x4 v1) const {
        v4u w; w.x = pg8::cvt_pk_bf16(v0[0], v0[1]); w.y = pg8::cvt_pk_bf16(v0[2], v0[3]); w.z = pg8::cvt_pk_bf16(v1[0], v1[1]); w.w = pg8::cvt_pk_bf16(v1[2], v1[3]);
        *(v4u*)(O + (size_t)row * ldc + col) = w; } };
struct StBf16BiasGelu { bf16* O; int ldc; const float* bias;
    __device__ __forceinline__ void operator()(int row, int col, f32x4 v0, f32x4 v1) const {
        const f32x4 b0 = *(const f32x4*)(bias + col), b1 = *(const f32x4*)(bias + col + 4);
#pragma unroll
        for (int j = 0; j < 4; ++j) { v0[j] = gelu_tanh(v0[j] + b0[j]); v1[j] = gelu_tanh(v1[j] + b1[j]); }
        v4u w; w.x = pg8::cvt_pk_bf16(v0[0], v0[1]); w.y = pg8::cvt_pk_bf16(v0[2], v0[3]); w.z = pg8::cvt_pk_bf16(v1[0], v1[1]); w.w = pg8::cvt_pk_bf16(v1[2], v1[3]);
        *(v4u*)(O + (size_t)row * ldc + col) = w; } };
struct StBf16Scale { bf16* O; int ldc; const float* scale;
    __device__ __forceinline__ void operator()(int row, int col, f32x4 v0, f32x4 v1) const {
        const f32x4 b0 = *(const f32x4*)(scale + col), b1 = *(const f32x4*)(scale + col + 4);
        v0 = v0 * b0; v1 = v1 * b1;
        v4u w; w.x = pg8::cvt_pk_bf16(v0[0], v0[1]); w.y = pg8::cvt_pk_bf16(v0[2], v0[3]); w.z = pg8::cvt_pk_bf16(v1[0], v1[1]); w.w = pg8::cvt_pk_bf16(v1[2], v1[3]);
        *(v4u*)(O + (size_t)row * ldc + col) = w; } };
struct StF32 { float* C; int ldc;
    __device__ __forceinline__ void operator()(int row, int col, f32x4 v) const { *(f32x4*)(C + (size_t)row * ldc + col) = v; } };
struct StNsa { bf16* Q; bf16* T; float* Gt;
    __device__ __forceinline__ void operator()(int row, int col, f32x4 v0, f32x4 v1) const {
        v4u w; w.x = pg8::cvt_pk_bf16(v0[0], v0[1]); w.y = pg8::cvt_pk_bf16(v0[2], v0[3]); w.z = pg8::cvt_pk_bf16(v1[0], v1[1]); w.w = pg8::cvt_pk_bf16(v1[2], v1[3]);
        if (col < 2048) { *(v4u*)(Q + (size_t)row * 2048 + col) = w; }
        else if (col < 5120) { const int c2 = col - 2048, ten = c2 >> 9, g = (c2 >> 7) & 3, d = c2 & 127, b = row >> 12, t = row & 4095;
            *(v4u*)(T + (size_t)ten * NT_STRIDE + ((size_t)((b * 4 + g) * 4096 + t)) * 128 + d) = w; }
        else if (col < 5168) { float* p = Gt + (size_t)row * 48 + (col - 5120); *(f32x4*)p = v0; *(f32x4*)(p + 4) = v1; }
    } };
struct StKv { bf16* KV; bf16* XVT;
    __device__ __forceinline__ void operator()(int row, int col, f32x4 v0, f32x4 v1) const {
        if (col < 512) { v4u w; w.x = pg8::cvt_pk_bf16(v0[0], v0[1]); w.y = pg8::cvt_pk_bf16(v0[2], v0[3]); w.z = pg8::cvt_pk_bf16(v1[0], v1[1]); w.w = pg8::cvt_pk_bf16(v1[2], v1[3]); *(v4u*)(KV + (size_t)row * 1024 + col) = w; }
        else { const int c2 = col - 512, b = row >> 8, m = row & 255; bf16* p = XVT + ((size_t)(b * 4 + (c2 >> 7)) * 128 + (c2 & 127)) * 256 + m;
#pragma unroll
            for (int j = 0; j < 4; ++j) { p[(size_t)j * 256] = (bf16)f2bf(v0[j]); p[(size_t)(4 + j) * 256] = (bf16)f2bf(v1[j]); } }
    } };
struct StHid { bf16* O; const float* pb;
    __device__ __forceinline__ void operator()(int row, int col, f32x4 v0, f32x4 v1) const {
        const int ten = row >> 12; const float* bias = pb + ten * 256 + col;
        const f32x4 b0 = *(const f32x4*)(bias), b1 = *(const f32x4*)(bias + 4);
#pragma unroll
        for (int j = 0; j < 4; ++j) { v0[j] = gelu_tanh(v0[j] + b0[j]); v1[j] = gelu_tanh(v1[j] + b1[j]); }
        v4u w; w.x = pg8::cvt_pk_bf16(v0[0], v0[1]); w.y = pg8::cvt_pk_bf16(v0[2], v0[3]); w.z = pg8::cvt_pk_bf16(v1[0], v1[1]); w.w = pg8::cvt_pk_bf16(v1[2], v1[3]);
        *(v4u*)(O + (size_t)row * 256 + col) = w; } };

struct Ctx { LAS unsigned char* lds; int tid, lane, wave, vcu, G, gw, NGW; };
__device__ __forceinline__ Ctx opq(const Ctx& c) { Ctx r = c; asm volatile("" : "+v"(r.tid), "+v"(r.lane)); r.tid &= 511; r.lane &= 63; return r; }
__device__ __forceinline__ float dpp_shr1(float x) { return __builtin_bit_cast(float, __builtin_amdgcn_update_dpp(0, __builtin_bit_cast(int, x), 0x111, 0xf, 0xf, true)); }
struct EpiFfn {
    static constexpr bool PERM = true;
    bf16* ACT; bf16* HALO; const float* RS; const float* cw; const float* cb;
    __device__ __forceinline__ void operator()(const f32x4 (&acc)[2][2][4][2], const pg8::Unit& u, int wr, int wc, int fr, int fq) const {
        const int ch0 = 128 * u.pn + 32 * wc + 8 * fq, tok0 = 256 * u.pm + 128 * wr + 8 * fr;
        const f32x4 r0 = *(const f32x4*)(RS + tok0), r1 = *(const f32x4*)(RS + tok0 + 4);
        bf16* hb = HALO + ((size_t)((u.pm * 44 + u.pn) * 2 + wr) * 4) * 256 + 32 * wc + 8 * fq;
#pragma unroll
        for (int n = 0; n < 2; ++n) {
            float g[8][4], v[8][4];
#pragma unroll
            for (int e = 0; e < 8; ++e) { const float rs = (e < 4) ? r0[e & 3] : r1[e & 3];
#pragma unroll
                for (int jj = 0; jj < 4; ++jj) { g[e][jj] = acc[e >> 2][0][e & 3][n][jj] * rs; v[e][jj] = acc[e >> 2][1][e & 3][n][jj] * rs; } }
            if (fr == 0) {
#pragma unroll
                for (int q = 0; q < 2; ++q) { v2u a, b; a.x = pk2(g[q][0], g[q][1]); a.y = pk2(g[q][2], g[q][3]); b.x = pk2(v[q][0], v[q][1]); b.y = pk2(v[q][2], v[q][3]);
                    *(v2u*)(hb + (size_t)q * 256 + 4 * n) = a; *(v2u*)(hb + (size_t)q * 256 + 128 + 4 * n) = b; } }
            if (fr == 15) {
#pragma unroll
                for (int q = 0; q < 2; ++q) { v2u a, b; a.x = pk2(g[6 + q][0], g[6 + q][1]); a.y = pk2(g[6 + q][2], g[6 + q][3]); b.x = pk2(v[6 + q][0], v[6 + q][1]); b.y = pk2(v[6 + q][2], v[6 + q][3]);
                    *(v2u*)(hb + (size_t)(2 + q) * 256 + 4 * n) = a; *(v2u*)(hb + (size_t)(2 + q) * 256 + 128 + 4 * n) = b; } }
            const int cc = ch0 + 4 * n;
            const f32x4 wg0 = *(const f32x4*)(cw + cc), wg1 = *(const f32x4*)(cw + FF2 + cc), wg2 = *(const f32x4*)(cw + 2 * FF2 + cc), wv0 = *(const f32x4*)(cw + FFH + cc), wv1 = *(const f32x4*)(cw + FF2 + FFH + cc), wv2 = *(const f32x4*)(cw + 2 * FF2 + FFH + cc);
            const f32x4 bg = *(const f32x4*)(cb + cc), bv = *(const f32x4*)(cb + FFH + cc);
#pragma unroll
            for (int jj = 0; jj < 4; ++jj) {
                float g2 = dpp_shr1(g[6][jj]), g1 = dpp_shr1(g[7][jj]), v2 = dpp_shr1(v[6][jj]), v1 = dpp_shr1(v[7][jj]);
#pragma unroll
                for (int e = 0; e < 8; ++e) { const float g0 = g[e][jj], v0 = v[e][jj];
                    const float cg = bg[jj] + wg0[jj] * g2 + wg1[jj] * g1 + wg2[jj] * g0, cv = bv[jj] + wv0[jj] * v2 + wv1[jj] * v1 + wv2[jj] * v0;
                    g[e][jj] = silu_fast(cg) * cv; g2 = g1; g1 = g0; v2 = v1; v1 = v0; } }
#pragma unroll
            for (int e = 0; e < 8; ++e) { v2u w; w.x = pk2(g[e][0], g[e][1]); w.y = pk2(g[e][2], g[e][3]); *(v2u*)(ACT + (size_t)(tok0 + e) * FFH + cc) = w; }
        }
    }
};
__device__ __forceinline__ void ffn_fixup(const Ctx& c, const bf16* HALO, const float* cw, const float* cb, bf16* ACT) {
    for (int it = c.vcu * 512 + c.tid; it < 64 * 44 * 2 * 16; it += c.G * 512) {
        const int cg8 = it & 15, wr = (it >> 4) & 1, tile = it >> 5, pm = tile / 44, pn = tile % 44, ch0 = 128 * pn + 8 * cg8;
        const bf16* cur = HALO + ((size_t)(tile * 2 + wr) * 4) * 256 + 8 * cg8;
        const bool hasprev = wr == 1 || (pm & 15) != 0; const bf16* prv = wr == 1 ? HALO + ((size_t)(tile * 2) * 4 + 2) * 256 + 8 * cg8 : HALO + ((size_t)((tile - 44) * 2 + 1) * 4 + 2) * 256 + 8 * cg8;
        const v4u z4 = (v4u){0u, 0u, 0u, 0u};
        const v4u cg0 = *(const v4u*)cur, cv0 = *(const v4u*)(cur + 128), cg1 = *(const v4u*)(cur + 256), cv1 = *(const v4u*)(cur + 256 + 128);
        const v4u pg2 = hasprev ? *(const v4u*)prv : z4, pv2 = hasprev ? *(const v4u*)(prv + 128) : z4, pg3 = hasprev ? *(const v4u*)(prv + 256) : z4, pv3 = hasprev ? *(const v4u*)(prv + 256 + 128) : z4;
        float oa[8], ob[8];
#pragma unroll
        for (int j = 0; j < 8; ++j) { const int q = j >> 1; const bool hi = j & 1;
            const float wg0 = cw[ch0 + j], wg1 = cw[FF2 + ch0 + j], wg2 = cw[2 * FF2 + ch0 + j], wv0 = cw[FFH + ch0 + j], wv1 = cw[FF2 + FFH + ch0 + j], wv2 = cw[2 * FF2 + FFH + ch0 + j], bg = cb[ch0 + j], bv = cb[FFH + ch0 + j];
            const float gA2 = hi ? bfhi(pg2[q]) : bflo(pg2[q]), gA1 = hi ? bfhi(pg3[q]) : bflo(pg3[q]), gA0 = hi ? bfhi(cg0[q]) : bflo(cg0[q]), gB0 = hi ? bfhi(cg1[q]) : bflo(cg1[q]);
            const float vA2 = hi ? bfhi(pv2[q]) : bflo(pv2[q]), vA1 = hi ? bfhi(pv3[q]) : bflo(pv3[q]), vA0 = hi ? bfhi(cv0[q]) : bflo(cv0[q]), vB0 = hi ? bfhi(cv1[q]) : bflo(cv1[q]);
            oa[j] = siluf_(bg + wg0 * gA2 + wg1 * gA1 + wg2 * gA0) * (bv + wv0 * vA2 + wv1 * vA1 + wv2 * vA0);
            ob[j] = siluf_(bg + wg0 * gA1 + wg1 * gA0 + wg2 * gB0) * (bv + wv0 * vA1 + wv1 * vA0 + wv2 * vB0); }
        const size_t tok = (size_t)256 * pm + 128 * wr;
        v4u w; w.x = pk2(oa[0], oa[1]); w.y = pk2(oa[2], oa[3]); w.z = pk2(oa[4], oa[5]); w.w = pk2(oa[6], oa[7]); *(v4u*)(ACT + tok * FFH + ch0) = w;
        w.x = pk2(ob[0], ob[1]); w.y = pk2(ob[2], ob[3]); w.z = pk2(ob[4], ob[5]); w.w = pk2(ob[6], ob[7]); *(v4u*)(ACT + (tok + 1) * FFH + ch0) = w;
    }
}


__device__ __forceinline__ void conv_w(const Ctx& c, const float* W, int K, int N, int Npad, bf16* WT, const float* gain = nullptr, bool ffnmap = false, int gw_ = -1, int ngw_ = 0) {
    LAS float* scr = (LAS float*)(c.lds + c.wave * 16640);
    const int nblk = Npad / 64, items = (K / 64) * nblk, lane = c.lane;
#if PROBE == 5
#pragma unroll 1
    for (int rep_ = 0; rep_ < 2; ++rep_)
#endif
    const int gw0 = gw_ >= 0 ? gw_ : c.gw, ngw = gw_ >= 0 ? ngw_ : c.NGW;
    for (int it = gw0; it < items; it += ngw) {
        const int kb = it / nblk, nb = it % nblk, k0 = 64 * kb, n0 = 64 * nb, nq = (lane & 15) * 4, kr = lane >> 4; const bool ok = (n0 + nq) < N;
        f32x4 v[16];
#pragma unroll
        for (int i = 0; i < 16; ++i) v[i] = ok ? __builtin_nontemporal_load((const f32x4*)(W + (size_t)(k0 + 4 * i + kr) * N + n0 + nq)) : (f32x4){0.f, 0.f, 0.f, 0.f};
        if (gain) {
#pragma unroll
            for (int i = 0; i < 16; ++i) v[i] *= gain[k0 + 4 * i + kr]; }
#pragma unroll
        for (int i = 0; i < 16; ++i) { LAS float* d = scr + (4 * i + kr) * 65 + nq; d[0] = v[i].x; d[1] = v[i].y; d[2] = v[i].z; d[3] = v[i].w; }
        LDS_WAIT(); asm volatile("" ::: "memory");
        const int c8 = lane & 7; int d0 = n0;
        if (ffnmap) { const int bj = n0 >= FFH ? 1 : 0, chn = n0 - FFH * bj; d0 = 256 * (chn >> 7) + 128 * bj + (chn & 127); }
#pragma unroll
        for (int j = 0; j < 8; ++j) { const int n = (lane >> 3) + 8 * j; const LAS float* sp = scr + (8 * c8) * 65 + n;
            v4u o; o.x = pk2(sp[0 * 65], sp[1 * 65]); o.y = pk2(sp[2 * 65], sp[3 * 65]); o.z = pk2(sp[4 * 65], sp[5 * 65]); o.w = pk2(sp[6 * 65], sp[7 * 65]);
            *(v4u*)(WT + (size_t)(d0 + n) * K + k0 + 8 * c8) = o; }
        LDS_WAIT(); asm volatile("" ::: "memory");
    }
}

__device__ __forceinline__ void rms_row_bf16(const Ctx& c, const float* xrow, const float* gain, bf16* orow, float* copy) {
    const f32x4* xr = (const f32x4*)xrow + c.lane; f32x4 v[8]; float s = 0.f;
#pragma unroll
    for (int j = 0; j < 8; ++j) { v[j] = xr[64 * j]; s += (v[j].x * v[j].x + v[j].y * v[j].y) + (v[j].z * v[j].z + v[j].w * v[j].w); }
    const float rs = rsqrtf(wave_sum(s) * (1.f / DM) + EPS);
    if (copy) {
#pragma unroll
        for (int j = 0; j < 8; ++j) ((f32x4*)copy + c.lane)[64 * j] = v[j]; }
    const f32x4* gr = (const f32x4*)gain + c.lane; v2u* o8 = (v2u*)orow + c.lane;
#pragma unroll
    for (int j = 0; j < 8; ++j) { const f32x4 g = gr[64 * j]; v2u o; o.x = pk2(v[j].x * rs * g.x, v[j].y * rs * g.y); o.y = pk2(v[j].z * rs * g.z, v[j].w * rs * g.w); o8[64 * j] = o; }
}
__device__ __forceinline__ void postnorm(const Ctx& c, const bf16* MF, bf16* XB, float* RS, const float* gpost, float* OUT) {
    for (int row = c.gw; row < MT; row += c.NGW) {
        const v4u* mr = (const v4u*)(MF + (size_t)row * DM) + c.lane; v4u* xr = (v4u*)(XB + (size_t)row * DM) + c.lane;
        v4u mv[4], xv[4]; float v[4][8]; float s = 0.f;
#pragma unroll
        for (int j = 0; j < 4; ++j) { mv[j] = mr[64 * j]; xv[j] = xr[64 * j]; }
#pragma unroll
        for (int j = 0; j < 4; ++j)
#pragma unroll
            for (int k = 0; k < 4; ++k) { v[j][2 * k] = bflo(mv[j][k]); v[j][2 * k + 1] = bfhi(mv[j][k]); s += v[j][2 * k] * v[j][2 * k] + v[j][2 * k + 1] * v[j][2 * k + 1]; }
        const float rs = rsqrtf(wave_sum(s) * (1.f / DM) + EPS);
        float s2 = 0.f;
#pragma unroll
        for (int j = 0; j < 4; ++j) { const float* gp = gpost + (c.lane + 64 * j) * 8; const f32x4 g0 = *(const f32x4*)gp, g1 = *(const f32x4*)(gp + 4);
#pragma unroll
            for (int k = 0; k < 4; ++k) { const float ga = (k < 2) ? g0[2 * k] : g1[2 * k - 4], gb = (k < 2) ? g0[2 * k + 1] : g1[2 * k - 3];
                v[j][2 * k] = bflo(xv[j][k]) + v[j][2 * k] * rs * ga; v[j][2 * k + 1] = bfhi(xv[j][k]) + v[j][2 * k + 1] * rs * gb;
                s2 += v[j][2 * k] * v[j][2 * k] + v[j][2 * k + 1] * v[j][2 * k + 1]; } }
        if (OUT) {
#pragma unroll
            for (int j = 0; j < 4; ++j) { float* op = OUT + (size_t)row * DM + (c.lane + 64 * j) * 8; *(f32x4*)op = (f32x4){v[j][0], v[j][1], v[j][2], v[j][3]}; *(f32x4*)(op + 4) = (f32x4){v[j][4], v[j][5], v[j][6], v[j][7]}; }
        } else {
#pragma unroll
            for (int j = 0; j < 4; ++j) { v4u o; o.x = pk2(v[j][0], v[j][1]); o.y = pk2(v[j][2], v[j][3]); o.z = pk2(v[j][4], v[j][5]); o.w = pk2(v[j][6], v[j][7]); xr[64 * j] = o; }
            const float rs2 = rsqrtf(wave_sum(s2) * (1.f / DM) + EPS); if (c.lane == 0) RS[row] = rs2;
        }
    }
}
__device__ __forceinline__ void x_to_xb(const Ctx& c, const float* X, bf16* XB, float* RS) {
    for (int row = c.gw; row < MT; row += c.NGW) {
        const f32x4* xr = (const f32x4*)(X + (size_t)row * DM) + c.lane; f32x4 v[8]; float s = 0.f;
#pragma unroll
        for (int j = 0; j < 8; ++j) { v[j] = xr[64 * j]; s += (v[j].x * v[j].x + v[j].y * v[j].y) + (v[j].z * v[j].z + v[j].w * v[j].w); }
        const float rs = rsqrtf(wave_sum(s) * (1.f / DM) + EPS); if (c.lane == 0) RS[row] = rs;
        v2u* o8 = (v2u*)(XB + (size_t)row * DM) + c.lane;
#pragma unroll
        for (int j = 0; j < 8; ++j) { v2u o; o.x = pk2(v[j].x, v[j].y); o.y = pk2(v[j].z, v[j].w); o8[64 * j] = o; }
    }
}

__device__ __forceinline__ void ffn_convact(const Ctx& c, const bf16* U, const float* cw, const float* cb, bf16* ACT) {
    const int NCG = FFH / 8, items = (MT / 8) * NCG;
    for (int it = c.vcu * 512 + c.tid; it < items; it += c.G * 512) {
        const int rb = it / NCG, cg = it % NCG, c0 = cg * 8, row0 = rb * 8, t0 = row0 & (SEQ - 1);
        v4u ga[10], va[10];
#pragma unroll
        for (int i = 0; i < 10; ++i) { const bool ok = (i >= 2) || (t0 != 0); const size_t r = (size_t)(row0 + i - 2);
            ga[i] = ok ? *(const v4u*)(U + r * FF2 + c0) : (v4u){0u, 0u, 0u, 0u}; va[i] = ok ? *(const v4u*)(U + r * FF2 + FFH + c0) : (v4u){0u, 0u, 0u, 0u}; }
        float wg[3][8], wv[3][8], bg[8], bv[8];
#pragma unroll
        for (int k = 0; k < 3; ++k) { const f32x4 a0 = *(const f32x4*)(cw + k * FF2 + c0), a1 = *(const f32x4*)(cw + k * FF2 + c0 + 4), b0 = *(const f32x4*)(cw + k * FF2 + FFH + c0), b1 = *(const f32x4*)(cw + k * FF2 + FFH + c0 + 4);
#pragma unroll
            for (int j = 0; j < 4; ++j) { wg[k][j] = a0[j]; wg[k][4 + j] = a1[j]; wv[k][j] = b0[j]; wv[k][4 + j] = b1[j]; } }
        { const f32x4 a0 = *(const f32x4*)(cb + c0), a1 = *(const f32x4*)(cb + c0 + 4), b0 = *(const f32x4*)(cb + FFH + c0), b1 = *(const f32x4*)(cb + FFH + c0 + 4);
#pragma unroll
          for (int j = 0; j < 4; ++j) { bg[j] = a0[j]; bg[4 + j] = a1[j]; bv[j] = b0[j]; bv[4 + j] = b1[j]; } }
#pragma unroll
        for (int i = 0; i < 8; ++i) {
            float o[8];
#pragma unroll
            for (int j = 0; j < 8; ++j) { const int q = j >> 1;
                const float g2 = (j & 1) ? bfhi(ga[i][q]) : bflo(ga[i][q]), g1 = (j & 1) ? bfhi(ga[i + 1][q]) : bflo(ga[i + 1][q]), g0 = (j & 1) ? bfhi(ga[i + 2][q]) : bflo(ga[i + 2][q]);
                const float v2 = (j & 1) ? bfhi(va[i][q]) : bflo(va[i][q]), v1 = (j & 1) ? bfhi(va[i + 1][q]) : bflo(va[i + 1][q]), v0 = (j & 1) ? bfhi(va[i + 2][q]) : bflo(va[i + 2][q]);
                const float cgv = bg[j] + wg[0][j] * g2 + wg[1][j] * g1 + wg[2][j] * g0, cvv = bv[j] + wv[0][j] * v2 + wv[1][j] * v1 + wv[2][j] * v0;
                o[j] = siluf_(cgv) * cvv; }
            v4u w; w.x = pk2(o[0], o[1]); w.y = pk2(o[2], o[3]); w.z = pk2(o[4], o[5]); w.w = pk2(o[6], o[7]);
            *(v4u*)(ACT + (size_t)(row0 + i) * FFH + c0) = w;
        }
    }
}

__device__ __forceinline__ void ssd_conv(const Ctx& c, const bf16* P, const float* cw, const float* cb, const float* dtb, bf16* X2, float* DT) {
    const int NC = 6144, NCG = NC / 8, items = (MT / 8) * NCG;
    for (int it = c.vcu * 512 + c.tid; it < items; it += c.G * 512) {
        const int rb = it / NCG, cg = it % NCG, c0 = cg * 8, row0 = rb * 8, t0 = row0 & (SEQ - 1);
        v4u xa[11];
#pragma unroll
        for (int i = 0; i < 11; ++i) { const bool ok = (i >= 3) || (t0 != 0); xa[i] = ok ? *(const v4u*)(P + (size_t)(row0 + i - 3) * SSD_NP + 4096 + c0) : (v4u){0u, 0u, 0u, 0u}; }
        float w[4][8], bb[8];
#pragma unroll
        for (int k = 0; k < 4; ++k) { const f32x4 a0 = *(const f32x4*)(cw + k * NC + c0), a1 = *(const f32x4*)(cw + k * NC + c0 + 4);
#pragma unroll
            for (int j = 0; j < 4; ++j) { w[k][j] = a0[j]; w[k][4 + j] = a1[j]; } }
        { const f32x4 a0 = *(const f32x4*)(cb + c0), a1 = *(const f32x4*)(cb + c0 + 4);
#pragma unroll
          for (int j = 0; j < 4; ++j) { bb[j] = a0[j]; bb[4 + j] = a1[j]; } }
#pragma unroll
        for (int i = 0; i < 8; ++i) {
            float o[8];
#pragma unroll
            for (int j = 0; j < 8; ++j) { const int q = j >> 1; float y = bb[j];
#pragma unroll
                for (int k = 0; k < 4; ++k) y += w[k][j] * ((j & 1) ? bfhi(xa[i + k][q]) : bflo(xa[i + k][q]));
                o[j] = silu_fast(y); }
            v4u wv; wv.x = pk2(o[0], o[1]); wv.y = pk2(o[2], o[3]); wv.z = pk2(o[4], o[5]); wv.w = pk2(o[6], o[7]);
            *(v4u*)(X2 + (size_t)(row0 + i) * NC + c0) = wv;
        }
    }
    for (int it = c.vcu * 512 + c.tid; it < MT * 64; it += c.G * 512) {
        const int row = it >> 6, h = it & 63; const float raw = bflo((unsigned)P[(size_t)row * SSD_NP + 10240 + h]) + dtb[h];
        DT[it] = raw > 20.f ? raw : log1pf(expf(raw));
    }
}

__device__ __forceinline__ s16x4 tr16(const LAS unsigned char* p) { return __builtin_amdgcn_ds_read_tr16_b64_v4i16((LAS s16x4*)p); }
__device__ __forceinline__ bf16x8 cat8(s16x4 a, s16x4 b) { bf16x8 r; r[0] = a[0]; r[1] = a[1]; r[2] = a[2]; r[3] = a[3]; r[4] = b[0]; r[5] = b[1]; r[6] = b[2]; r[7] = b[3]; return r; }
__device__ __forceinline__ void ssd_scan_mfma(const Ctx& c, bf16* X2, const float* DT, const float* a_log, const float* dskip, bool do_store) {
    constexpr int SS_B = 0, SS_C = 17408, SS_XR = 34816, SS_XD = 44032, SS_XW = 53248, SS_SB = 62464  , SS_CS = 97280  , SS_DTS = 97792  ;
    LAS unsigned char* L = c.lds;
    const int tid = c.tid, lane = c.lane, l15 = lane & 15, lg = lane >> 4, w = c.wave, lt = w >> 1, ph = w & 1, tq = l15 >> 2, tp = l15 & 3;
    for (int u = c.vcu; u < NB * 64; u += c.G) {
        const int b = u >> 6, h = u & 63, g = h >> 3; const float Ah = -expf(a_log[h]), Dh = dskip[h];
        f32x4 ST[4];
#pragma unroll
        for (int i = 0; i < 4; ++i) ST[i] = (f32x4){0.f, 0.f, 0.f, 0.f};
        __syncthreads();
        for (int i = tid; i < 17408 / 16; i += 512) *(LAS v4u*)(L + SS_SB + i * 16) = (v4u){0u, 0u, 0u, 0u};
        v4u rB[2], rC[2], rXR; float rdt = 0.f;
        const bf16* x2b = X2 + (size_t)b * SEQ * 6144;
#define SSD_LOAD(t0_) do { _Pragma("unroll") for (int e = 0; e < 2; ++e) { const int cc = tid + 512 * e; \
            rB[e] = *(const v4u*)(x2b + (size_t)((t0_) + (cc >> 4)) * 6144 + 4096 + g * 128 + (cc & 15) * 8); rC[e] = *(const v4u*)(x2b + (size_t)((t0_) + (cc >> 4)) * 6144 + 5120 + g * 128 + (cc & 15) * 8); } \
            rXR = *(const v4u*)(x2b + (size_t)((t0_) + (tid >> 3)) * 6144 + h * 64 + (tid & 7) * 8); } while (0)
#define SSD_CS(buf_) do { if (w == 0) { float a = rdt * Ah; \
            _Pragma("unroll") for (int o = 1; o < 64; o <<= 1) { const float v = __shfl_up(a, o); if (lane >= o) a += v; } \
            ((LAS float*)(L + SS_CS))[(buf_) * 64 + lane] = a; ((LAS float*)(L + SS_DTS))[(buf_) * 64 + lane] = rdt; } } while (0)
#define SSD_LDT(t0_) do { if (w == 0) rdt = DT[((size_t)b * SEQ + (t0_) + lane) * 64 + h]; } while (0)
        SSD_LOAD(0); SSD_LDT(0); SSD_CS(0); SSD_LDT(64);
        for (int ch = 0; ch < SEQ / 64; ++ch) {
            const int t0 = ch * 64, cb = ch & 1; LAS float* CS = (LAS float*)(L + SS_CS) + cb * 64; LAS float* DTS = (LAS float*)(L + SS_DTS) + cb * 64;
            LAS unsigned char* SBr = L + SS_SB + cb * 17408; LAS unsigned char* SBw = L + SS_SB + (cb ^ 1) * 17408;
            __syncthreads();
#pragma unroll
            for (int e = 0; e < 2; ++e) { const int cc = tid + 512 * e;
                *(LAS v4u*)(L + SS_B + (cc >> 4) * 272 + (cc & 15) * 16) = rB[e]; *(LAS v4u*)(L + SS_C + (cc >> 4) * 272 + (cc & 15) * 16) = rC[e]; }
            *(LAS v4u*)(L + SS_XR + (tid >> 3) * 144 + (tid & 7) * 16) = rXR;
            { const int sr = tid >> 3, p8 = tid & 7; const float fd = DTS[sr], fw = fd * __expf(CS[63] - CS[sr]);
              float xv[8];
#pragma unroll
              for (int j = 0; j < 4; ++j) { xv[2 * j] = bflo(rXR[j]); xv[2 * j + 1] = bfhi(rXR[j]); }
              v4u o1, o2; o1.x = pk2(xv[0] * fd, xv[1] * fd); o1.y = pk2(xv[2] * fd, xv[3] * fd); o1.z = pk2(xv[4] * fd, xv[5] * fd); o1.w = pk2(xv[6] * fd, xv[7] * fd);
              o2.x = pk2(xv[0] * fw, xv[1] * fw); o2.y = pk2(xv[2] * fw, xv[3] * fw); o2.z = pk2(xv[4] * fw, xv[5] * fw); o2.w = pk2(xv[6] * fw, xv[7] * fw);
              *(LAS v4u*)(L + SS_XD + sr * 144 + p8 * 16) = o1; *(LAS v4u*)(L + SS_XW + sr * 144 + p8 * 16) = o2; }
            if (ch + 1 < SEQ / 64) { SSD_LOAD(t0 + 64); SSD_CS(cb ^ 1); if (ch + 2 < SEQ / 64) SSD_LDT(t0 + 128); }
            __syncthreads();
            {
                const float csl = CS[16 * lt + l15];
                bf16x8 Cf[4];
#pragma unroll
                for (int ks = 0; ks < 4; ++ks) Cf[ks] = *(const LAS bf16x8*)(L + SS_C + (16 * lt + l15) * 272 + (32 * ks + 8 * lg) * 2);
                f32x4 GT[4];
#pragma unroll
                for (int st = 0; st < 4; ++st) { GT[st] = (f32x4){0.f, 0.f, 0.f, 0.f};
                    if (st <= lt) {
#pragma unroll
                        for (int ks = 0; ks < 4; ++ks) { const bf16x8 bf = *(const LAS bf16x8*)(L + SS_B + (16 * st + l15) * 272 + (32 * ks + 8 * lg) * 2); GT[st] = __builtin_amdgcn_mfma_f32_16x16x32_bf16(bf, Cf[ks], GT[st], 0, 0, 0); }
                        const f32x4 css = *(const LAS f32x4*)(CS + 16 * st + 4 * lg);
#pragma unroll
                        for (int r = 0; r < 4; ++r) { const bool ok = (16 * st + 4 * lg + r) <= (16 * lt + l15); GT[st][r] = ok ? GT[st][r] * __expf(csl - css[r]) : 0.f; }
                    } }
                bf16x8 Lf[2];
#pragma unroll
                for (int k2 = 0; k2 < 2; ++k2) { v4u q; q.x = pg8::cvt_pk_bf16(GT[2 * k2][0], GT[2 * k2][1]); q.y = pg8::cvt_pk_bf16(GT[2 * k2][2], GT[2 * k2][3]); q.z = pg8::cvt_pk_bf16(GT[2 * k2 + 1][0], GT[2 * k2 + 1][1]); q.w = pg8::cvt_pk_bf16(GT[2 * k2 + 1][2], GT[2 * k2 + 1][3]);
                    Lf[k2] = __builtin_bit_cast(bf16x8, q); }
                const float el = __expf(csl);
                const LAS unsigned char* xdb = L + SS_XD + (4 * lg + tq) * 144 + tp * 8;
#pragma unroll
                for (int pp = 0; pp < 2; ++pp) { const int pt = 2 * ph + pp; f32x4 Y = (f32x4){0.f, 0.f, 0.f, 0.f}, Yo = (f32x4){0.f, 0.f, 0.f, 0.f};
#pragma unroll
                    for (int k2 = 0; k2 < 2; ++k2) if (2 * k2 <= lt) { const LAS unsigned char* xp = xdb + k2 * 32 * 144 + pt * 32;
                        Y = __builtin_amdgcn_mfma_f32_16x16x32_bf16(cat8(tr16(xp), tr16(xp + 16 * 144)), Lf[k2], Y, 0, 0, 0); }
#pragma unroll
                    for (int ks = 0; ks < 4; ++ks) { const bf16x8 sb = *(const LAS bf16x8*)(SBr + (16 * pt + l15) * 272 + (32 * ks + 8 * lg) * 2); Yo = __builtin_amdgcn_mfma_f32_16x16x32_bf16(sb, Cf[ks], Yo, 0, 0, 0); }
                    const v2u xr = *(const LAS v2u*)(L + SS_XR + (16 * lt + l15) * 144 + (16 * pt + 4 * lg) * 2);
                    const float y0 = Y[0] + el * Yo[0] + Dh * bflo(xr.x), y1 = Y[1] + el * Yo[1] + Dh * bfhi(xr.x), y2 = Y[2] + el * Yo[2] + Dh * bflo(xr.y), y3 = Y[3] + el * Yo[3] + Dh * bfhi(xr.y);
                    v2u o; o.x = pk2(y0, y1); o.y = pk2(y2, y3);
                    if (do_store) *(v2u*)(X2 + ((size_t)b * SEQ + t0 + 16 * lt + l15) * 6144 + h * 64 + 16 * pt + 4 * lg) = o; }
                const float e63 = __expf(CS[63]); const int pts = w >> 1;
                const LAS unsigned char* bb = L + SS_B + (8 * lg + tq) * 272 + tp * 8; const LAS unsigned char* xwb = L + SS_XW + (8 * lg + tq) * 144 + tp * 8 + pts * 32;
                bf16x8 Xf[2];
#pragma unroll
                for (int ks = 0; ks < 2; ++ks) Xf[ks] = cat8(tr16(xwb + ks * 32 * 144), tr16(xwb + ks * 32 * 144 + 4 * 144));
#pragma unroll
                for (int i = 0; i < 4; ++i) { const int nt = 4 * (w & 1) + i; ST[i] *= e63;
#pragma unroll
                    for (int ks = 0; ks < 2; ++ks) { const LAS unsigned char* bp = bb + ks * 32 * 272 + nt * 32;
                        ST[i] = __builtin_amdgcn_mfma_f32_16x16x32_bf16(cat8(tr16(bp), tr16(bp + 4 * 272)), Xf[ks], ST[i], 0, 0, 0); }
                    v2u q; q.x = pk2(ST[i][0], ST[i][1]); q.y = pk2(ST[i][2], ST[i][3]);
                    *(LAS v2u*)(SBw + (16 * pts + l15) * 272 + (16 * nt + 4 * lg) * 2) = q; }
            }
        }
#undef SSD_LOAD
#undef SSD_CS
#undef SSD_LDT
    }
    __syncthreads();
}

__device__ __forceinline__ void ssd_gnorm(const Ctx& c, bf16* X2, const bf16* P, const float* g) {
    for (int row = c.gw; row < MT; row += c.NGW) {
        v4u* yr = (v4u*)(X2 + (size_t)row * 6144) + c.lane; const v4u* zr = (const v4u*)(P + (size_t)row * SSD_NP) + c.lane;
        float v[8][8]; float s = 0.f;
#pragma unroll
        for (int j = 0; j < 8; ++j) { const v4u y = yr[64 * j], z = zr[64 * j];
#pragma unroll
            for (int k = 0; k < 4; ++k) { const float a = bflo(y[k]) * siluf_(bflo(z[k])), b = bfhi(y[k]) * siluf_(bfhi(z[k])); v[j][2 * k] = a; v[j][2 * k + 1] = b; s += a * a + b * b; } }
        const float rs = rsqrtf(wave_sum(s) * (1.f / 4096.f) + EPS);
#pragma unroll
        for (int j = 0; j < 8; ++j) { const float* gg = g + (c.lane + 64 * j) * 8; const f32x4 g0 = *(const f32x4*)gg, g1 = *(const f32x4*)(gg + 4);
            v4u w; w.x = pk2(v[j][0] * rs * g0.x, v[j][1] * rs * g0.y); w.y = pk2(v[j][2] * rs * g0.z, v[j][3] * rs * g0.w); w.z = pk2(v[j][4] * rs * g1.x, v[j][5] * rs * g1.y); w.w = pk2(v[j][6] * rs * g1.z, v[j][7] * rs * g1.w);
            yr[64 * j] = w; }
    }
}

__device__ __forceinline__ void sgu_ln(const Ctx& c, bf16* P, const float* g) {
    for (int row = c.gw; row < MT; row += c.NGW) {
        v4u* vr = (v4u*)(P + (size_t)row * 8192 + 4096) + c.lane;
        float v[8][8]; float s = 0.f;
#pragma unroll
        for (int j = 0; j < 8; ++j) { const v4u y = vr[64 * j];
#pragma unroll
            for (int k = 0; k < 4; ++k) { v[j][2 * k] = bflo(y[k]); v[j][2 * k + 1] = bfhi(y[k]); s += v[j][2 * k] + v[j][2 * k + 1]; } }
        const float mu = wave_sum(s) * (1.f / 4096.f); float q = 0.f;
#pragma unroll
        for (int j = 0; j < 8; ++j)
#pragma unroll
            for (int k = 0; k < 8; ++k) { v[j][k] -= mu; q += v[j][k] * v[j][k]; }
        const float rs = rsqrtf(wave_sum(q) * (1.f / 4096.f) + EPS);
#pragma unroll
        for (int j = 0; j < 8; ++j) { const float* gg = g + (c.lane + 64 * j) * 8; const f32x4 g0 = *(const f32x4*)gg, g1 = *(const f32x4*)(gg + 4);
            v4u w; w.x = pk2(v[j][0] * rs * g0.x, v[j][1] * rs * g0.y); w.y = pk2(v[j][2] * rs * g0.z, v[j][3] * rs * g0.w); w.z = pk2(v[j][4] * rs * g1.x, v[j][5] * rs * g1.y); w.w = pk2(v[j][6] * rs * g1.z, v[j][7] * rs * g1.w);
            vr[64 * j] = w; }
    }
}
__device__ __forceinline__ void sgu_spatial(const Ctx& c, const bf16* P, const float* Wsp, const float* bsp, bf16* ACT) {
    LAS unsigned char* Vs = c.lds;
    for (int u = c.vcu; u < NB * 32 * 8; u += c.G) {
        const int g = u & 7, bc = u >> 3; const size_t row0 = (size_t)bc * 128;
        __syncthreads();
        for (int i = c.tid; i < 128 * 64; i += 512) { const int s = i >> 6, d8 = i & 63; *(LAS v4u*)(Vs + s * 1024 + d8 * 16) = *(const v4u*)(P + (row0 + s) * 8192 + 4096 + g * 512 + d8 * 8); }
        __syncthreads();
        const int d8 = c.lane;
        for (int i = 0; i < 16; ++i) {
            const int t = c.wave + 8 * i; const float* wrow = Wsp + ((size_t)g * 128 + t) * 128;
            float acc[8];
#pragma unroll
            for (int j = 0; j < 8; ++j) acc[j] = 0.f;
            for (int s = 0; s <= t; ++s) { const float w = wrow[s]; const v4u v = *(const LAS v4u*)(Vs + s * 1024 + d8 * 16);
#pragma unroll
                for (int j = 0; j < 4; ++j) { acc[2 * j] += w * bflo(v[j]); acc[2 * j + 1] += w * bfhi(v[j]); } }
            const float bb = bsp[g * 128 + t]; const v4u uu = *(const v4u*)(P + (row0 + t) * 8192 + g * 512 + d8 * 8);
            v4u w; w.x = pk2(bflo(uu.x) * (acc[0] + bb), bfhi(uu.x) * (acc[1] + bb)); w.y = pk2(bflo(uu.y) * (acc[2] + bb), bfhi(uu.y) * (acc[3] + bb));
            w.z = pk2(bflo(uu.z) * (acc[4] + bb), bfhi(uu.z) * (acc[5] + bb)); w.w = pk2(bflo(uu.w) * (acc[6] + bb), bfhi(uu.w) * (acc[7] + bb));
            *(v4u*)(ACT + (row0 + t) * 4096 + g * 512 + d8 * 8) = w;
        }
    }
    __syncthreads();
}

__device__ __forceinline__ void sgu_spatial_mfma(const Ctx& c, const bf16* P, const float* Wsp, const float* bsp, bf16* ACT) {
    constexpr int RS = 528, WB = 128 * RS, WRS = 272;
    LAS unsigned char* L = c.lds; const int tid = c.tid, l15 = c.lane & 15, lg = c.lane >> 4, w = c.wave;
    for (int u_ = c.vcu; u_ < (PROBE == 22 ? 2 : 1) * NB * 32 * 8; u_ += c.G) {
        const int u = u_ & (NB * 32 * 8 - 1); const int g = u & 7, bc = u >> 3; const size_t row0 = (size_t)bc * 128;
        __syncthreads();
#pragma unroll
        for (int e = 0; e < 4; ++e) { const int cc = tid + 512 * e, t = cc >> 4, s8 = cc & 15; const float* wp = Wsp + ((size_t)g * 128 + t) * 128 + s8 * 8; f32x4 a = *(const f32x4*)wp, b = *(const f32x4*)(wp + 4);
#pragma unroll
            for (int j = 0; j < 4; ++j) { if (s8 * 8 + j > t) a[j] = 0.f; if (s8 * 8 + 4 + j > t) b[j] = 0.f; }
            v4u q; q.x = pk2(a[0], a[1]); q.y = pk2(a[2], a[3]); q.z = pk2(b[0], b[1]); q.w = pk2(b[2], b[3]); *(LAS v4u*)(L + WB + t * WRS + s8 * 16) = q; }
        for (int half = 0; half < 2; ++half) {
            if (half) __syncthreads();
#pragma unroll
            for (int e = 0; e < 8; ++e) { const int cc = tid + 512 * e, sr = cc >> 5, d8 = cc & 31; *(LAS v4u*)(L + sr * RS + d8 * 16) = *(const v4u*)(P + (row0 + sr) * 8192 + 4096 + g * 512 + 256 * half + d8 * 8); }
            __syncthreads();
            bf16x8 Wf[4];
#pragma unroll
            for (int ks = 0; ks < 4; ++ks) Wf[ks] = *(const LAS bf16x8*)(L + WB + (16 * w + l15) * WRS + (32 * ks + 8 * lg) * 2);
            const int nks = (w >> 1) + 1; const int t = 16 * w + l15; const float bb = bsp[g * 128 + t];
            const LAS unsigned char* vb = L + (8 * lg + (l15 >> 2)) * RS + (l15 & 3) * 8;
            v2u uv[16];
#pragma unroll
            for (int dt = 0; dt < 16; ++dt) uv[dt] = *(const v2u*)(P + (row0 + t) * 8192 + (size_t)g * 512 + 256 * half + 16 * dt + 4 * lg);
#pragma unroll
            for (int dt = 0; dt < 16; ++dt) {
                f32x4 acc = (f32x4){0.f, 0.f, 0.f, 0.f};
#pragma unroll
                for (int ks = 0; ks < 4; ++ks) if (ks < nks) {
                    const s16x4 a0 = __builtin_amdgcn_ds_read_tr16_b64_v4i16((LAS s16x4*)(vb + ks * 32 * RS + dt * 32)), a1 = __builtin_amdgcn_ds_read_tr16_b64_v4i16((LAS s16x4*)(vb + ks * 32 * RS + 4 * RS + dt * 32));
                    bf16x8 af; af[0] = a0[0]; af[1] = a0[1]; af[2] = a0[2]; af[3] = a0[3]; af[4] = a1[0]; af[5] = a1[1]; af[6] = a1[2]; af[7] = a1[3];
                    acc = __builtin_amdgcn_mfma_f32_16x16x32_bf16(af, Wf[ks], acc, 0, 0, 0); }
                const size_t col = (size_t)g * 512 + 256 * half + 16 * dt + 4 * lg;
                const v2u uu = uv[dt];
                v2u o; o.x = pk2(bflo(uu.x) * (acc[0] + bb), bfhi(uu.x) * (acc[1] + bb)); o.y = pk2(bflo(uu.y) * (acc[2] + bb), bfhi(uu.y) * (acc[3] + bb));
                *(v2u*)(ACT + (row0 + t) * 4096 + col) = o;
            }
        }
    }
    __syncthreads();
}

template <int WIN> __device__ __forceinline__ f32x4 pool_sum(const float* zp, int t) {
    f32x4 v[WIN];
#pragma unroll
    for (int j = 1; j < WIN; ++j) v[j] = (j <= t) ? *(const f32x4*)(zp - (size_t)j * DM) : (f32x4){0.f, 0.f, 0.f, 0.f};
    f32x4 s = (f32x4){0.f, 0.f, 0.f, 0.f};
#pragma unroll
    for (int j = 1; j < WIN; ++j) s += v[j];
    return s;
}
__device__ __forceinline__ void pool_pool(const Ctx& c, const float* Z, bf16* O) {
    for (int it = c.vcu * 512 + c.tid; it < MT * 512; it += c.G * 512) {
        const int row = it >> 9, c4 = (it & 511) * 4, gi = __builtin_amdgcn_readfirstlane(c4 >> 9), win = 2 << gi, t = row & (SEQ - 1), cnt = (t + 1 < win) ? t + 1 : win;
        const float* zp = Z + (size_t)row * DM + c4; const f32x4 z0 = *(const f32x4*)zp; f32x4 s;
        if (gi == 0) s = pool_sum<2>(zp, t); else if (gi == 1) s = pool_sum<4>(zp, t); else if (gi == 2) s = pool_sum<8>(zp, t); else s = pool_sum<16>(zp, t);
        s += z0;
        const float ic = 1.f / (float)cnt; v2u o; o.x = pk2(s.x * ic - z0.x, s.y * ic - z0.y); o.y = pk2(s.z * ic - z0.z, s.w * ic - z0.w);
        *(v2u*)(O + (size_t)row * DM + c4) = o;
    }
}

__device__ __forceinline__ void xa_attn(const Ctx& c, const bf16* Q, const bf16* KV, bf16* O) {
    LAS unsigned char* Ks = c.lds; LAS unsigned char* Vs = c.lds + 69632; LAS float* qs = (LAS float*)(c.lds + 135168 + c.wave * 1536); LAS float* ps = qs + 128;
    const int lane = c.lane; const float scale = 0.08838834764831845f;
    for (int u = c.vcu; u < 256; u += c.G) {
        const int bh = u >> 4, chunk = u & 15, b = bh >> 2, hd = bh & 3;
        __syncthreads();
        for (int i = c.tid; i < 256 * 16; i += 512) { const int key = i >> 4, d8 = i & 15; const bf16* src = KV + (size_t)(b * 256 + key) * 1024 + hd * 128 + d8 * 8;
            *(LAS v4u*)(Ks + key * 272 + d8 * 16) = *(const v4u*)src; *(LAS v4u*)(Vs + key * 256 + d8 * 16) = *(const v4u*)(src + 512); }
        __syncthreads();
        for (int i = 0; i < 32; ++i) {
            const size_t row = (size_t)b * SEQ + chunk * 256 + c.wave * 32 + i;
            const unsigned qq = *(const unsigned*)(Q + row * 512 + hd * 128 + 2 * lane);
            qs[2 * lane] = bflo(qq); qs[2 * lane + 1] = bfhi(qq);
            LDS_WAIT();
            float sc[4] = {0.f, 0.f, 0.f, 0.f};
#pragma unroll 2
            for (int d8 = 0; d8 < 16; ++d8) { const f32x4 q0 = *(const LAS f32x4*)(qs + d8 * 8), q1 = *(const LAS f32x4*)(qs + d8 * 8 + 4);
#pragma unroll
                for (int r = 0; r < 4; ++r) { const v4u kv = *(const LAS v4u*)(Ks + (lane + 64 * r) * 272 + d8 * 16);
                    sc[r] += bflo(kv.x) * q0.x + bfhi(kv.x) * q0.y + bflo(kv.y) * q0.z + bfhi(kv.y) * q0.w + bflo(kv.z) * q1.x + bfhi(kv.z) * q1.y + bflo(kv.w) * q1.z + bfhi(kv.w) * q1.w; } }
#pragma unroll
            for (int r = 0; r < 4; ++r) sc[r] *= scale;
            const float m = wave_max(fmaxf(fmaxf(sc[0], sc[1]), fmaxf(sc[2], sc[3])));
            float l = 0.f;
#pragma unroll
            for (int r = 0; r < 4; ++r) { const float p = __expf(sc[r] - m); l += p; ps[lane + 64 * r] = p; }
            l = wave_sum(l);
            LDS_WAIT();
            float o0 = 0.f, o1 = 0.f;
#pragma unroll 8
            for (int key = 0; key < 256; ++key) { const float p = ps[key]; const unsigned vv = *(const LAS unsigned*)(Vs + key * 256 + lane * 4); o0 += p * bflo(vv); o1 += p * bfhi(vv); }
            const float il = 1.f / l;
            *(unsigned*)(O + row * 512 + hd * 128 + 2 * lane) = pk2(o0 * il, o1 * il);
            LDS_WAIT();
        }
    }
    __syncthreads();
}

__device__ __forceinline__ void nsa_posbias(const Ctx& c, const float* pos, const float* w1, float* PBP) {
    for (int o = ((c.gw & 3) == 3) ? (c.gw >> 2) : 512; o < 512; o += (c.NGW >> 2)) { const int ten = o >> 8, nb = (o >> 6) & 3, ks = o & 63, n = nb * 64 + c.lane; float a = 0.f;
#pragma unroll 16
        for (int k = 0; k < 64; ++k) a += pos[ten * 4096 + ks * 64 + k] * w1[((size_t)ten * 4096 + ks * 64 + k) * 256 + n];
        PBP[(ten * 64 + ks) * 256 + n] = a; }
}
__device__ __forceinline__ void nsa_posbias_reduce(const Ctx& c, const float* PBP, float* PB) {
    if (c.vcu == 0) { const int ten = c.tid >> 8, n = c.tid & 255; float a = 0.f;
#pragma unroll 16
        for (int ks = 0; ks < 64; ++ks) a += PBP[(ten * 64 + ks) * 256 + n];
        PB[c.tid] = a; }
}
__device__ __forceinline__ void nsa_w2(const Ctx& c, const bf16* HID, const float* w2, float* KC) {
    for (int it = c.vcu * 512 + c.tid; it < 8192 * 128; it += c.G * 512) {
        const int r = it >> 7, d = it & 127, ten = r >> 12; const bf16* hrow = HID + (size_t)r * 256; const float* w = w2 + (size_t)ten * 256 * 128 + d; float a = 0.f;
#pragma unroll 8
        for (int h = 0; h < 256; ++h) a += bflo((unsigned)hrow[h]) * w[h * 128];
        KC[it] = a;
    }
}
__device__ __forceinline__ void nsa_block(const bf16* Kb, const bf16* Vb, bool valid, const LAS float* qs, LAS float* ps, int lane, float (&m)[4], float (&l)[4], float (&o)[4][2]) {
    const float scale = 0.08838834764831845f;
    float sc[4] = {0.f, 0.f, 0.f, 0.f};
    const v4u* kr = (const v4u*)(Kb + (size_t)lane * 128);
#pragma unroll 4
    for (int d8 = 0; d8 < 16; ++d8) { const v4u kv = kr[d8]; float k[8];
#pragma unroll
        for (int j = 0; j < 4; ++j) { k[2 * j] = bflo(kv[j]); k[2 * j + 1] = bfhi(kv[j]); }
#pragma unroll
        for (int h = 0; h < 4; ++h) { const f32x4 q0 = *(const LAS f32x4*)(qs + h * 128 + d8 * 8), q1 = *(const LAS f32x4*)(qs + h * 128 + d8 * 8 + 4);
            sc[h] += k[0] * q0.x + k[1] * q0.y + k[2] * q0.z + k[3] * q0.w + k[4] * q1.x + k[5] * q1.y + k[6] * q1.z + k[7] * q1.w; } }
    float alpha[4];
#pragma unroll
    for (int h = 0; h < 4; ++h) { const float s = valid ? sc[h] * scale : -1e30f; const float mn = fmaxf(m[h], wave_max(s)); const float p = valid ? __expf(s - mn) : 0.f;
        alpha[h] = __expf(m[h] - mn); m[h] = mn; l[h] = l[h] * alpha[h] + wave_sum(p); ps[h * 64 + lane] = p; o[h][0] *= alpha[h]; o[h][1] *= alpha[h]; }
    LDS_WAIT();
#pragma unroll 4
    for (int s = 0; s < 64; ++s) { const unsigned vv = *(const unsigned*)(Vb + (size_t)s * 128 + 2 * lane); const float v0 = bflo(vv), v1 = bfhi(vv);
#pragma unroll
        for (int h = 0; h < 4; ++h) { const float p = ps[h * 64 + s]; o[h][0] += p * v0; o[h][1] += p * v1; } }
    LDS_WAIT();
}
__device__ __forceinline__ void nsa_attn(const Ctx& c, const bf16* Q, const bf16* T, const float* KC, const float* Gt, bf16* OUT) {
    LAS float* qs = (LAS float*)(c.lds + c.wave * 8192);
    LAS float* ps = qs + 512;
    LAS float* psum = ps + 1024;
    const int lane = c.lane; const float scale = 0.08838834764831845f;
    for (int task = c.gw; task < MT * 4; task += c.NGW) {
        const int g = task & 3, row = task >> 2, b = row >> 12, t = row & 4095, bg = b * 4 + g;
        { const v4u qv = *(const v4u*)(Q + (size_t)row * 2048 + g * 512 + lane * 8); LAS float* qd = qs + lane * 8;
#pragma unroll
          for (int j = 0; j < 4; ++j) { qd[2 * j] = bflo(qv[j]); qd[2 * j + 1] = bfhi(qv[j]); } }
        LDS_WAIT();
        const int nv = (t >= 31) ? ((t - 31) >> 4) + 1 : 0;
        float oc[4][2] = {{0.f, 0.f}, {0.f, 0.f}, {0.f, 0.f}, {0.f, 0.f}};
        const float* kcb = KC + (size_t)bg * 256 * 128; const float* vcb = KC + (size_t)(16 + bg) * 256 * 128;
        psum[lane] = 0.f; psum[lane + 64] = 0.f; psum[lane + 128] = 0.f; psum[lane + 192] = 0.f;
        if (nv > 0) {
            float sc[4][4];
#pragma unroll
            for (int r = 0; r < 4; ++r) { const int i = lane + 64 * r;
#pragma unroll
                for (int h = 0; h < 4; ++h) sc[h][r] = 0.f;
                if (i < nv) { const f32x4* kr = (const f32x4*)(kcb + (size_t)i * 128);
#pragma unroll 4
                    for (int d4 = 0; d4 < 32; ++d4) { const f32x4 kv = kr[d4];
#pragma unroll
                        for (int h = 0; h < 4; ++h) { const f32x4 q0 = *(const LAS f32x4*)(qs + h * 128 + d4 * 4); sc[h][r] += kv.x * q0.x + kv.y * q0.y + kv.z * q0.z + kv.w * q0.w; } } } }
            float ps_r[4] = {0.f, 0.f, 0.f, 0.f};
#pragma unroll
            for (int h = 0; h < 4; ++h) { float mx = -1e30f;
#pragma unroll
                for (int r = 0; r < 4; ++r) { const bool ok = (lane + 64 * r) < nv; sc[h][r] = ok ? sc[h][r] * scale : -1e30f; mx = fmaxf(mx, sc[h][r]); }
                mx = wave_max(mx); float sm = 0.f;
#pragma unroll
                for (int r = 0; r < 4; ++r) { const bool ok = (lane + 64 * r) < nv; sc[h][r] = ok ? __expf(sc[h][r] - mx) : 0.f; sm += sc[h][r]; }
                sm = wave_sum(sm); const float inv = 1.f / sm;
#pragma unroll
                for (int r = 0; r < 4; ++r) { const float p = sc[h][r] * inv; ps[h * 256 + lane + 64 * r] = p; ps_r[r] += p; } }
#pragma unroll
            for (int r = 0; r < 4; ++r) psum[lane + 64 * r] = ps_r[r];
            LDS_WAIT();
            for (int i = 0; i < nv; ++i) { const f32x2 vv = *(const f32x2*)(vcb + (size_t)i * 128 + 2 * lane);
#pragma unroll
                for (int h = 0; h < 4; ++h) { const float p = ps[h * 256 + i]; oc[h][0] += p * vv.x; oc[h][1] += p * vv.y; } }
        }
        LDS_WAIT();
        const int cur = t >> 6;
        float imp = 0.f;
        { const int i0 = (4 * lane - 1) < 0 ? 0 : 4 * lane - 1, i1 = (4 * lane + 3) > 254 ? 254 : 4 * lane + 3;
          for (int i = i0; i <= i1; ++i) imp += psum[i]; }
        const bool forced = (lane == 0) || (lane <= cur && lane > cur - 3), future = lane > cur;
        const float score = forced ? 1e30f : (future ? -1e30f : imp);
        int rank = 0;
        for (int k = 0; k < 64; ++k) { const float sk = __shfl(score, k); rank += (sk > score || (sk == score && k < lane)) ? 1 : 0; }
        const unsigned long long selmask = __ballot(rank < 16);
        LDS_WAIT();
        float m1[4] = {-1e30f, -1e30f, -1e30f, -1e30f}, l1[4] = {0.f, 0.f, 0.f, 0.f}, o1[4][2] = {{0.f, 0.f}, {0.f, 0.f}, {0.f, 0.f}, {0.f, 0.f}};
        const bf16* ksb = T + 2 * NT_STRIDE + (size_t)bg * 4096 * 128; const bf16* vsb = T + 3 * NT_STRIDE + (size_t)bg * 4096 * 128;
        for (int k = 0; k <= cur; ++k) { if (!((selmask >> k) & 1ull)) continue;
            nsa_block(ksb + (size_t)k * 64 * 128, vsb + (size_t)k * 64 * 128, (k * 64 + lane) <= t, qs, ps, lane, m1, l1, o1); }
        float m2[4] = {-1e30f, -1e30f, -1e30f, -1e30f}, l2[4] = {0.f, 0.f, 0.f, 0.f}, o2[4][2] = {{0.f, 0.f}, {0.f, 0.f}, {0.f, 0.f}, {0.f, 0.f}};
        const bf16* kwb = T + 4 * NT_STRIDE + (size_t)bg * 4096 * 128; const bf16* vwb = T + 5 * NT_STRIDE + (size_t)bg * 4096 * 128;
        const int lo = (t - 511) < 0 ? 0 : (t - 511);
        for (int k = lo >> 6; k <= cur; ++k) { const int pos = k * 64 + lane;
            nsa_block(kwb + (size_t)k * 64 * 128, vwb + (size_t)k * 64 * 128, pos <= t && pos >= lo, qs, ps, lane, m2, l2, o2); }
#pragma unroll
        for (int h = 0; h < 4; ++h) { const float* gl = Gt + (size_t)row * 48 + (g * 4 + h) * 3; const float g0 = sigmoidf_(gl[0]), g1 = sigmoidf_(gl[1]), g2 = sigmoidf_(gl[2]);
            const float i1 = 1.f / l1[h], i2 = 1.f / l2[h];
            const float a = g0 * oc[h][0] + g1 * o1[h][0] * i1 + g2 * o2[h][0] * i2, bq = g0 * oc[h][1] + g1 * o1[h][1] * i1 + g2 * o2[h][1] * i2;
            *(unsigned*)(OUT + (size_t)row * 2048 + (g * 4 + h) * 128 + 2 * lane) = pk2(a, bq); }
        LDS_WAIT();
    }
}


namespace fa {
constexpr int KS_STRIDE = 272, VT_STRIDE = 144, KS_BYTES = 64 * KS_STRIDE, VT_BYTES = 128 * VT_STRIDE, BUF_BYTES = KS_BYTES + VT_BYTES;
constexpr int PS_OFF = 2 * BUF_BYTES, PS_STRIDE = 260, SM_OFF = PS_OFF + 64 * PS_STRIDE * 4;
constexpr float C2 = 0.08838834764831845f * 1.4426950408889634f;
struct Src { const bf16* K; size_t kstride; const bf16* Vt; size_t vstride; };
struct Stage { v4u k[2], v[2]; };
template <bool WITH_V> __device__ __forceinline__ void load_tile(const Src& s, int key0, int tid, Stage& st) {
#pragma unroll
    for (int e = 0; e < 2; ++e) { const int cc = tid + 512 * e;
        st.k[e] = *(const v4u*)(s.K + (size_t)(key0 + (cc >> 4)) * s.kstride + (cc & 15) * 8);
        if constexpr (WITH_V) st.v[e] = *(const v4u*)(s.Vt + (size_t)(cc >> 3) * s.vstride + key0 + (cc & 7) * 8); }
}
template <bool WITH_V> __device__ __forceinline__ void store_tile(LAS unsigned char* buf, int tid, const Stage& st) {
#pragma unroll
    for (int e = 0; e < 2; ++e) { const int cc = tid + 512 * e;
        *(LAS v4u*)(buf + (cc >> 4) * KS_STRIDE + (cc & 15) * 16) = st.k[e];
        if constexpr (WITH_V) *(LAS v4u*)(buf + KS_BYTES + (cc >> 3) * VT_STRIDE + (cc & 7) * 16) = st.v[e]; }
}
struct NoMask { __device__ __forceinline__ bool valid(int, int, int) const { return true; } __device__ __forceinline__ bool need(int) const { return false; } };
struct CmpMask { int nvq[2]; __device__ __forceinline__ bool valid(int kb, int ko, int mi) const { return kb * 64 + ko < nvq[mi]; } __device__ __forceinline__ bool need(int kb) const { return !__all(kb * 64 + 64 <= nvq[0] && kb * 64 + 64 <= nvq[1]); } };
struct SelMask { int tq[2]; unsigned long long sm[2]; int qb; __device__ __forceinline__ bool valid(int kb, int ko, int mi) const { return ((sm[mi] >> kb) & 1ull) && (kb * 64 + ko <= tq[mi]); }
    __device__ __forceinline__ bool need(int kb) const { return kb == qb || !__all((int)((sm[0] >> kb) & (sm[1] >> kb) & 1ull)); } };
struct WinMask { int tq[2]; int qb; __device__ __forceinline__ bool valid(int kb, int ko, int mi) const { const int kp = kb * 64 + ko; return kp <= tq[mi] && kp + 511 >= tq[mi]; } __device__ __forceinline__ bool need(int kb) const { return kb == qb || kb + 8 <= qb; } };

template <int MODE, class MaskF>
__device__ __forceinline__ void tile_qk(const LAS unsigned char* buf, const bf16x8 (&Qf)[2][4], f32x4 (&O)[8][2], float (&m)[2], float (&l)[2], const float (&invl)[2],
                                        int kb, const MaskF& mf, LAS float* PS, int wave, int l15, int lg, bf16x8 (&Pf)[2][2], f32x4 (&OL)[2]) {
    f32x4 S[4][2];
#pragma unroll
    for (int nt = 0; nt < 4; ++nt)
#pragma unroll
        for (int mi = 0; mi < 2; ++mi) S[nt][mi] = (f32x4){0.f, 0.f, 0.f, 0.f};
    const LAS unsigned char* kbase = buf + l15 * KS_STRIDE + lg * 16;
    bf16x8 kf[2][2];
#pragma unroll
    for (int q = 0; q < 2; ++q) kf[0][q] = *(const LAS bf16x8*)(kbase + q * 16 * KS_STRIDE);
#pragma unroll
    for (int h = 0; h < 8; ++h) { const int ks = h >> 1, n0 = (h & 1) * 2;
        if (h < 7) { const int ks1 = (h + 1) >> 1, n1 = ((h + 1) & 1) * 2;
#pragma unroll
            for (int q = 0; q < 2; ++q) kf[(h + 1) & 1][q] = *(const LAS bf16x8*)(kbase + (n1 + q) * 16 * KS_STRIDE + ks1 * 64); }
        __builtin_amdgcn_sched_barrier(0);
        __builtin_amdgcn_s_setprio(1);
#pragma unroll
        for (int q = 0; q < 2; ++q)
#pragma unroll
            for (int mi = 0; mi < 2; ++mi) S[n0 + q][mi] = __builtin_amdgcn_mfma_f32_16x16x32_bf16(kf[h & 1][q], Qf[mi][ks], S[n0 + q][mi], 0, 0, 0);
        __builtin_amdgcn_s_setprio(0);
        __builtin_amdgcn_sched_barrier(0);
    }
    const float NEG = -__builtin_inff();
    float mx[2] = {NEG, NEG};
    if (mf.need(kb)) {
#pragma unroll
        for (int nt = 0; nt < 4; ++nt)
#pragma unroll
            for (int mi = 0; mi < 2; ++mi)
#pragma unroll
                for (int r = 0; r < 4; ++r) { const float sv = mf.valid(kb, 16 * nt + 4 * lg + r, mi) ? S[nt][mi][r] : NEG; S[nt][mi][r] = sv; mx[mi] = fmaxf(mx[mi], sv); }
    } else {
#pragma unroll
        for (int nt = 0; nt < 4; ++nt)
#pragma unroll
            for (int mi = 0; mi < 2; ++mi)
#pragma unroll
                for (int r = 0; r < 4; ++r) mx[mi] = fmaxf(mx[mi], S[nt][mi][r]);
    }
#pragma unroll
    for (int mi = 0; mi < 2; ++mi) {
        float ref;
        if constexpr (MODE == 2) { ref = m[mi]; }
        else { float t = fmaxf(mx[mi], __shfl_xor(mx[mi], 16)); t = fmaxf(t, __shfl_xor(t, 32)); t *= C2;
            if (__all(t <= m[mi] + 6.0f)) { ref = m[mi]; }
            else { const float mn = fmaxf(m[mi], t); const float alpha = __builtin_amdgcn_exp2f(m[mi] - mn); m[mi] = mn; ref = mn;
                if constexpr (MODE == 0) { OL[mi] *= alpha;
#pragma unroll
                    for (int dt = 0; dt < 8; ++dt) O[dt][mi] *= alpha; }
                else l[mi] *= alpha; } }
        float ps = 0.f;
#pragma unroll
        for (int nt = 0; nt < 4; ++nt)
#pragma unroll
            for (int r = 0; r < 4; ++r) { float p = __builtin_amdgcn_exp2f(__builtin_fmaf(S[nt][mi][r], C2, -ref)); if constexpr (MODE == 2) p *= invl[mi]; S[nt][mi][r] = p; if constexpr (MODE == 1) ps += p; }
        if constexpr (MODE == 1) l[mi] += ps;
    }
    if constexpr (MODE == 2) {
#pragma unroll
        for (int nt = 0; nt < 4; ++nt)
#pragma unroll
            for (int mi = 0; mi < 2; ++mi) { f32x4 v = S[nt][mi];
#pragma unroll
                for (int r = 0; r < 4; ++r) { v[r] += __shfl_xor(v[r], 1); v[r] += __shfl_xor(v[r], 2); }
                if ((l15 & 3) == 0) *(LAS f32x4*)(PS + ((32 * wave + 16 * mi + l15) >> 2) * PS_STRIDE + 64 * kb + 16 * nt + 4 * lg) = v; }
    }
    if constexpr (MODE != 1) {
#pragma unroll
        for (int mi = 0; mi < 2; ++mi)
#pragma unroll
            for (int k2 = 0; k2 < 2; ++k2) { v4u w; w.x = pg8::cvt_pk_bf16(S[2 * k2][mi][0], S[2 * k2][mi][1]); w.y = pg8::cvt_pk_bf16(S[2 * k2][mi][2], S[2 * k2][mi][3]);
                w.z = pg8::cvt_pk_bf16(S[2 * k2 + 1][mi][0], S[2 * k2 + 1][mi][1]); w.w = pg8::cvt_pk_bf16(S[2 * k2 + 1][mi][2], S[2 * k2 + 1][mi][3]); Pf[mi][k2] = __builtin_bit_cast(bf16x8, w); }
    }
}
__device__ __forceinline__ void tile_pv(const LAS unsigned char* buf, const bf16x8 (&Pf)[2][2], f32x4 (&O)[8][2], int l15, int lg, f32x4 (&OL)[2], bool with_l) {
    if (with_l) { v4u ow; ow.x = ow.y = ow.z = ow.w = 0x3F803F80u; const bf16x8 ones = __builtin_bit_cast(bf16x8, ow);
#pragma unroll
        for (int k2 = 0; k2 < 2; ++k2)
#pragma unroll
            for (int mi = 0; mi < 2; ++mi) OL[mi] = __builtin_amdgcn_mfma_f32_16x16x32_bf16(ones, Pf[mi][k2], OL[mi], 0, 0, 0); }
    const LAS unsigned char* vbase = buf + KS_BYTES + l15 * VT_STRIDE + lg * 8;
    v2u va[2][2][2];
#define FA_LDV(slot_, g_) do { _Pragma("unroll") for (int q = 0; q < 2; ++q) { const int dt_ = ((g_) & 3) * 2 + q, k2_ = (g_) >> 2; \
        va[slot_][q][0] = *(const LAS v2u*)(vbase + dt_ * 16 * VT_STRIDE + k2_ * 64); va[slot_][q][1] = *(const LAS v2u*)(vbase + dt_ * 16 * VT_STRIDE + k2_ * 64 + 32); } } while (0)
    FA_LDV(0, 0);
#pragma unroll
    for (int g = 0; g < 8; ++g) {
        if (g < 7) FA_LDV((g + 1) & 1, g + 1);
        __builtin_amdgcn_sched_barrier(0);
        __builtin_amdgcn_s_setprio(1);
#pragma unroll
        for (int q = 0; q < 2; ++q) { const int dt = (g & 3) * 2 + q, k2 = g >> 2; v4u w; w.x = va[g & 1][q][0].x; w.y = va[g & 1][q][0].y; w.z = va[g & 1][q][1].x; w.w = va[g & 1][q][1].y; const bf16x8 vf = __builtin_bit_cast(bf16x8, w);
#pragma unroll
            for (int mi = 0; mi < 2; ++mi) O[dt][mi] = __builtin_amdgcn_mfma_f32_16x16x32_bf16(vf, Pf[mi][k2], O[dt][mi], 0, 0, 0); }
        __builtin_amdgcn_s_setprio(0);
        __builtin_amdgcn_sched_barrier(0);
    }
#undef FA_LDV
}
template <int MODE, class MaskF>
__device__ __forceinline__ void run(LAS unsigned char* lds, const Src& src, unsigned long long tiles, const bf16x8 (&Qf)[2][4], f32x4 (&O)[8][2], float (&m)[2], float (&l)[2], const float (&invl)[2],
                                    const MaskF& mf, int tid, int wave, int l15, int lg) {
    if (tiles == 0ull) return;
    int kb = __builtin_ctzll(tiles); tiles &= tiles - 1ull; int cur = 0;
    f32x4 OL[2]; OL[0] = (f32x4){0.f, 0.f, 0.f, 0.f}; OL[1] = (f32x4){0.f, 0.f, 0.f, 0.f};
    { Stage st; load_tile<MODE != 1>(src, kb * 64, tid, st); store_tile<MODE != 1>(lds, tid, st); }
    __syncthreads();
    for (;;) {
        const bool more = tiles != 0ull; int nkb = 0;
        if (more) { nkb = __builtin_ctzll(tiles); tiles &= tiles - 1ull; }
        bf16x8 Pf[2][2];
        tile_qk<MODE>(lds + cur * BUF_BYTES, Qf, O, m, l, invl, kb, mf, (LAS float*)(lds + PS_OFF), wave, l15, lg, Pf, OL);
        __builtin_amdgcn_sched_barrier(0);
        Stage st;
        if (more) load_tile<MODE != 1>(src, nkb * 64, tid, st);
        if constexpr (MODE != 1) tile_pv(lds + cur * BUF_BYTES, Pf, O, l15, lg, OL, MODE == 0);
        if (more) store_tile<MODE != 1>(lds + (cur ^ 1) * BUF_BYTES, tid, st);
        __syncthreads();
        if (!more) break;
        kb = nkb; cur ^= 1;
    }
    if constexpr (MODE == 0) { l[0] = OL[0][0] * 0.25f; l[1] = OL[1][0] * 0.25f; }
}
}

__device__ __forceinline__ void xa_attn_fa(const Ctx& c, const bf16* Q, const bf16* KV, const bf16* XVT, bf16* Oo) {
    const int l15 = c.lane & 15, lg = c.lane >> 4;
    for (int u_ = c.vcu; u_ < (PROBE == 12 ? 512 : 256); u_ += c.G) {
        const int u = u_ & 255; const int bh = u >> 4, chunk = u & 15, b = bh >> 2, hd = bh & 3;
        bf16x8 Qf[2][4]; size_t grow[2];
#pragma unroll
        for (int mi = 0; mi < 2; ++mi) { grow[mi] = (size_t)b * SEQ + chunk * 256 + 32 * c.wave + 16 * mi + l15;
#pragma unroll
            for (int ks = 0; ks < 4; ++ks) Qf[mi][ks] = *(const bf16x8*)(Q + grow[mi] * 512 + hd * 128 + 32 * ks + 8 * lg); }
        f32x4 O[8][2]; float m[2] = {-1e30f, -1e30f}, l[2] = {0.f, 0.f}; const float invl[2] = {0.f, 0.f};
#pragma unroll
        for (int dt = 0; dt < 8; ++dt) { O[dt][0] = (f32x4){0.f, 0.f, 0.f, 0.f}; O[dt][1] = (f32x4){0.f, 0.f, 0.f, 0.f}; }
        fa::Src src{KV + (size_t)b * 256 * 1024 + hd * 128, 1024, XVT + (size_t)bh * 128 * 256, 256};
        fa::run<0>(c.lds, src, 0xFull, Qf, O, m, l, invl, fa::NoMask{}, c.tid, c.wave, l15, lg);
#pragma unroll
        for (int mi = 0; mi < 2; ++mi) { float lt = l[mi]; lt += __shfl_xor(lt, 16); lt += __shfl_xor(lt, 32); const float il = 1.f / lt;
#pragma unroll
            for (int dt = 0; dt < 8; ++dt) { const f32x4 o = O[dt][mi] * il; v2u w; w.x = pk2(o[0], o[1]); w.y = pk2(o[2], o[3]);
                *(v2u*)(Oo + grow[mi] * 512 + hd * 128 + 16 * dt + 4 * lg) = w; } }
    }
}
__device__ __forceinline__ void xa_vt(const Ctx& c, const bf16* KV, bf16* XVT) {
    for (int it = c.vcu * 512 + c.tid; it < 16 * 128 * 32; it += c.G * 512) {
        const int m8 = it & 31, d = (it >> 5) & 127, bh = it >> 12, b = bh >> 2, hd = bh & 3; unsigned short v[8];
#pragma unroll
        for (int j = 0; j < 8; ++j) v[j] = KV[(size_t)(b * 256 + m8 * 8 + j) * 1024 + 512 + hd * 128 + d];
        v4u w; w.x = v[0] | ((unsigned)v[1] << 16); w.y = v[2] | ((unsigned)v[3] << 16); w.z = v[4] | ((unsigned)v[5] << 16); w.w = v[6] | ((unsigned)v[7] << 16);
        *(v4u*)(XVT + ((size_t)bh * 128 + d) * 256 + m8 * 8) = w;
    }
}
__device__ __forceinline__ void nsa_vt(const Ctx& c, const bf16* T, bf16* VT) {
    LAS unsigned short* Tt = (LAS unsigned short*)c.lds;
    for (int it = c.vcu; it < 2 * 16 * 64; it += c.G) {
        const int tb = it & 63, bg = (it >> 6) & 15, which = it >> 10; const bf16* src = T + (size_t)(3 + 2 * which) * NT_STRIDE + ((size_t)bg * 4096 + tb * 64) * 128;
        __syncthreads();
#pragma unroll
        for (int e = 0; e < 2; ++e) { const int cc = c.tid + 512 * e, key = cc >> 4, d8 = cc & 15; const v4u v = *(const v4u*)(src + (size_t)key * 128 + d8 * 8);
#pragma unroll
            for (int j = 0; j < 4; ++j) { Tt[(d8 * 8 + 2 * j) * 72 + key] = (unsigned short)(v[j] & 0xffffu); Tt[(d8 * 8 + 2 * j + 1) * 72 + key] = (unsigned short)(v[j] >> 16); } }
        __syncthreads();
#pragma unroll
        for (int e = 0; e < 2; ++e) { const int cc = c.tid + 512 * e, d = cc >> 3, k8 = cc & 7;
            *(v4u*)(VT + ((size_t)(which * 16 + bg) * 128 + d) * 4096 + tb * 64 + k8 * 8) = *(const LAS v4u*)((const LAS unsigned char*)Tt + d * 144 + k8 * 16); }
    }
    __syncthreads();
}
__device__ __forceinline__ void nsa_hidreduce(const Ctx& c, const float* HIDP, const float* pb, bf16* HID) {
    for (int it = c.vcu * 512 + c.tid; it < 8192 * 32; it += c.G * 512) {
        const int r = it >> 5, h0 = (it & 31) * 8, ten = r >> 12; const float* hrow = HIDP + (size_t)r * 2048 + h0;
        f32x4 a0 = *(const f32x4*)(pb + ten * 256 + h0), a1 = *(const f32x4*)(pb + ten * 256 + h0 + 4);
#pragma unroll
        for (int sp = 0; sp < 8; ++sp) { a0 += *(const f32x4*)(hrow + sp * 256); a1 += *(const f32x4*)(hrow + sp * 256 + 4); }
        v4u o; o.x = pk2(gelu_tanh(a0.x), gelu_tanh(a0.y)); o.y = pk2(gelu_tanh(a0.z), gelu_tanh(a0.w)); o.z = pk2(gelu_tanh(a1.x), gelu_tanh(a1.y)); o.w = pk2(gelu_tanh(a1.z), gelu_tanh(a1.w));
        *(v4u*)(HID + (size_t)r * 256 + h0) = o;
    }
}
__device__ __forceinline__ void nsa_w2b(const Ctx& c, const bf16* HID, const float* w2, bf16* KCb, bf16* VCT) {
    for (int it = c.vcu * 512 + c.tid; it < 8192 * 16; it += c.G * 512) {
        const int r = it >> 4, d0 = (it & 15) * 8, ten = r >> 12, bg = (r >> 8) & 15, i = r & 255; const bf16* hrow = HID + (size_t)r * 256; const float* w = w2 + (size_t)ten * 256 * 128 + d0;
        float a[8];
#pragma unroll
        for (int j = 0; j < 8; ++j) a[j] = 0.f;
#pragma unroll 4
        for (int h8 = 0; h8 < 32; ++h8) { const v4u hv = *(const v4u*)(hrow + h8 * 8);
#pragma unroll
            for (int q = 0; q < 8; ++q) { const float hf = (q & 1) ? bfhi(hv[q >> 1]) : bflo(hv[q >> 1]); const f32x4 w0 = *(const f32x4*)(w + (size_t)(h8 * 8 + q) * 128), w1 = *(const f32x4*)(w + (size_t)(h8 * 8 + q) * 128 + 4);
                a[0] += hf * w0.x; a[1] += hf * w0.y; a[2] += hf * w0.z; a[3] += hf * w0.w; a[4] += hf * w1.x; a[5] += hf * w1.y; a[6] += hf * w1.z; a[7] += hf * w1.w; } }
        if (ten == 0) { v4u o; o.x = pk2(a[0], a[1]); o.y = pk2(a[2], a[3]); o.z = pk2(a[4], a[5]); o.w = pk2(a[6], a[7]); *(v4u*)(KCb + ((size_t)bg * 256 + i) * 128 + d0) = o; }
        else {
#pragma unroll
            for (int j = 0; j < 8; ++j) VCT[((size_t)bg * 128 + d0 + j) * 256 + i] = (bf16)f2bf(a[j]); }
    }
}
#define NSA_UNIT_PROLOGUE \
        const int ui = uu >> 8, slot = uu & 255; \
        const int bg = 2 * (slot >> 5) + (slot & 1), x = (slot & 31) >> 1, qb = (ui == 0) ? x : (ui == 1) ? 31 - x : (ui == 2) ? 32 + x : 63 - x;   \
        const int b = bg >> 2, g = bg & 3, t0 = qb * 64; \
        bf16x8 Qf[2][4]; int grow[2]; int tq[2], hcol[2]; \
        _Pragma("unroll") for (int mi = 0; mi < 2; ++mi) { const int qrow = 32 * c.wave + 16 * mi + l15, tl = qrow >> 2, j = qrow & 3; tq[mi] = t0 + tl; grow[mi] = b * SEQ + tq[mi]; hcol[mi] = (g * 4 + j) * 128; \
            _Pragma("unroll") for (int ks = 0; ks < 4; ++ks) Qf[mi][ks] = *(const bf16x8*)(Q + (size_t)grow[mi] * 2048 + hcol[mi] + 32 * ks + 8 * lg); }
__device__ __forceinline__ void nsa_attn_cmp(const Ctx& c, const bf16* Q, const bf16* KCb, const bf16* VCT, const float* Gt, float* NACC, unsigned long long* SMg) {
    const int l15 = c.lane & 15, lg = c.lane >> 4, lane = c.lane;
    LAS float* PS = (LAS float*)(c.lds + fa::PS_OFF);
#if PROBE == 9
#pragma unroll 1
    for (int rep_ = 0; rep_ < 2; ++rep_)
#endif
    for (int uu = c.vcu; uu < 1024; uu += c.G) {
        NSA_UNIT_PROLOGUE
        f32x4 O[8][2]; float m[2], l[2], invl[2] = {0.f, 0.f};
        const int tmax = t0 + 63, nvmax = tmax >= 31 ? ((tmax - 31) >> 4) + 1 : 0, ntile = (nvmax + 63) >> 6;
        { const unsigned long long tiles = (1ull << ntile) - 1ull;
          fa::CmpMask mk; mk.nvq[0] = tq[0] >= 31 ? ((tq[0] - 31) >> 4) + 1 : 0; mk.nvq[1] = tq[1] >= 31 ? ((tq[1] - 31) >> 4) + 1 : 0;
          fa::Src src{KCb + (size_t)bg * 256 * 128, 128, VCT + (size_t)bg * 128 * 256, 256};
          m[0] = m[1] = -1e30f; l[0] = l[1] = 0.f;
          fa::run<1>(c.lds, src, tiles, Qf, O, m, l, invl, mk, c.tid, c.wave, l15, lg);
#pragma unroll
          for (int mi = 0; mi < 2; ++mi) { float lt = l[mi]; lt += __shfl_xor(lt, 16); lt += __shfl_xor(lt, 32); invl[mi] = lt > 0.f ? 1.f / lt : 0.f; }
#pragma unroll
          for (int dt = 0; dt < 8; ++dt) { O[dt][0] = (f32x4){0.f, 0.f, 0.f, 0.f}; O[dt][1] = (f32x4){0.f, 0.f, 0.f, 0.f}; }
          fa::run<2>(c.lds, src, tiles, Qf, O, m, l, invl, mk, c.tid, c.wave, l15, lg);
#pragma unroll
          for (int mi = 0; mi < 2; ++mi) { const float g0 = sigmoidf_(Gt[(size_t)grow[mi] * 48 + (hcol[mi] >> 7) * 3 + 0]);
#pragma unroll
              for (int dt = 0; dt < 8; ++dt) *(f32x4*)(NACC + (size_t)grow[mi] * 2048 + hcol[mi] + 16 * dt + 4 * lg) = O[dt][mi] * g0; }
        }
        __syncthreads();
        for (int i = 0; i < 8; ++i) { const int tl = 8 * c.wave + i; const LAS float* pr = PS + tl * fa::PS_STRIDE; float imp = 0.f;
            { const int i0 = (4 * lane - 1) < 0 ? 0 : 4 * lane - 1; int i1 = (4 * lane + 3) > 254 ? 254 : 4 * lane + 3; if (i1 > 64 * ntile - 1) i1 = 64 * ntile - 1; for (int q = i0; q <= i1; ++q) imp += pr[q]; }
            const bool forced = (lane == 0) || (lane <= qb && lane > qb - 3), future = lane > qb;
            const float score = forced ? 1e30f : (future ? -1e30f : imp); int rank = 0;
            for (int k = 0; k < 64; ++k) { const float sk = __shfl(score, k); rank += (sk > score || (sk == score && k < lane)) ? 1 : 0; }
            const unsigned long long sel = __ballot(rank < 16); if (lane == 0) SMg[(size_t)bg * SEQ + t0 + tl] = sel; }
        __syncthreads();
    }
}
__device__ __forceinline__ void nsa_attn_sw(const Ctx& c, const bf16* Q, const bf16* T, const bf16* VT, const float* Gt, const float* NACC, float* NACC2, const unsigned long long* SMg, bf16* OUT) {
    const int l15 = c.lane & 15, lg = c.lane >> 4, lane = c.lane;
    for (int uu_ = c.vcu; uu_ < (PROBE == 21 ? 2048 : 1024); uu_ += c.G) { const int uu = uu_ & 1023;
        NSA_UNIT_PROLOGUE
        unsigned long long um = SMg[(size_t)bg * SEQ + t0 + lane];
#pragma unroll
        for (int o = 1; o < 64; o <<= 1) { const unsigned lo_ = __shfl_xor((unsigned)um, o), hi_ = __shfl_xor((unsigned)(um >> 32), o); um |= ((unsigned long long)hi_ << 32) | lo_; }
        const unsigned long long umu = ((unsigned long long)__builtin_amdgcn_readfirstlane((unsigned)(um >> 32)) << 32) | (unsigned)__builtin_amdgcn_readfirstlane((unsigned)um);
        f32x4 O[8][2]; float m[2], l[2]; const float invl[2] = {0.f, 0.f};
        { fa::SelMask mk; mk.qb = qb; mk.tq[0] = tq[0]; mk.tq[1] = tq[1]; mk.sm[0] = SMg[(size_t)bg * SEQ + tq[0]]; mk.sm[1] = SMg[(size_t)bg * SEQ + tq[1]];
          const unsigned long long tiles = umu & ((2ull << qb) - 1ull);
          fa::Src src{T + 2 * NT_STRIDE + (size_t)bg * 4096 * 128, 128, VT + (size_t)bg * 128 * 4096, 4096};
          m[0] = m[1] = -1e30f; l[0] = l[1] = 0.f;
#pragma unroll
          for (int dt = 0; dt < 8; ++dt) { O[dt][0] = (f32x4){0.f, 0.f, 0.f, 0.f}; O[dt][1] = (f32x4){0.f, 0.f, 0.f, 0.f}; }
          fa::run<0>(c.lds, src, tiles, Qf, O, m, l, invl, mk, c.tid, c.wave, l15, lg);
#pragma unroll
          for (int mi = 0; mi < 2; ++mi) { float lt = l[mi]; lt += __shfl_xor(lt, 16); lt += __shfl_xor(lt, 32); const float sc = sigmoidf_(Gt[(size_t)grow[mi] * 48 + (hcol[mi] >> 7) * 3 + 1]) / lt;
#pragma unroll
              for (int dt = 0; dt < 8; ++dt) { const size_t off = (size_t)grow[mi] * 2048 + hcol[mi] + 16 * dt + 4 * lg; *(f32x4*)(NACC2 + off) = *(const f32x4*)(NACC + off) + O[dt][mi] * sc; } }
        }
        { fa::WinMask mk; mk.qb = qb; mk.tq[0] = tq[0]; mk.tq[1] = tq[1];
          const int kb0 = qb - 8 < 0 ? 0 : qb - 8; const unsigned long long tiles = ((2ull << qb) - 1ull) & ~((1ull << kb0) - 1ull);
          fa::Src src{T + 4 * NT_STRIDE + (size_t)bg * 4096 * 128, 128, VT + (size_t)(16 + bg) * 128 * 4096, 4096};
          m[0] = m[1] = -1e30f; l[0] = l[1] = 0.f;
#pragma unroll
          for (int dt = 0; dt < 8; ++dt) { O[dt][0] = (f32x4){0.f, 0.f, 0.f, 0.f}; O[dt][1] = (f32x4){0.f, 0.f, 0.f, 0.f}; }
          fa::run<0>(c.lds, src, tiles, Qf, O, m, l, invl, mk, c.tid, c.wave, l15, lg);
#pragma unroll
          for (int mi = 0; mi < 2; ++mi) { float lt = l[mi]; lt += __shfl_xor(lt, 16); lt += __shfl_xor(lt, 32); const float sc = sigmoidf_(Gt[(size_t)grow[mi] * 48 + (hcol[mi] >> 7) * 3 + 2]) / lt;
#pragma unroll
              for (int dt = 0; dt < 8; ++dt) { const f32x4 a = *(const f32x4*)(NACC2 + (size_t)grow[mi] * 2048 + hcol[mi] + 16 * dt + 4 * lg) + O[dt][mi] * sc; v2u w_; w_.x = pk2(a[0], a[1]); w_.y = pk2(a[2], a[3]);
                  *(v2u*)(OUT + (size_t)grow[mi] * 2048 + hcol[mi] + 16 * dt + 4 * lg) = w_; } }
        }
    }
}

struct Args { const float* in[35]; float* out; unsigned char* ws; int ph_lo, ph_hi; };
constexpr int NPH = 16, N_PHASES = 4 * NPH;


#define IN(k) (lo <= (k) && (k) < hi)
#if MK_MULTI
#define SEAM(k) do { } while (0)
#else
#if PROBE == 4
#define SEAM(k) do { if (IN(k) && IN((k) + 1)) { xcd_barrier(bar); xcd_barrier(bar); } } while (0)
#else
#define SEAM(k) do { if (IN(k) && IN((k) + 1)) xcd_barrier(bar); } while (0)
#endif
#endif
template <int L>
__device__ __forceinline__ void layer_body(const Ctx& c, const Args& args, const XcdBarrier& bar, int lo, int hi) {
    constexpr int P0 = L * NPH;
    unsigned char* ws = args.ws;
    const float* x_in = args.in[0]; const float* mem = args.in[1]; const float* norm_pre = args.in[2]; const float* norm_post = args.in[3]; const float* norm_mem = args.in[4];
    float* X = args.out;
    bf16* XB = (bf16*)(ws + WS_H); float* RS = (float*)(ws + WS_PB + 256 * 1024); bf16* POOLED = (bf16*)(ws + WS_ACT + 64 * MiB); (void)POOLED; bf16* PROJ = (bf16*)(ws + WS_PROJ); float* MF = (float*)(ws + WS_PROJ); bf16* MFb = (bf16*)(ws + WS_PROJ); bf16* ACT = (bf16*)(ws + WS_ACT);
    bf16* XQ = (bf16*)(ws + WS_Q); bf16* XO = (bf16*)(ws + WS_O); bf16* KV = (bf16*)(ws + WS_KV); bf16* MEMN = (bf16*)(ws + WS_MEMN); float* DT = (float*)(ws + WS_DT); float* PB = (float*)(ws + WS_PB); float* PBP = (float*)(ws + WS_PB + 4096); (void)PBP;
    bf16* NQ = (bf16*)(ws + WS_NQ); bf16* NT = (bf16*)(ws + WS_NT); bf16* NHID = (bf16*)(ws + WS_NHID); float* NKC = (float*)(ws + WS_NKC); float* NG = (float*)(ws + WS_NG);
    bf16* Wmi = (bf16*)(ws + W_MIX_IN); bf16* Wmo = (bf16*)(ws + W_MIX_OUT); bf16* Wmx = (bf16*)(ws + W_MIX_X);
    bf16* Wxq = (bf16*)(ws + W_XQ); bf16* Wxkv = (bf16*)(ws + W_XKV); bf16* Wxo = (bf16*)(ws + W_XO); bf16* Wup = (bf16*)(ws + W_UP); bf16* Wdn = (bf16*)(ws + W_DOWN);
    const int cid = (int)blockIdx.x;
    bf16* NVT = (bf16*)(ws + WS_NVT); bf16* XVT = (bf16*)(ws + WS_XVT); bf16* KCb = (bf16*)(ws + WS_NKC); bf16* VCT = (bf16*)(ws + WS_NKC + 1 * MiB); unsigned long long* SMg = (unsigned long long*)(ws + WS_NKC + 2 * MiB);
    (void)x_in; (void)DT; (void)PB; (void)NQ; (void)NT; (void)NHID; (void)NKC; (void)NG; (void)Wmx; (void)NVT; (void)KCb; (void)VCT; (void)SMg;

        if (IN(P0 + 0))
#if PROBE == 11
#pragma unroll 1
        for (int rep_ = 0; rep_ < 2; ++rep_)
#endif
        {
            if constexpr (L == 0) { conv_w(opq(c), args.in[5], 2048, SSD_IN, SSD_NP, Wmi, norm_pre + (L * 3) * DM); conv_w(opq(c), args.in[12], 4096, 2048, 2048, Wmo); }
            if constexpr (L == 1) nsa_posbias(opq(c), args.in[14], args.in[15], PBP);
            conv_w(opq(c), args.in[28] + (size_t)L * 2048 * 512, 2048, 512, 512, Wxq, norm_pre + (L * 3 + 1) * DM, false, c.gw, c.NGW);
            conv_w(opq(c), args.in[29] + (size_t)L * 2048 * 1024, 2048, 1024, 1024, Wxkv, nullptr, false, (c.gw + c.NGW - 256) % c.NGW, c.NGW);
            conv_w(opq(c), args.in[30] + (size_t)L * 512 * 2048, 512, 2048, 2048, Wxo, nullptr, false, (c.gw + c.NGW - 768) % c.NGW, c.NGW);
            for (int r = (c.gw + c.NGW - 1024) % c.NGW; r < 1024; r += c.NGW) rms_row_bf16(opq(c), mem + (size_t)r * DM, norm_mem + L * DM, MEMN + (size_t)r * DM, nullptr);
            if constexpr (L == 0) x_to_xb(opq(c), x_in, XB, RS);
        }
        SEAM(P0 + 0);
        if (IN(P0 + 1)) {
            constexpr int NA = (L == 0) ? 11 : (L == 1) ? 6 : (L == 2) ? 8 : 2, NBU = (L == 0) ? 10 : (L == 1) ? 5 : (L == 2) ? 8 : 2;
            if ((cid >> 3) & 1) { const int ga = ((cid & 7) | ((cid >> 4) << 3)) * 8 + c.wave;
                conv_w(opq(c), args.in[31] + (size_t)L * 2048 * FF2, 2048, FF2, FF2, Wup, norm_pre + (L * 3 + 2) * DM, true, ga, 1024);
                conv_w(opq(c), args.in[34] + (size_t)L * FFH * 2048, FFH, 2048, 2048, Wdn, nullptr, false, ga, 1024); __syncthreads(); }
            if constexpr (L == 0) { pg8::ProbSplit S; S.init(XB, Wmi, 2048, 2048, 2048, 64, SSD_NP / 256, c.G, cid); S.nA = NA; S.nB = NBU; pg8::EpiP<StBf16> E{{PROJ, SSD_NP}, RS}; pg8::gemm_phase(c.lds, S, E); }
            else if constexpr (L == 1) { nsa_posbias_reduce(opq(c), PBP, PB); pg8::ProbSplit S; S.init(XB, Wmi, 2048, 2048, 2048, 64, NSA_NP / 256, c.G, cid); S.nA = NA; S.nB = NBU; pg8::EpiP<StNsa> E{{NQ, NT, NG}, RS}; pg8::gemm_phase(c.lds, S, E); }
            else if constexpr (L == 2) { pg8::ProbSplit S; S.init(XB, Wmi, 2048, 2048, 2048, 64, 32, c.G, cid); S.nA = NA; S.nB = NBU; pg8::EpiP<StBf16BiasGelu> E{{PROJ, 8192, args.in[19]}, RS}; pg8::gemm_phase(c.lds, S, E); }
            else { pg8::ProbSplit S; S.init(XB, Wmi, 2048, 2048, 2048, 64, 8, c.G, cid); S.nA = NA; S.nB = NBU; pg8::EpiN<StF32> E{{MF, 2048}, RS}; pg8::gemm_phase(c.lds, S, E); }
        }
        SEAM(P0 + 1);
        if (IN(P0 + 2)) {
            if constexpr (L == 0) { ssd_conv(opq(c), PROJ, args.in[6], args.in[7], args.in[8], ACT, DT);
#if PROBE == 11
                ssd_conv(opq(c), PROJ, args.in[6], args.in[7], args.in[8], ACT, DT);
#endif
            }
            else if constexpr (L == 1) { pg8::ProbC S; S.init(NT, Wmx, 2048, 4096, 512, 32, 8, c.G, cid); S.a_tile_stride = (size_t)4096 * 128;
                pg8::EpiN<StF32> E{{(float*)(ws + WS_ACT), 2048}, nullptr}; pg8::gemm_phase(c.lds, S, E); nsa_vt(opq(c), NT, NVT);
#if PROBE == 11
                nsa_vt(opq(c), NT, NVT);
#endif
            }
            else if constexpr (L == 2) sgu_ln(opq(c), PROJ, args.in[20]);
            else { pool_pool(opq(c), MF, POOLED);
#if PROBE == 11
                pool_pool(opq(c), MF, POOLED);
#endif
            }
        }
        SEAM(P0 + 2);
        if (IN(P0 + 3)) {
            if constexpr (L == 0) {
#if PROBE == 10
                ssd_scan_mfma(opq(c), ACT, DT, args.in[9], args.in[10], lo < 0);
#endif
                ssd_scan_mfma(opq(c), ACT, DT, args.in[9], args.in[10], true); }
            else if constexpr (L == 1) { nsa_hidreduce(opq(c), (const float*)(ws + WS_ACT), PB, NHID); if (IN(P0 + 3) && IN(P0 + 4)) xcd_barrier(bar); nsa_w2b(opq(c), NHID, args.in[16], KCb, VCT);
#if PROBE == 11
                nsa_hidreduce(opq(c), (const float*)(ws + WS_ACT), PB, NHID); if (IN(P0 + 3) && IN(P0 + 4)) xcd_barrier(bar); nsa_w2b(opq(c), NHID, args.in[16], KCb, VCT);
#endif
            }
            else if constexpr (L == 2) sgu_spatial_mfma(opq(c), PROJ, args.in[21], args.in[22], ACT);
            else { pg8::Prob S; S.init(POOLED, Wmx, 2048, 512, 512, 64, 8, c.G, cid); S.a_group_shift = 1; S.a_group_cols = 512; pg8::EpiP<StBf16Scale> E{{ACT, 2048, args.in[26]}, nullptr}; pg8::gemm_phase(c.lds, S, E); }
        }
        SEAM(P0 + 3);
        if (IN(P0 + 4)) {
            if constexpr (L == 0) ssd_gnorm(opq(c), ACT, PROJ, args.in[11]);
            else if constexpr (L == 1) nsa_attn_cmp(opq(c), NQ, KCb, VCT, NG, MF, SMg);
        }
        if constexpr (L <= 1) SEAM(P0 + 4);
        if (IN(P0 + 5)) {
            if constexpr (L == 1) { nsa_attn_sw(opq(c), NQ, NT, NVT, NG, MF, (float*)(ws + WS_ACT + 64 * MiB), SMg, ACT);
#if PROBE == 1
                nsa_attn_sw(opq(c), NQ, NT, NVT, NG, MF, (float*)(ws + WS_ACT + 64 * MiB), SMg, ACT);
#endif
            }
        }
        if constexpr (L == 1) SEAM(P0 + 5);
        if (IN(P0 + 6)) {
            if constexpr (L == 0) { pg8::Prob S; S.init(ACT, Wmo, 6144, 4096, 4096, 64, 8, c.G, cid); pg8::EpiP<StBf16> E{{MFb, 2048}, nullptr}; pg8::gemm_phase(c.lds, S, E); }
            else if constexpr (L == 2) { pg8::Prob S; S.init(ACT, Wmo, 4096, 4096, 4096, 64, 8, c.G, cid); pg8::EpiP<StBf16> E{{MFb, 2048}, nullptr}; pg8::gemm_phase(c.lds, S, E); }
            else { pg8::Prob S; S.init(ACT, Wmo, 2048, 2048, 2048, 64, 8, c.G, cid); pg8::EpiP<StBf16> E{{MFb, 2048}, nullptr}; pg8::gemm_phase(c.lds, S, E); }
        }
        SEAM(P0 + 6);
        if (IN(P0 + 7)) postnorm(opq(c), MFb, XB, RS, norm_post + (L * 3 + 0) * DM, nullptr);
        SEAM(P0 + 7);
        if (IN(P0 + 8)) {
            { pg8::Prob S; S.init(XB, Wxq, 2048, 2048, 2048, 64, 2, c.G, cid); pg8::EpiP<StBf16> E{{XQ, 512}, RS}; pg8::gemm_phase(c.lds, S, E); }
            { pg8::Prob S; S.init(MEMN, Wxkv, 2048, 2048, 2048, 4, 4, c.G, (cid + c.G - 128) % c.G); pg8::EpiP<StKv> E{{KV, XVT}, nullptr}; pg8::gemm_phase(c.lds, S, E); }
            if (cid >= 144 && c.G == 256) { const int ga = (cid - 144) * 8 + c.wave; constexpr int NG_ = 112 * 8;
                if constexpr (L == 0) { conv_w(opq(c), args.in[13], 2048, NSA_IN, NSA_NP, Wmi, norm_pre + ((L + 1) * 3) * DM, false, ga, NG_); conv_w(opq(c), args.in[17], 2048, 2048, 2048, Wmo, nullptr, false, ga, NG_);
                    conv_w(opq(c), args.in[15], 4096, 256, 256, Wmx, nullptr, false, ga, NG_); conv_w(opq(c), args.in[15] + (size_t)4096 * 256, 4096, 256, 256, Wmx + (size_t)256 * 4096, nullptr, false, ga, NG_); }
                else if constexpr (L == 1) { conv_w(opq(c), args.in[18], 2048, 8192, 8192, Wmi, norm_pre + ((L + 1) * 3) * DM, false, ga, NG_); conv_w(opq(c), args.in[23], 4096, 2048, 2048, Wmo, nullptr, false, ga, NG_); }
                else if constexpr (L == 2) { conv_w(opq(c), args.in[24], 2048, 2048, 2048, Wmi, norm_pre + ((L + 1) * 3) * DM, false, ga, NG_); conv_w(opq(c), args.in[27], 2048, 2048, 2048, Wmo, nullptr, false, ga, NG_);
#pragma unroll 1
                    for (int g = 0; g < 4; ++g) conv_w(opq(c), args.in[25] + (size_t)g * 512 * 512, 512, 512, 512, Wmx + (size_t)g * 512 * 512, nullptr, false, ga, NG_); }
            }
        }
        SEAM(P0 + 8);
        if (IN(P0 + 9)) xa_attn_fa(opq(c), XQ, KV, XVT, XO);
        SEAM(P0 + 9);
        if (IN(P0 + 10)) { pg8::Prob S; S.init(XO, Wxo, 512, 512, 512, 64, 8, c.G, cid); pg8::EpiP<StBf16> E{{MFb, 2048}, nullptr}; pg8::gemm_phase(c.lds, S, E); }
        SEAM(P0 + 10);
        if (IN(P0 + 11)) postnorm(opq(c), MFb, XB, RS, norm_post + (L * 3 + 1) * DM, nullptr);
        SEAM(P0 + 11);
        if (IN(P0 + 12)) { pg8::ProbR S; S.init(XB, Wup, 2048, 2048, 2048, 64, 44, c.G, cid); EpiFfn E{ACT, (bf16*)(ws + WS_SXT), RS, args.in[32] + (size_t)L * 3 * FF2, args.in[33] + (size_t)L * FF2}; pg8::gemm_phase(c.lds, S, E); }
        SEAM(P0 + 12);
        if (IN(P0 + 13)) ffn_fixup(opq(c), (const bf16*)(ws + WS_SXT), args.in[32] + (size_t)L * 3 * FF2, args.in[33] + (size_t)L * FF2, ACT);
        SEAM(P0 + 13);
        if (IN(P0 + 14)) { pg8::Prob S; S.init(ACT, Wdn, FFH, FFH, FFH, 64, 8, c.G, cid); pg8::EpiP<StBf16> E{{MFb, 2048}, nullptr}; pg8::gemm_phase(c.lds, S, E); }
        SEAM(P0 + 14);
        if (IN(P0 + 15)) postnorm(opq(c), MFb, XB, RS, norm_post + (L * 3 + 2) * DM, (L == 3) ? X : nullptr);
    }
#undef IN
#undef SEAM

__global__ void __launch_bounds__(512, 2) mega_fwd(Args args) {
    extern __shared__ __attribute__((aligned(16))) unsigned char lds_raw[];
    Ctx c; c.lds = (LAS unsigned char*)lds_raw; c.tid = threadIdx.x; c.lane = c.tid & 63; c.wave = __builtin_amdgcn_readfirstlane(c.tid >> 6);
    c.G = gridDim.x; { const int bx = blockIdx.x; c.vcu = (c.G % 8 == 0) ? (bx % 8) * (c.G / 8) + bx / 8 : bx; }
    c.gw = c.vcu * 8 + c.wave; c.NGW = c.G * 8;
    volatile LAS unsigned* MISC = (volatile LAS unsigned*)(c.lds + MISC_OFF);
    if (c.tid < 64) MISC[c.tid] = 0u;
    __syncthreads();
    unsigned char* ws = args.ws;
    unsigned* ctl = (unsigned*)(ws + WS_CTL);
    XcdBarrier bar; bar.bar = ctl + CW_BAR; bar.x = 0; bar.st = nullptr;
#if !MK_MULTI
    bar = xcd_barrier_post(ctl + CW_BAR, MISC + 8);
#endif
    const int lo = args.ph_lo, hi = args.ph_hi;
    layer_body<0>(c, args, bar, lo, hi);
    layer_body<1>(c, args, bar, lo, hi);
    layer_body<2>(c, args, bar, lo, hi);
    layer_body<3>(c, args, bar, lo, hi);
}

extern "C" void kernel_launch(void* const* d_in, const int* in_sizes, int n_in, void* d_out, int out_size, void* d_ws, size_t ws_size, hipStream_t stream) {
    static int grid = 0;
    if (grid == 0) {
        if (n_in != 35 || out_size != MT * DM || ws_size < WS_END) { fprintf(stderr, "kernel_launch: unexpected shapes: n_in %d out %d ws %zu (need %zu)\n", n_in, out_size, ws_size, (size_t)WS_END); grid = -1; return; }
        int dev = 0, cus = 0, per_cu = 0;
        if (hipGetDevice(&dev) != hipSuccess || hipDeviceGetAttribute(&cus, hipDeviceAttributeMultiprocessorCount, dev) != hipSuccess) { grid = -1; return; }
        if (hipFuncSetAttribute((const void*)mega_fwd, hipFuncAttributeMaxDynamicSharedMemorySize, LDS_BYTES) != hipSuccess) { fprintf(stderr, "kernel_launch: hipFuncSetAttribute failed\n"); grid = -1; return; }
        if (hipOccupancyMaxActiveBlocksPerMultiprocessor(&per_cu, (const void*)mega_fwd, 512, LDS_BYTES) != hipSuccess || per_cu < 1) { fprintf(stderr, "kernel_launch: occupancy query says %d\n", per_cu); grid = -1; return; }
        (void)hipGetLastError();
        if (cus < 256) { fprintf(stderr, "kernel_launch: needs >= 256 CUs (got %d)\n", cus); grid = -1; return; }
        grid = 256;
    }
    if (grid < 0) return;
    (void)hipMemsetAsync((char*)d_ws + WS_CTL, 0, CTL_ZERO_BYTES, stream);
    Args a{};
    for (int i = 0; i < 35; ++i) a.in[i] = (const float*)d_in[i];
    a.out = (float*)d_out; a.ws = (unsigned char*)d_ws;
#if MK_MULTI
    for (int p = 0; p < N_PHASES; ++p) { a.ph_lo = p; a.ph_hi = p + 1; hipLaunchKernelGGL(mega_fwd, dim3(grid), dim3(512), LDS_BYTES, stream, a); }
#else
    a.ph_lo = 0; a.ph_hi = N_PHASES;
    hipLaunchKernelGGL(mega_fwd, dim3(grid), dim3(512), LDS_BYTES, stream, a);
#endif
}
```

```cpp
#include <hip/hip_runtime.h>
#include <cstdio>
#include <cstdint>

#ifndef MK_MULTI
#define MK_MULTI 0
#endif
#ifndef PROBE
#define PROBE 0
#endif

#define GAS __attribute__((address_space(1)))
#define LAS __attribute__((address_space(3)))
typedef unsigned short bf16;
typedef unsigned v4u __attribute__((ext_vector_type(4)));
typedef unsigned v2u __attribute__((ext_vector_type(2)));
typedef float f32x4 __attribute__((ext_vector_type(4)));
typedef float f32x2 __attribute__((ext_vector_type(2)));
typedef short bf16x8 __attribute__((ext_vector_type(8)));
typedef short s16x4 __attribute__((ext_vector_type(4)));
#define LDS_WAIT() asm volatile("s_waitcnt lgkmcnt(0)" ::: "memory")

constexpr int DM = 2048, NB = 4, SEQ = 4096, MT = NB * SEQ;
constexpr int SSD_NP = 10496, SSD_IN = 10304;
constexpr int NSA_NP = 5376, NSA_IN = 5168;
constexpr int FFH = 5632, FF2 = 11264;
constexpr float EPS = 1e-6f;

constexpr size_t MiB = 1u << 20;
constexpr size_t WS_CTL = 0, CTL_ZERO_BYTES = 64 * 1024;
constexpr size_t WS_W = 1 * MiB;
constexpr size_t W_MIX_IN = WS_W + 0, W_MIX_OUT = WS_W + 44 * MiB, W_MIX_X = WS_W + 62 * MiB;
constexpr size_t W_XQ = WS_W + 68 * MiB, W_XKV = WS_W + 71 * MiB, W_XO = WS_W + 76 * MiB, W_UP = WS_W + 79 * MiB, W_DOWN = WS_W + 123 * MiB;
constexpr size_t WS_H = 148 * MiB;
constexpr size_t WS_PROJ = 212 * MiB;
constexpr size_t WS_ACT = 564 * MiB;
constexpr size_t WS_Q = 756 * MiB, WS_O = 772 * MiB, WS_KV = 788 * MiB, WS_MEMN = 790 * MiB, WS_DT = 794 * MiB, WS_PB = 798 * MiB;
constexpr size_t WS_SXT = 800 * MiB;
constexpr size_t WS_SBT = 928 * MiB;
constexpr size_t WS_END = 960 * MiB;
constexpr size_t WS_NQ = WS_PROJ + 128 * MiB;
constexpr size_t WS_NT = WS_NQ + 64 * MiB;
constexpr size_t NT_STRIDE = (size_t)16 * 4096 * 128;
constexpr size_t WS_NHID = WS_NT + 97 * MiB;
constexpr size_t WS_NKC = WS_NHID + 4 * MiB;
constexpr size_t WS_NG = WS_NKC + 4 * MiB;
constexpr size_t WS_NVT = WS_NG + 3 * MiB;
static_assert(WS_NVT + 32 * MiB <= WS_ACT, "nsa map");
constexpr size_t WS_XVT = 799 * MiB;
constexpr int CW_BAR = 4096;

constexpr int LDS_BYTES = 159744;
constexpr int MISC_OFF = LDS_BYTES - 256;

__device__ __forceinline__ unsigned f2bf(float f) { unsigned u = __builtin_bit_cast(unsigned, f); return (u + 0x7fffu + ((u >> 16) & 1u)) >> 16; }
__device__ __forceinline__ unsigned pk2(float lo, float hi) { return f2bf(lo) | (f2bf(hi) << 16); }
__device__ __forceinline__ float bflo(unsigned u) { return __builtin_bit_cast(float, u << 16); }
__device__ __forceinline__ float bfhi(unsigned u) { return __builtin_bit_cast(float, u & 0xffff0000u); }
__device__ __forceinline__ float wave_sum(float v) {
#pragma unroll
    for (int o = 1; o < 64; o <<= 1) v += __shfl_xor(v, o);
    return v;
}
__device__ __forceinline__ float wave_max(float v) {
#pragma unroll
    for (int o = 1; o < 64; o <<= 1) v = fmaxf(v, __shfl_xor(v, o));
    return v;
}
__device__ __forceinline__ float sigmoidf_(float x) { return 1.f / (1.f + __expf(-x)); }
__device__ __forceinline__ float silu_fast(float x) { return x * __builtin_amdgcn_rcpf(1.f + __builtin_amdgcn_exp2f(-1.4426950408889634f * x)); }
__device__ __forceinline__ float siluf_(float x) { return x * sigmoidf_(x); }
__device__ __forceinline__ float gelu_tanh(float x) { return x * __builtin_amdgcn_rcpf(1.f + __builtin_amdgcn_exp2f(x * __builtin_fmaf(-1.029432396e-01f, x * x, -2.302208198e+00f))); }

#define XB_TMO      128
#define XB_XCNT(j)  (256  + 64 * (j))
#define XB_XSUB(j)  (1280 + 64 * (j))
#define XB_XGEN(j)  (2304 + 64 * (j))
#define XB_TOP      3328
#define XB_TOPGEN   3392
#define XCD_BAR_WORDS 3456
#define XB_SPIN_CAP (1u << 22)

__device__ __forceinline__ unsigned xb_ld(unsigned* p)              { return __hip_atomic_load(p, __ATOMIC_RELAXED, __HIP_MEMORY_SCOPE_AGENT); }
__device__ __forceinline__ unsigned xb_add(unsigned* p, unsigned v) { return __hip_atomic_fetch_add(p, v, __ATOMIC_RELAXED, __HIP_MEMORY_SCOPE_AGENT); }
__device__ __forceinline__ unsigned xb_xcc_id() { return (unsigned)__builtin_amdgcn_s_getreg((3 << 11) | 20) & 0xFu; }
#define XB_SPIN(cond, bar) do { unsigned _sp = 0; while (cond) { __builtin_amdgcn_s_sleep(1); \
    if ((++_sp & 255u) == 0u) { if (xb_ld(&(bar)[XB_TMO])) break; if (_sp > XB_SPIN_CAP) { atomicAdd(&(bar)[XB_TMO], 1u); break; } } } } while (0)

struct XcdBarrier { unsigned* bar; unsigned x; volatile LAS unsigned* st; };

__device__ __forceinline__ XcdBarrier xcd_barrier_post(unsigned* bar, volatile LAS unsigned* st) {
    XcdBarrier b; b.bar = bar; b.x = xb_xcc_id(); b.st = st;
    if (threadIdx.x == 0) (void)xb_add(&bar[XB_XCNT(b.x)], 1u);
    return b;
}
__device__ __forceinline__ void xcd_barrier_complete(unsigned* bar, unsigned x, unsigned& nloc, unsigned& nx) {
    const unsigned G = gridDim.x * gridDim.y * gridDim.z;
    unsigned sum, cnt, mine, sp = 0u;
    for (;;) {
        sum = 0u; cnt = 0u; mine = 0u;
#pragma unroll
        for (unsigned j = 0; j < 16; ++j) { const unsigned c = xb_ld(&bar[XB_XCNT(j)]); sum += c; cnt += (c > 0u) ? 1u : 0u; mine = (j == x) ? c : mine; }
        if (sum == G) break;
        __builtin_amdgcn_s_sleep(1);
        if ((++sp & 255u) == 0u) { if (xb_ld(&bar[XB_TMO])) break; if (sp > XB_SPIN_CAP) { atomicAdd(&bar[XB_TMO], 1u); break; } }
    }
    nloc = mine > 0u ? mine : 1u; nx = cnt > 0u ? cnt : 1u;
}
__device__ __forceinline__ void xcd_barrier(const XcdBarrier& b) {
    asm volatile("s_waitcnt vmcnt(0)" ::: "memory");
    __syncthreads();
    if (threadIdx.x == 0) {
        unsigned* bar = b.bar;
        __builtin_amdgcn_s_waitcnt(0);
        unsigned nloc = b.st[0], nx = b.st[1];
        if (nloc == 0u) { xcd_barrier_complete(bar, b.x, nloc, nx); b.st[0] = nloc; b.st[1] = nx; }
        const unsigned old = xb_add(&bar[XB_XSUB(b.x)], 1u);
        const unsigned gen = old / nloc;
        if (old + 1u == (gen + 1u) * nloc) {
            __builtin_amdgcn_fence(__ATOMIC_RELEASE, "agent");
            asm volatile("s_waitcnt vmcnt(0)" ::: "memory");
            const unsigned og = xb_add(&bar[XB_TOP], 1u);
            const unsigned tg = og / nx;
            if (og + 1u == (tg + 1u) * nx) xb_add(&bar[XB_TOPGEN], 1u);
            else XB_SPIN(xb_ld(&bar[XB_TOPGEN]) == tg, bar);
            __builtin_amdgcn_fence(__ATOMIC_ACQUIRE, "agent");
            xb_add(&bar[XB_XGEN(b.x)], 1u);
            asm volatile("s_waitcnt vmcnt(0)" ::: "memory");
        } else {
            XB_SPIN(xb_ld(&bar[XB_XGEN(b.x)]) == gen, bar);
            __builtin_amdgcn_fence(__ATOMIC_ACQUIRE, "agent");
            asm volatile("s_waitcnt vmcnt(0)" ::: "memory");
        }
    }
    __syncthreads();
}

namespace pg8 {
constexpr int BM = 256, BK = 64, HALF = 128, HTB = HALF * BK * 2, STAGE_BYTES = 8 * HTB, NXCD = 8, WGM = 8;
__device__ __forceinline__ int lds_byte(int r, int c) { const int st = (r >> 4) * 2 + (c >> 5), rr = r & 15, cc = c & 31, ob = rr * 64 + cc * 2; return st * 1024 + (ob ^ (((ob >> 9) & 1) << 5)); }
__device__ __forceinline__ void stage_rc(int b, int& R, int& C) { const int st = b / 1024, sb = b % 1024, swz = sb ^ (((sb >> 9) & 1) << 5); R = (st >> 1) * 16 + swz / 64; C = (st & 1) * 32 + (swz % 64) / 2; }
__device__ __forceinline__ int perm32(int rho) { const int n = rho >> 4, i = rho & 15; return 8 * (i >> 2) + 4 * n + (i & 3); }
struct Unit { int pm, pn; };
struct Prob {
    static constexpr bool ROWPERM = false;
    const bf16* A; const bf16* Bt; int lda, ldb, K, nM, nN, G, c; int a_group_shift, a_group_cols;
    size_t a_tile_stride, b_tile_stride;
    __device__ __forceinline__ void init(const bf16* A_, const bf16* Bt_, int lda_, int ldb_, int K_, int nM_, int nN_, int G_, int c_) {
        A = A_; Bt = Bt_; lda = lda_; ldb = ldb_; K = K_; nM = nM_; nN = nN_; G = G_; c = c_; a_group_shift = 0; a_group_cols = 0; a_tile_stride = (size_t)256 * lda_; b_tile_stride = (size_t)256 * ldb_; }
    __device__ __forceinline__ bool next(int i, Unit& u) const {
        const int nwg = nM * nN; const long L = (long)i * G + c; if (L >= nwg) return false;
        int wgid = (int)L; { const int q = nwg / NXCD, r = nwg % NXCD, xcd = wgid % NXCD, off = wgid / NXCD; wgid = (xcd < r ? xcd * (q + 1) : r * (q + 1) + (xcd - r) * q) + off; }
        const int nig = WGM * nN, gid = wgid / nig, fm = gid * WGM, gsz = (nM - fm) < WGM ? (nM - fm) : WGM;
        u.pm = fm + ((wgid % nig) % gsz); u.pn = (wgid % nig) / gsz; return true;
    }
    __device__ __forceinline__ const char* pa(const Unit& u) const { return (const char*)(A + (size_t)u.pm * a_tile_stride + (size_t)((u.pn >> a_group_shift) * a_group_cols)); }
    __device__ __forceinline__ const char* pb(const Unit& u) const { return (const char*)(Bt + (size_t)u.pn * b_tile_stride); }
};
struct ProbR : Prob { static constexpr bool ROWPERM = true; };
struct ProbSplit : Prob { int nA, nB;
    __device__ __forceinline__ bool next(int i, Unit& u) const {
        const int nwg = nM * nN, a = (c & 7) | ((c >> 4) << 3), grp = (c >> 3) & 1;
        if (i >= (grp ? nB : nA)) return false;
        const int L = (grp ? 128 * nA : 0) + i * 128 + a; if (L >= nwg) return false;
        int wgid = L; { const int q = nwg / NXCD, r = nwg % NXCD, xcd = wgid % NXCD, off = wgid / NXCD; wgid = (xcd < r ? xcd * (q + 1) : r * (q + 1) + (xcd - r) * q) + off; }
        const int nig = WGM * nN, gid = wgid / nig, fm = gid * WGM, gsz = (nM - fm) < WGM ? (nM - fm) : WGM;
        u.pm = fm + ((wgid % nig) % gsz); u.pn = (wgid % nig) / gsz; return true;
    } };
struct ProbC : Prob {
    __device__ __forceinline__ const char* pa(const Unit& u) const { return (const char*)(A + (size_t)u.pm * a_tile_stride + (size_t)u.pn * 512); }
    __device__ __forceinline__ const char* pb(const Unit& u) const { return (const char*)(Bt + (size_t)(u.pm >> 4) * 256 * 4096 + (size_t)u.pn * 512); } };
__device__ __forceinline__ unsigned cvt_pk_bf16(float lo, float hi) { unsigned r; asm volatile("v_cvt_pk_bf16_f32 %0, %1, %2" : "=v"(r) : "v"(lo), "v"(hi)); return r; }

template <class F> struct EpiP {
    static constexpr bool PERM = true; F f; const float* rowscale;
    __device__ __forceinline__ void operator()(const f32x4 (&acc)[2][2][4][2], const Unit& u, int wr, int wc, int fr, int fq) const {
        const int row0 = u.pm * BM + wr * 64 + fr, col0 = u.pn * BM + wc * 32 + 8 * fq;
#pragma unroll
        for (int ai = 0; ai < 2; ++ai)
#pragma unroll
            for (int m = 0; m < 4; ++m) { const int row = row0 + ai * HALF + m * 16; const float rs = rowscale ? rowscale[row] : 1.f;
#pragma unroll
                for (int bj = 0; bj < 2; ++bj) f(row, col0 + bj * HALF, acc[ai][bj][m][0] * rs, acc[ai][bj][m][1] * rs); }
    }
};
template <class F> struct EpiN {
    static constexpr bool PERM = false; F f; const float* rowscale;
    __device__ __forceinline__ void operator()(const f32x4 (&acc)[2][2][4][2], const Unit& u, int wr, int wc, int fr, int fq) const {
        const int row0 = u.pm * BM + wr * 64 + fr, col0 = u.pn * BM + wc * 32 + 4 * fq;
#pragma unroll
        for (int ai = 0; ai < 2; ++ai)
#pragma unroll
            for (int m = 0; m < 4; ++m) { const int row = row0 + ai * HALF + m * 16; const float rs = rowscale ? rowscale[row] : 1.f;
#pragma unroll
                for (int bj = 0; bj < 2; ++bj)
#pragma unroll
                    for (int n = 0; n < 2; ++n) f(row, col0 + bj * HALF + n * 16, acc[ai][bj][m][n] * rs); }
    }
};

#ifndef GEMM_REP
#define GEMM_REP 1
#endif
template <class PT, class Epi> __device__ __forceinline__ void gemm_phase_once(LAS unsigned char* lds, const PT& S, const Epi& E, bool epi_on);
template <class PT, class Epi>
__device__ __forceinline__ void gemm_phase(LAS unsigned char* lds, const PT& S, const Epi& E) {
    gemm_phase_once(lds, S, E, true);
}
template <class PT, class Epi>
__device__ __forceinline__ void gemm_phase_once(LAS unsigned char* lds, const PT& S, const Epi& E, bool epi_on) {
    const int tid = threadIdx.x, wid = __builtin_amdgcn_readfirstlane(tid >> 6), lane = tid & 63, wr = wid >> 2, wc = wid & 3, fr = lane & 15, fq = lane >> 4;
    const int K = S.K, nt = K / BK, lda = S.lda, ldb = S.ldb;
    unsigned voffA[2], voffB[2];
#pragma unroll
    for (int i = 0; i < 2; ++i) { int R, C; stage_rc(tid * 16 + i * 8192, R, C); const int Rb = Epi::PERM ? ((R & ~31) + perm32(R & 31)) : R;
        const int Ra = PT::ROWPERM ? (128 * (R >> 6) + 8 * (R & 15) + ((R >> 4) & 3)) : R;
        voffA[i] = (unsigned)(Ra * lda + C) * 2u; voffB[i] = (unsigned)(Rb * ldb + C) * 2u; }
    const size_t kstep = (size_t)(BK * 2);
    const size_t hstepA = (size_t)(PT::ROWPERM ? 4 : HALF) * lda * 2, hstepB = (size_t)HALF * ldb * 2;
    const unsigned ldsw = (unsigned)wid * 1024u;
    const int aoff = lds_byte(wr * 64 + fr, fq * 8), boff = lds_byte(wc * 32 + fr, fq * 8);
#define PG8_SA(b, h) (((b) * 2 + (h)) * HTB)
#define PG8_SB(b, h) ((4 + (b) * 2 + (h)) * HTB)
#define PG8_STAGE(bufoff, gbase, voff) do { _Pragma("unroll") for (int _i = 0; _i < 2; ++_i) \
        __builtin_amdgcn_global_load_lds((const unsigned*)((const char*)(gbase) + (voff)[_i]), (LAS unsigned*)(lds + (bufoff) + ldsw + _i * 8192), 16, 0, 0); } while (0)
#define PG8_LDA(dst, b, h) do { _Pragma("unroll") for (int m = 0; m < 4; ++m) _Pragma("unroll") for (int k = 0; k < 2; ++k) dst[m][k] = *(const LAS bf16x8*)(lds + PG8_SA(b, h) + aoff + m * 2048 + k * 1024); } while (0)
#define PG8_LDB(dst, b, h) do { _Pragma("unroll") for (int n = 0; n < 2; ++n) _Pragma("unroll") for (int k = 0; k < 2; ++k) dst[n][k] = *(const LAS bf16x8*)(lds + PG8_SB(b, h) + boff + n * 2048 + k * 1024); } while (0)
#define PG8_MMA(ai, bj, At, Bt) do { __builtin_amdgcn_s_setprio(1); _Pragma("unroll") for (int m = 0; m < 4; ++m) _Pragma("unroll") for (int n = 0; n < 2; ++n) _Pragma("unroll") for (int k = 0; k < 2; ++k) \
        acc[ai][bj][m][n] = __builtin_amdgcn_mfma_f32_16x16x32_bf16(Bt[n][k], At[m][k], acc[ai][bj][m][n], 0, 0, 0); __builtin_amdgcn_s_setprio(0); } while (0)
#define PG8_WAIT_V(n) asm volatile("s_waitcnt vmcnt(" #n ")" ::: "memory")
#define PG8_WAIT_L(n) asm volatile("s_waitcnt lgkmcnt(" #n ")" ::: "memory")
#define PG8_BAR __builtin_amdgcn_s_barrier()
#define PG8_SCHED __builtin_amdgcn_sched_barrier(0)
    Unit cur, nxt; int ui = 0;
    if (!S.next(0, cur)) return;
    f32x4 acc[2][2][4][2];
#pragma unroll
    for (int a = 0; a < 2; ++a)
#pragma unroll
        for (int b = 0; b < 2; ++b)
#pragma unroll
            for (int m = 0; m < 4; ++m)
#pragma unroll
                for (int n = 0; n < 2; ++n) acc[a][b][m][n] = (f32x4){0.f, 0.f, 0.f, 0.f};
    bf16x8 At[4][2], B0[2][2], B1[2][2];
    const char* cA = S.pa(cur); const char* cB = S.pb(cur);
    PG8_STAGE(PG8_SB(0, 0), cB, voffB); PG8_STAGE(PG8_SA(0, 0), cA, voffA); PG8_STAGE(PG8_SB(0, 1), cB + hstepB, voffB); PG8_STAGE(PG8_SA(0, 1), cA + hstepA, voffA);
    if (wr == 1) PG8_BAR;
    PG8_WAIT_V(4); PG8_BAR;
    PG8_STAGE(PG8_SB(1, 0), cB + kstep, voffB); PG8_STAGE(PG8_SA(1, 0), cA + kstep, voffA); PG8_STAGE(PG8_SB(1, 1), cB + hstepB + kstep, voffB);
    PG8_WAIT_V(6); PG8_BAR;
    for (;;) {
        const bool has_next = S.next(ui + 1, nxt);
        const char* nA = has_next ? S.pa(nxt) : cA; const char* nB = has_next ? S.pb(nxt) : cB;
        for (int t = 0; t < nt; t += 2) {
            const bool last = (t == nt - 2);
            const char* a1 = cA + (size_t)(t + 1) * kstep;
            const char* a2 = last ? nA : cA + (size_t)(t + 2) * kstep; const char* b2 = last ? nB : cB + (size_t)(t + 2) * kstep;
            const char* a3 = a2 + kstep; const char* b3 = b2 + kstep;
            PG8_LDB(B0, 0, 0); PG8_SCHED; PG8_LDA(At, 0, 0); PG8_STAGE(PG8_SA(1, 1), a1 + hstepA, voffA);
            PG8_WAIT_L(8); PG8_BAR; PG8_WAIT_L(0); PG8_MMA(0, 0, At, B0); PG8_BAR; PG8_SCHED;
            PG8_LDB(B1, 0, 1); PG8_STAGE(PG8_SB(0, 0), b2, voffB);
            PG8_BAR; PG8_WAIT_L(0); PG8_MMA(0, 1, At, B1); PG8_BAR;
            PG8_LDA(At, 0, 1); PG8_STAGE(PG8_SA(0, 0), a2, voffA);
            PG8_BAR; PG8_WAIT_L(0); PG8_MMA(1, 0, At, B0); PG8_BAR; PG8_SCHED;
            PG8_STAGE(PG8_SB(0, 1), b2 + hstepB, voffB);
            PG8_WAIT_V(6); PG8_BAR; PG8_MMA(1, 1, At, B1); PG8_BAR;
            PG8_LDB(B0, 1, 0); PG8_SCHED; PG8_LDA(At, 1, 0); PG8_STAGE(PG8_SA(0, 1), a2 + hstepA, voffA);
            PG8_WAIT_L(8); PG8_BAR; PG8_WAIT_L(0); PG8_MMA(0, 0, At, B0); PG8_BAR; PG8_SCHED;
            PG8_LDB(B1, 1, 1); PG8_STAGE(PG8_SB(1, 0), b3, voffB);
            PG8_BAR; PG8_WAIT_L(0); PG8_MMA(0, 1, At, B1); PG8_BAR;
            PG8_LDA(At, 1, 1); PG8_STAGE(PG8_SA(1, 0), a3, voffA);
            PG8_BAR; PG8_WAIT_L(0); PG8_MMA(1, 0, At, B0); PG8_BAR; PG8_SCHED;
            PG8_STAGE(PG8_SB(1, 1), b3 + hstepB, voffB);
            PG8_WAIT_V(6); PG8_BAR; PG8_MMA(1, 1, At, B1); PG8_BAR;
        }
        if (epi_on) E(acc, cur, wr, wc, fr, fq);
        if (!has_next) break;
#pragma unroll
        for (int a = 0; a < 2; ++a)
#pragma unroll
            for (int b = 0; b < 2; ++b)
#pragma unroll
                for (int m = 0; m < 4; ++m)
#pragma unroll
                    for (int n = 0; n < 2; ++n) acc[a][b][m][n] = (f32x4){0.f, 0.f, 0.f, 0.f};
        cur = nxt; cA = nA; cB = nB; ++ui;
    }
    PG8_WAIT_V(0);
    if (wr == 0) PG8_BAR;
    PG8_BAR;
#undef PG8_SA
#undef PG8_SB
#undef PG8_STAGE
#undef PG8_LDA
#undef PG8_LDB
#undef PG8_MMA
#undef PG8_WAIT_V
#undef PG8_WAIT_L
#undef PG8_BAR
#undef PG8_SCHED
}
}

struct StBf16 { bf16* O; int ldc;
    __device__ __forceinline__ void operator()(int row, int col, f32x4 v0, f32x4 v1) const {
        v4u w; w.x = pg8::cvt_pk_bf16(v0[0], v0[1]); w.y = pg8::cvt_pk_bf16(v0[2], v0[3]); w.z = pg8::cvt_pk_bf16(v1[0], v1[1]); w.w = pg8::cvt_pk_bf16(v1[2], v1[3]);
        *(v4u*)(O + (size_t)row * ldc + col) = w; } };
struct StBf16BiasGelu { bf16* O; int ldc; const float* bias;
    __device__ __forceinline__ void operator()(int row, int col, f32x4 v0, f32x4 v1) const {
        const f32x4 b0 = *(const f32x4*)(bias + col), b1 = *(const f32x4*)(bias + col + 4);
#pragma unroll
        for (int j = 0; j < 4; ++j) { v0[j] = gelu_tanh(v0[j] + b0[j]); v1[j] = gelu_tanh(v1[j] + b1[j]); }
        v4u w; w.x = pg8::cvt_pk_bf16(v0[0], v0[1]); w.y = pg8::cvt_pk_bf16(v0[2], v0[3]); w.z = pg8::cvt_pk_bf16(v1[0], v1[1]); w.w = pg8::cvt_pk_bf16(v1[2], v1[3]);
        *(v4u*)(O + (size_t)row * ldc + col) = w; } };
struct StBf16Scale { bf16* O; int ldc; const float* scale;
    __device__ __forceinline__ void operator()(int row, int col, f32x4 v0, f32x4 v1) const {
        const f32x4 b0 = *(const f32x4*)(scale + col), b1 = *(const f32x4*)(scale + col + 4);
        v0 = v0 * b0; v1 = v1 * b1;
        v4u w; w.x = pg8::cvt_pk_bf16(v0[0], v0[1]); w.y = pg8::cvt_pk_bf16(v0[2], v0[3]); w.z = pg8::cvt_pk_bf16(v1[0], v1[1]); w.w = pg8::cvt_pk_bf16(v1[2], v1[3]);
        *(v4u*)(O + (size_t)row * ldc + col) = w; } };
struct StF32 { float* C; int ldc;
    __device__ __forceinline__ void operator()(int row, int col, f32x4 v) const { *(f32x4*)(C + (size_t)row * ldc + col) = v; } };
struct StNsa { bf16* Q; bf16* T; float* Gt;
    __device__ __forceinline__ void operator()(int row, int col, f32x4 v0, f32x4 v1) const {
        v4u w; w.x = pg8::cvt_pk_bf16(v0[0], v0[1]); w.y = pg8::cvt_pk_bf16(v0[2], v0[3]); w.z = pg8::cvt_pk_bf16(v1[0], v1[1]); w.w = pg8::cvt_pk_bf16(v1[2], v1[3]);
        if (col < 2048) { *(v4u*)(Q + (size_t)row * 2048 + col) = w; }
        else if (col < 5120) { const int c2 = col - 2048, ten = c2 >> 9, g = (c2 >> 7) & 3, d = c2 & 127, b = row >> 12, t = row & 4095;
            *(v4u*)(T + (size_t)ten * NT_STRIDE + ((size_t)((b * 4 + g) * 4096 + t)) * 128 + d) = w; }
        else if (col < 5168) { float* p = Gt + (size_t)row * 48 + (col - 5120); *(f32x4*)p = v0; *(f32x4*)(p + 4) = v1; }
    } };
struct StKv { bf16* KV; bf16* XVT;
    __device__ __forceinline__ void operator()(int row, int col, f32x4 v0, f32x4 v1) const {
        if (col < 512) { v4u w; w.x = pg8::cvt_pk_bf16(v0[0], v0[1]); w.y = pg8::cvt_pk_bf16(v0[2], v0[3]); w.z = pg8::cvt_pk_bf16(v1[0], v1[1]); w.w = pg8::cvt_pk_bf16(v1[2], v1[3]); *(v4u*)(KV + (size_t)row * 1024 + col) = w; }
        else { const int c2 = col - 512, b = row >> 8, m = row & 255; bf16* p = XVT + ((size_t)(b * 4 + (c2 >> 7)) * 128 + (c2 & 127)) * 256 + m;
#pragma unroll
            for (int j = 0; j < 4; ++j) { p[(size_t)j * 256] = (bf16)f2bf(v0[j]); p[(size_t)(4 + j) * 256] = (bf16)f2bf(v1[j]); } }
    } };
struct StHid { bf16* O; const float* pb;
    __device__ __forceinline__ void operator()(int row, int col, f32x4 v0, f32x4 v1) const {
        const int ten = row >> 12; const float* bias = pb + ten * 256 + col;
        const f32x4 b0 = *(const f32x4*)(bias), b1 = *(const f32x4*)(bias + 4);
#pragma unroll
        for (int j = 0; j < 4; ++j) { v0[j] = gelu_tanh(v0[j] + b0[j]); v1[j] = gelu_tanh(v1[j] + b1[j]); }
        v4u w; w.x = pg8::cvt_pk_bf16(v0[0], v0[1]); w.y = pg8::cvt_pk_bf16(v0[2], v0[3]); w.z = pg8::cvt_pk_bf16(v1[0], v1[1]); w.w = pg8::cvt_pk_bf16(v1[2], v1[3]);
        *(v4u*)(O + (size_t)row * 256 + col) = w; } };

struct Ctx { LAS unsigned char* lds; int tid, lane, wave, vcu, G, gw, NGW; };
__device__ __forceinline__ Ctx opq(const Ctx& c) { Ctx r = c; asm volatile("" : "+v"(r.tid), "+v"(r.lane)); r.tid &= 511; r.lane &= 63; return r; }
__device__ __forceinline__ float dpp_shr1(float x) { return __builtin_bit_cast(float, __builtin_amdgcn_update_dpp(0, __builtin_bit_cast(int, x), 0x111, 0xf, 0xf, true)); }
struct EpiFfn {
    static constexpr bool PERM = true;
    bf16* ACT; bf16* HALO; const float* RS; const float* cw; const float* cb;
    __device__ __forceinline__ void operator()(const f32x4 (&acc)[2][2][4][2], const pg8::Unit& u, int wr, int wc, int fr, int fq) const {
        const int ch0 = 128 * u.pn + 32 * wc + 8 * fq, tok0 = 256 * u.pm + 128 * wr + 8 * fr;
        const f32x4 r0 = *(const f32x4*)(RS + tok0), r1 = *(const f32x4*)(RS + tok0 + 4);
        bf16* hb = HALO + ((size_t)((u.pm * 44 + u.pn) * 2 + wr) * 4) * 256 + 32 * wc + 8 * fq;
#pragma unroll
        for (int n = 0; n < 2; ++n) {
            float g[8][4], v[8][4];
#pragma unroll
            for (int e = 0; e < 8; ++e) { const float rs = (e < 4) ? r0[e & 3] : r1[e & 3];
#pragma unroll
                for (int jj = 0; jj < 4; ++jj) { g[e][jj] = acc[e >> 2][0][e & 3][n][jj] * rs; v[e][jj] = acc[e >> 2][1][e & 3][n][jj] * rs; } }
            if (fr == 0) {
#pragma unroll
                for (int q = 0; q < 2; ++q) { v2u a, b; a.x = pk2(g[q][0], g[q][1]); a.y = pk2(g[q][2], g[q][3]); b.x = pk2(v[q][0], v[q][1]); b.y = pk2(v[q][2], v[q][3]);
                    *(v2u*)(hb + (size_t)q * 256 + 4 * n) = a; *(v2u*)(hb + (size_t)q * 256 + 128 + 4 * n) = b; } }
            if (fr == 15) {
#pragma unroll
                for (int q = 0; q < 2; ++q) { v2u a, b; a.x = pk2(g[6 + q][0], g[6 + q][1]); a.y = pk2(g[6 + q][2], g[6 + q][3]); b.x = pk2(v[6 + q][0], v[6 + q][1]); b.y = pk2(v[6 + q][2], v[6 + q][3]);
                    *(v2u*)(hb + (size_t)(2 + q) * 256 + 4 * n) = a; *(v2u*)(hb + (size_t)(2 + q) * 256 + 128 + 4 * n) = b; } }
            const int cc = ch0 + 4 * n;
            const f32x4 wg0 = *(const f32x4*)(cw + cc), wg1 = *(const f32x4*)(cw + FF2 + cc), wg2 = *(const f32x4*)(cw + 2 * FF2 + cc), wv0 = *(const f32x4*)(cw + FFH + cc), wv1 = *(const f32x4*)(cw + FF2 + FFH + cc), wv2 = *(const f32x4*)(cw + 2 * FF2 + FFH + cc);
            const f32x4 bg = *(const f32x4*)(cb + cc), bv = *(const f32x4*)(cb + FFH + cc);
#pragma unroll
            for (int jj = 0; jj < 4; ++jj) {
                float g2 = dpp_shr1(g[6][jj]), g1 = dpp_shr1(g[7][jj]), v2 = dpp_shr1(v[6][jj]), v1 = dpp_shr1(v[7][jj]);
#pragma unroll
                for (int e = 0; e < 8; ++e) { const float g0 = g[e][jj], v0 = v[e][jj];
                    const float cg = bg[jj] + wg0[jj] * g2 + wg1[jj] * g1 + wg2[jj] * g0, cv = bv[jj] + wv0[jj] * v2 + wv1[jj] * v1 + wv2[jj] * v0;
                    g[e][jj] = silu_fast(cg) * cv; g2 = g1; g1 = g0; v2 = v1; v1 = v0; } }
#pragma unroll
            for (int e = 0; e < 8; ++e) { v2u w; w.x = pk2(g[e][0], g[e][1]); w.y = pk2(g[e][2], g[e][3]); *(v2u*)(ACT + (size_t)(tok0 + e) * FFH + cc) = w; }
        }
    }
};
__device__ __forceinline__ void ffn_fixup(const Ctx& c, const bf16* HALO, const float* cw, const float* cb, bf16* ACT) {
    for (int it = c.vcu * 512 + c.tid; it < 64 * 44 * 2 * 16; it += c.G * 512) {
        const int cg8 = it & 15, wr = (it >> 4) & 1, tile = it >> 5, pm = tile / 44, pn = tile % 44, ch0 = 128 * pn + 8 * cg8;
        const bf16* cur = HALO + ((size_t)(tile * 2 + wr) * 4) * 256 + 8 * cg8;
        const bool hasprev = wr == 1 || (pm & 15) != 0; const bf16* prv = wr == 1 ? HALO + ((size_t)(tile * 2) * 4 + 2) * 256 + 8 * cg8 : HALO + ((size_t)((tile - 44) * 2 + 1) * 4 + 2) * 256 + 8 * cg8;
        const v4u z4 = (v4u){0u, 0u, 0u, 0u};
        const v4u cg0 = *(const v4u*)cur, cv0 = *(const v4u*)(cur + 128), cg1 = *(const v4u*)(cur + 256), cv1 = *(const v4u*)(cur + 256 + 128);
        const v4u pg2 = hasprev ? *(const v4u*)prv : z4, pv2 = hasprev ? *(const v4u*)(prv + 128) : z4, pg3 = hasprev ? *(const v4u*)(prv + 256) : z4, pv3 = hasprev ? *(const v4u*)(prv + 256 + 128) : z4;
        float oa[8], ob[8];
#pragma unroll
        for (int j = 0; j < 8; ++j) { const int q = j >> 1; const bool hi = j & 1;
            const float wg0 = cw[ch0 + j], wg1 = cw[FF2 + ch0 + j], wg2 = cw[2 * FF2 + ch0 + j], wv0 = cw[FFH + ch0 + j], wv1 = cw[FF2 + FFH + ch0 + j], wv2 = cw[2 * FF2 + FFH + ch0 + j], bg = cb[ch0 + j], bv = cb[FFH + ch0 + j];
            const float gA2 = hi ? bfhi(pg2[q]) : bflo(pg2[q]), gA1 = hi ? bfhi(pg3[q]) : bflo(pg3[q]), gA0 = hi ? bfhi(cg0[q]) : bflo(cg0[q]), gB0 = hi ? bfhi(cg1[q]) : bflo(cg1[q]);
            const float vA2 = hi ? bfhi(pv2[q]) : bflo(pv2[q]), vA1 = hi ? bfhi(pv3[q]) : bflo(pv3[q]), vA0 = hi ? bfhi(cv0[q]) : bflo(cv0[q]), vB0 = hi ? bfhi(cv1[q]) : bflo(cv1[q]);
            oa[j] = siluf_(bg + wg0 * gA2 + wg1 * gA1 + wg2 * gA0) * (bv + wv0 * vA2 + wv1 * vA1 + wv2 * vA0);
            ob[j] = siluf_(bg + wg0 * gA1 + wg1 * gA0 + wg2 * gB0) * (bv + wv0 * vA1 + wv1 * vA0 + wv2 * vB0); }
        const size_t tok = (size_t)256 * pm + 128 * wr;
        v4u w; w.x = pk2(oa[0], oa[1]); w.y = pk2(oa[2], oa[3]); w.z = pk2(oa[4], oa[5]); w.w = pk2(oa[6], oa[7]); *(v4u*)(ACT + tok * FFH + ch0) = w;
        w.x = pk2(ob[0], ob[1]); w.y = pk2(ob[2], ob[3]); w.z = pk2(ob[4], ob[5]); w.w = pk2(ob[6], ob[7]); *(v4u*)(ACT + (tok + 1) * FFH + ch0) = w;
    }
}


__device__ __forceinline__ void conv_w(const Ctx& c, const float* W, int K, int N, int Npad, bf16* WT, const float* gain = nullptr, bool ffnmap = false, int gw_ = -1, int ngw_ = 0) {
    LAS float* scr = (LAS float*)(c.lds + c.wave * 16640);
    const int nblk = Npad / 64, items = (K / 64) * nblk, lane = c.lane;
#if PROBE == 5
#pragma unroll 1
    for (int rep_ = 0; rep_ < 2; ++rep_)
#endif
    const int gw0 = gw_ >= 0 ? gw_ : c.gw, ngw = gw_ >= 0 ? ngw_ : c.NGW;
    for (int it = gw0; it < items; it += ngw) {
        const int kb = it / nblk, nb = it % nblk, k0 = 64 * kb, n0 = 64 * nb, nq = (lane & 15) * 4, kr = lane >> 4; const bool ok = (n0 + nq) < N;
        f32x4 v[16];
#pragma unroll
        for (int i = 0; i < 16; ++i) v[i] = ok ? __builtin_nontemporal_load((const f32x4*)(W + (size_t)(k0 + 4 * i + kr) * N + n0 + nq)) : (f32x4){0.f, 0.f, 0.f, 0.f};
        if (gain) {
#pragma unroll
            for (int i = 0; i < 16; ++i) v[i] *= gain[k0 + 4 * i + kr]; }
#pragma unroll
        for (int i = 0; i < 16; ++i) { LAS float* d = scr + (4 * i + kr) * 65 + nq; d[0] = v[i].x; d[1] = v[i].y; d[2] = v[i].z; d[3] = v[i].w; }
        LDS_WAIT(); asm volatile("" ::: "memory");
        const int c8 = lane & 7; int d0 = n0;
        if (ffnmap) { const int bj = n0 >= FFH ? 1 : 0, chn = n0 - FFH * bj; d0 = 256 * (chn >> 7) + 128 * bj + (chn & 127); }
#pragma unroll
        for (int j = 0; j < 8; ++j) { const int n = (lane >> 3) + 8 * j; const LAS float* sp = scr + (8 * c8) * 65 + n;
            v4u o; o.x = pk2(sp[0 * 65], sp[1 * 65]); o.y = pk2(sp[2 * 65], sp[3 * 65]); o.z = pk2(sp[4 * 65], sp[5 * 65]); o.w = pk2(sp[6 * 65], sp[7 * 65]);
            *(v4u*)(WT + (size_t)(d0 + n) * K + k0 + 8 * c8) = o; }
        LDS_WAIT(); asm volatile("" ::: "memory");
    }
}

__device__ __forceinline__ void rms_row_bf16(const Ctx& c, const float* xrow, const float* gain, bf16* orow, float* copy) {
    const f32x4* xr = (const f32x4*)xrow + c.lane; f32x4 v[8]; float s = 0.f;
#pragma unroll
    for (int j = 0; j < 8; ++j) { v[j] = xr[64 * j]; s += (v[j].x * v[j].x + v[j].y * v[j].y) + (v[j].z * v[j].z + v[j].w * v[j].w); }
    const float rs = rsqrtf(wave_sum(s) * (1.f / DM) + EPS);
    if (copy) {
#pragma unroll
        for (int j = 0; j < 8; ++j) ((f32x4*)copy + c.lane)[64 * j] = v[j]; }
    const f32x4* gr = (const f32x4*)gain + c.lane; v2u* o8 = (v2u*)orow + c.lane;
#pragma unroll
    for (int j = 0; j < 8; ++j) { const f32x4 g = gr[64 * j]; v2u o; o.x = pk2(v[j].x * rs * g.x, v[j].y * rs * g.y); o.y = pk2(v[j].z * rs * g.z, v[j].w * rs * g.w); o8[64 * j] = o; }
}
__device__ __forceinline__ void postnorm(const Ctx& c, const bf16* MF, bf16* XB, float* RS, const float* gpost, float* OUT) {
    for (int row = c.gw; row < MT; row += c.NGW) {
        const v4u* mr = (const v4u*)(MF + (size_t)row * DM) + c.lane; v4u* xr = (v4u*)(XB + (size_t)row * DM) + c.lane;
        v4u mv[4], xv[4]; float v[4][8]; float s = 0.f;
#pragma unroll
        for (int j = 0; j < 4; ++j) { mv[j] = mr[64 * j]; xv[j] = xr[64 * j]; }
#pragma unroll
        for (int j = 0; j < 4; ++j)
#pragma unroll
            for (int k = 0; k < 4; ++k) { v[j][2 * k] = bflo(mv[j][k]); v[j][2 * k + 1] = bfhi(mv[j][k]); s += v[j][2 * k] * v[j][2 * k] + v[j][2 * k + 1] * v[j][2 * k + 1]; }
        const float rs = rsqrtf(wave_sum(s) * (1.f / DM) + EPS);
        float s2 = 0.f;
#pragma unroll
        for (int j = 0; j < 4; ++j) { const float* gp = gpost + (c.lane + 64 * j) * 8; const f32x4 g0 = *(const f32x4*)gp, g1 = *(const f32x4*)(gp + 4);
#pragma unroll
            for (int k = 0; k < 4; ++k) { const float ga = (k < 2) ? g0[2 * k] : g1[2 * k - 4], gb = (k < 2) ? g0[2 * k + 1] : g1[2 * k - 3];
                v[j][2 * k] = bflo(xv[j][k]) + v[j][2 * k] * rs * ga; v[j][2 * k + 1] = bfhi(xv[j][k]) + v[j][2 * k + 1] * rs * gb;
                s2 += v[j][2 * k] * v[j][2 * k] + v[j][2 * k + 1] * v[j][2 * k + 1]; } }
        if (OUT) {
#pragma unroll
            for (int j = 0; j < 4; ++j) { float* op = OUT + (size_t)row * DM + (c.lane + 64 * j) * 8; *(f32x4*)op = (f32x4){v[j][0], v[j][1], v[j][2], v[j][3]}; *(f32x4*)(op + 4) = (f32x4){v[j][4], v[j][5], v[j][6], v[j][7]}; }
        } else {
#pragma unroll
            for (int j = 0; j < 4; ++j) { v4u o; o.x = pk2(v[j][0], v[j][1]); o.y = pk2(v[j][2], v[j][3]); o.z = pk2(v[j][4], v[j][5]); o.w = pk2(v[j][6], v[j][7]); xr[64 * j] = o; }
            const float rs2 = rsqrtf(wave_sum(s2) * (1.f / DM) + EPS); if (c.lane == 0) RS[row] = rs2;
        }
    }
}
__device__ __forceinline__ void x_to_xb(const Ctx& c, const float* X, bf16* XB, float* RS) {
    for (int row = c.gw; row < MT; row += c.NGW) {
        const f32x4* xr = (const f32x4*)(X + (size_t)row * DM) + c.lane; f32x4 v[8]; float s = 0.f;
#pragma unroll
        for (int j = 0; j < 8; ++j) { v[j] = xr[64 * j]; s += (v[j].x * v[j].x + v[j].y * v[j].y) + (v[j].z * v[j].z + v[j].w * v[j].w); }
        const float rs = rsqrtf(wave_sum(s) * (1.f / DM) + EPS); if (c.lane == 0) RS[row] = rs;
        v2u* o8 = (v2u*)(XB + (size_t)row * DM) + c.lane;
#pragma unroll
        for (int j = 0; j < 8; ++j) { v2u o; o.x = pk2(v[j].x, v[j].y); o.y = pk2(v[j].z, v[j].w); o8[64 * j] = o; }
    }
}

__device__ __forceinline__ void ffn_convact(const Ctx& c, const bf16* U, const float* cw, const float* cb, bf16* ACT) {
    const int NCG = FFH / 8, items = (MT / 8) * NCG;
    for (int it = c.vcu * 512 + c.tid; it < items; it += c.G * 512) {
        const int rb = it / NCG, cg = it % NCG, c0 = cg * 8, row0 = rb * 8, t0 = row0 & (SEQ - 1);
        v4u ga[10], va[10];
#pragma unroll
        for (int i = 0; i < 10; ++i) { const bool ok = (i >= 2) || (t0 != 0); const size_t r = (size_t)(row0 + i - 2);
            ga[i] = ok ? *(const v4u*)(U + r * FF2 + c0) : (v4u){0u, 0u, 0u, 0u}; va[i] = ok ? *(const v4u*)(U + r * FF2 + FFH + c0) : (v4u){0u, 0u, 0u, 0u}; }
        float wg[3][8], wv[3][8], bg[8], bv[8];
#pragma unroll
        for (int k = 0; k < 3; ++k) { const f32x4 a0 = *(const f32x4*)(cw + k * FF2 + c0), a1 = *(const f32x4*)(cw + k * FF2 + c0 + 4), b0 = *(const f32x4*)(cw + k * FF2 + FFH + c0), b1 = *(const f32x4*)(cw + k * FF2 + FFH + c0 + 4);
#pragma unroll
            for (int j = 0; j < 4; ++j) { wg[k][j] = a0[j]; wg[k][4 + j] = a1[j]; wv[k][j] = b0[j]; wv[k][4 + j] = b1[j]; } }
        { const f32x4 a0 = *(const f32x4*)(cb + c0), a1 = *(const f32x4*)(cb + c0 + 4), b0 = *(const f32x4*)(cb + FFH + c0), b1 = *(const f32x4*)(cb + FFH + c0 + 4);
#pragma unroll
          for (int j = 0; j < 4; ++j) { bg[j] = a0[j]; bg[4 + j] = a1[j]; bv[j] = b0[j]; bv[4 + j] = b1[j]; } }
#pragma unroll
        for (int i = 0; i < 8; ++i) {
            float o[8];
#pragma unroll
            for (int j = 0; j < 8; ++j) { const int q = j >> 1;
                const float g2 = (j & 1) ? bfhi(ga[i][q]) : bflo(ga[i][q]), g1 = (j & 1) ? bfhi(ga[i + 1][q]) : bflo(ga[i + 1][q]), g0 = (j & 1) ? bfhi(ga[i + 2][q]) : bflo(ga[i + 2][q]);
                const float v2 = (j & 1) ? bfhi(va[i][q]) : bflo(va[i][q]), v1 = (j & 1) ? bfhi(va[i + 1][q]) : bflo(va[i + 1][q]), v0 = (j & 1) ? bfhi(va[i + 2][q]) : bflo(va[i + 2][q]);
                const float cgv = bg[j] + wg[0][j] * g2 + wg[1][j] * g1 + wg[2][j] * g0, cvv = bv[j] + wv[0][j] * v2 + wv[1][j] * v1 + wv[2][j] * v0;
                o[j] = siluf_(cgv) * cvv; }
            v4u w; w.x = pk2(o[0], o[1]); w.y = pk2(o[2], o[3]); w.z = pk2(o[4], o[5]); w.w = pk2(o[6], o[7]);
            *(v4u*)(ACT + (size_t)(row0 + i) * FFH + c0) = w;
        }
    }
}

__device__ __forceinline__ void ssd_conv(const Ctx& c, const bf16* P, const float* cw, const float* cb, const float* dtb, bf16* X2, float* DT) {
    const int NC = 6144, NCG = NC / 8, items = (MT / 8) * NCG;
    for (int it = c.vcu * 512 + c.tid; it < items; it += c.G * 512) {
        const int rb = it / NCG, cg = it % NCG, c0 = cg * 8, row0 = rb * 8, t0 = row0 & (SEQ - 1);
        v4u xa[11];
#pragma unroll
        for (int i = 0; i < 11; ++i) { const bool ok = (i >= 3) || (t0 != 0); xa[i] = ok ? *(const v4u*)(P + (size_t)(row0 + i - 3) * SSD_NP + 4096 + c0) : (v4u){0u, 0u, 0u, 0u}; }
        float w[4][8], bb[8];
#pragma unroll
        for (int k = 0; k < 4; ++k) { const f32x4 a0 = *(const f32x4*)(cw + k * NC + c0), a1 = *(const f32x4*)(cw + k * NC + c0 + 4);
#pragma unroll
            for (int j = 0; j < 4; ++j) { w[k][j] = a0[j]; w[k][4 + j] = a1[j]; } }
        { const f32x4 a0 = *(const f32x4*)(cb + c0), a1 = *(const f32x4*)(cb + c0 + 4);
#pragma unroll
          for (int j = 0; j < 4; ++j) { bb[j] = a0[j]; bb[4 + j] = a1[j]; } }
#pragma unroll
        for (int i = 0; i < 8; ++i) {
            float o[8];
#pragma unroll
            for (int j = 0; j < 8; ++j) { const int q = j >> 1; float y = bb[j];
#pragma unroll
                for (int k = 0; k < 4; ++k) y += w[k][j] * ((j & 1) ? bfhi(xa[i + k][q]) : bflo(xa[i + k][q]));
                o[j] = silu_fast(y); }
            v4u wv; wv.x = pk2(o[0], o[1]); wv.y = pk2(o[2], o[3]); wv.z = pk2(o[4], o[5]); wv.w = pk2(o[6], o[7]);
            *(v4u*)(X2 + (size_t)(row0 + i) * NC + c0) = wv;
        }
    }
    for (int it = c.vcu * 512 + c.tid; it < MT * 64; it += c.G * 512) {
        const int row = it >> 6, h = it & 63; const float raw = bflo((unsigned)P[(size_t)row * SSD_NP + 10240 + h]) + dtb[h];
        DT[it] = raw > 20.f ? raw : log1pf(expf(raw));
    }
}

__device__ __forceinline__ s16x4 tr16(const LAS unsigned char* p) { return __builtin_amdgcn_ds_read_tr16_b64_v4i16((LAS s16x4*)p); }
__device__ __forceinline__ bf16x8 cat8(s16x4 a, s16x4 b) { bf16x8 r; r[0] = a[0]; r[1] = a[1]; r[2] = a[2]; r[3] = a[3]; r[4] = b[0]; r[5] = b[1]; r[6] = b[2]; r[7] = b[3]; return r; }
__device__ __forceinline__ void ssd_scan_mfma(const Ctx& c, bf16* X2, const float* DT, const float* a_log, const float* dskip, bool do_store) {
    constexpr int SS_B = 0, SS_C = 17408, SS_XR = 34816, SS_XD = 44032, SS_XW = 53248, SS_SB = 62464  , SS_CS = 97280  , SS_DTS = 97792  ;
    LAS unsigned char* L = c.lds;
    const int tid = c.tid, lane = c.lane, l15 = lane & 15, lg = lane >> 4, w = c.wave, lt = w >> 1, ph = w & 1, tq = l15 >> 2, tp = l15 & 3;
    for (int u = c.vcu; u < NB * 64; u += c.G) {
        const int b = u >> 6, h = u & 63, g = h >> 3; const float Ah = -expf(a_log[h]), Dh = dskip[h];
        f32x4 ST[4];
#pragma unroll
        for (int i = 0; i < 4; ++i) ST[i] = (f32x4){0.f, 0.f, 0.f, 0.f};
        __syncthreads();
        for (int i = tid; i < 17408 / 16; i += 512) *(LAS v4u*)(L + SS_SB + i * 16) = (v4u){0u, 0u, 0u, 0u};
        v4u rB[2], rC[2], rXR; float rdt = 0.f;
        const bf16* x2b = X2 + (size_t)b * SEQ * 6144;
#define SSD_LOAD(t0_) do { _Pragma("unroll") for (int e = 0; e < 2; ++e) { const int cc = tid + 512 * e; \
            rB[e] = *(const v4u*)(x2b + (size_t)((t0_) + (cc >> 4)) * 6144 + 4096 + g * 128 + (cc & 15) * 8); rC[e] = *(const v4u*)(x2b + (size_t)((t0_) + (cc >> 4)) * 6144 + 5120 + g * 128 + (cc & 15) * 8); } \
            rXR = *(const v4u*)(x2b + (size_t)((t0_) + (tid >> 3)) * 6144 + h * 64 + (tid & 7) * 8); } while (0)
#define SSD_CS(buf_) do { if (w == 0) { float a = rdt * Ah; \
            _Pragma("unroll") for (int o = 1; o < 64; o <<= 1) { const float v = __shfl_up(a, o); if (lane >= o) a += v; } \
            ((LAS float*)(L + SS_CS))[(buf_) * 64 + lane] = a; ((LAS float*)(L + SS_DTS))[(buf_) * 64 + lane] = rdt; } } while (0)
#define SSD_LDT(t0_) do { if (w == 0) rdt = DT[((size_t)b * SEQ + (t0_) + lane) * 64 + h]; } while (0)
        SSD_LOAD(0); SSD_LDT(0); SSD_CS(0); SSD_LDT(64);
        for (int ch = 0; ch < SEQ / 64; ++ch) {
            const int t0 = ch * 64, cb = ch & 1; LAS float* CS = (LAS float*)(L + SS_CS) + cb * 64; LAS float* DTS = (LAS float*)(L + SS_DTS) + cb * 64;
            LAS unsigned char* SBr = L + SS_SB + cb * 17408; LAS unsigned char* SBw = L + SS_SB + (cb ^ 1) * 17408;
            __syncthreads();
#pragma unroll
            for (int e = 0; e < 2; ++e) { const int cc = tid + 512 * e;
                *(LAS v4u*)(L + SS_B + (cc >> 4) * 272 + (cc & 15) * 16) = rB[e]; *(LAS v4u*)(L + SS_C + (cc >> 4) * 272 + (cc & 15) * 16) = rC[e]; }
            *(LAS v4u*)(L + SS_XR + (tid >> 3) * 144 + (tid & 7) * 16) = rXR;
            { const int sr = tid >> 3, p8 = tid & 7; const float fd = DTS[sr], fw = fd * __expf(CS[63] - CS[sr]);
              float xv[8];
#pragma unroll
              for (int j = 0; j < 4; ++j) { xv[2 * j] = bflo(rXR[j]); xv[2 * j + 1] = bfhi(rXR[j]); }
              v4u o1, o2; o1.x = pk2(xv[0] * fd, xv[1] * fd); o1.y = pk2(xv[2] * fd, xv[3] * fd); o1.z = pk2(xv[4] * fd, xv[5] * fd); o1.w = pk2(xv[6] * fd, xv[7] * fd);
              o2.x = pk2(xv[0] * fw, xv[1] * fw); o2.y = pk2(xv[2] * fw, xv[3] * fw); o2.z = pk2(xv[4] * fw, xv[5] * fw); o2.w = pk2(xv[6] * fw, xv[7] * fw);
              *(LAS v4u*)(L + SS_XD + sr * 144 + p8 * 16) = o1; *(LAS v4u*)(L + SS_XW + sr * 144 + p8 * 16) = o2; }
            if (ch + 1 < SEQ / 64) { SSD_LOAD(t0 + 64); SSD_CS(cb ^ 1); if (ch + 2 < SEQ / 64) SSD_LDT(t0 + 128); }
            __syncthreads();
            {
                const float csl = CS[16 * lt + l15];
                bf16x8 Cf[4];
#pragma unroll
                for (int ks = 0; ks < 4; ++ks) Cf[ks] = *(const LAS bf16x8*)(L + SS_C + (16 * lt + l15) * 272 + (32 * ks + 8 * lg) * 2);
                f32x4 GT[4];
#pragma unroll
                for (int st = 0; st < 4; ++st) { GT[st] = (f32x4){0.f, 0.f, 0.f, 0.f};
                    if (st <= lt) {
#pragma unroll
                        for (int ks = 0; ks < 4; ++ks) { const bf16x8 bf = *(const LAS bf16x8*)(L + SS_B + (16 * st + l15) * 272 + (32 * ks + 8 * lg) * 2); GT[st] = __builtin_amdgcn_mfma_f32_16x16x32_bf16(bf, Cf[ks], GT[st], 0, 0, 0); }
                        const f32x4 css = *(const LAS f32x4*)(CS + 16 * st + 4 * lg);
#pragma unroll
                        for (int r = 0; r < 4; ++r) { const bool ok = (16 * st + 4 * lg + r) <= (16 * lt + l15); GT[st][r] = ok ? GT[st][r] * __expf(csl - css[r]) : 0.f; }
                    } }
                bf16x8 Lf[2];
#pragma unroll
                for (int k2 = 0; k2 < 2; ++k2) { v4u q; q.x = pg8::cvt_pk_bf16(GT[2 * k2][0], GT[2 * k2][1]); q.y = pg8::cvt_pk_bf16(GT[2 * k2][2], GT[2 * k2][3]); q.z = pg8::cvt_pk_bf16(GT[2 * k2 + 1][0], GT[2 * k2 + 1][1]); q.w = pg8::cvt_pk_bf16(GT[2 * k2 + 1][2], GT[2 * k2 + 1][3]);
                    Lf[k2] = __builtin_bit_cast(bf16x8, q); }
                const float el = __expf(csl);
                const LAS unsigned char* xdb = L + SS_XD + (4 * lg + tq) * 144 + tp * 8;
#pragma unroll
                for (int pp = 0; pp < 2; ++pp) { const int pt = 2 * ph + pp; f32x4 Y = (f32x4){0.f, 0.f, 0.f, 0.f}, Yo = (f32x4){0.f, 0.f, 0.f, 0.f};
#pragma unroll
                    for (int k2 = 0; k2 < 2; ++k2) if (2 * k2 <= lt) { const LAS unsigned char* xp = xdb + k2 * 32 * 144 + pt * 32;
                        Y = __builtin_amdgcn_mfma_f32_16x16x32_bf16(cat8(tr16(xp), tr16(xp + 16 * 144)), Lf[k2], Y, 0, 0, 0); }
#pragma unroll
                    for (int ks = 0; ks < 4; ++ks) { const bf16x8 sb = *(const LAS bf16x8*)(SBr + (16 * pt + l15) * 272 + (32 * ks + 8 * lg) * 2); Yo = __builtin_amdgcn_mfma_f32_16x16x32_bf16(sb, Cf[ks], Yo, 0, 0, 0); }
                    const v2u xr = *(const LAS v2u*)(L + SS_XR + (16 * lt + l15) * 144 + (16 * pt + 4 * lg) * 2);
                    const float y0 = Y[0] + el * Yo[0] + Dh * bflo(xr.x), y1 = Y[1] + el * Yo[1] + Dh * bfhi(xr.x), y2 = Y[2] + el * Yo[2] + Dh * bflo(xr.y), y3 = Y[3] + el * Yo[3] + Dh * bfhi(xr.y);
                    v2u o; o.x = pk2(y0, y1); o.y = pk2(y2, y3);
                    if (do_store) *(v2u*)(X2 + ((size_t)b * SEQ + t0 + 16 * lt + l15) * 6144 + h * 64 + 16 * pt + 4 * lg) = o; }
                const float e63 = __expf(CS[63]); const int pts = w >> 1;
                const LAS unsigned char* bb = L + SS_B + (8 * lg + tq) * 272 + tp * 8; const LAS unsigned char* xwb = L + SS_XW + (8 * lg + tq) * 144 + tp * 8 + pts * 32;
                bf16x8 Xf[2];
#pragma unroll
                for (int ks = 0; ks < 2; ++ks) Xf[ks] = cat8(tr16(xwb + ks * 32 * 144), tr16(xwb + ks * 32 * 144 + 4 * 144));
#pragma unroll
                for (int i = 0; i < 4; ++i) { const int nt = 4 * (w & 1) + i; ST[i] *= e63;
#pragma unroll
                    for (int ks = 0; ks < 2; ++ks) { const LAS unsigned char* bp = bb + ks * 32 * 272 + nt * 32;
                        ST[i] = __builtin_amdgcn_mfma_f32_16x16x32_bf16(cat8(tr16(bp), tr16(bp + 4 * 272)), Xf[ks], ST[i], 0, 0, 0); }
                    v2u q; q.x = pk2(ST[i][0], ST[i][1]); q.y = pk2(ST[i][2], ST[i][3]);
                    *(LAS v2u*)(SBw + (16 * pts + l15) * 272 + (16 * nt + 4 * lg) * 2) = q; }
            }
        }
#undef SSD_LOAD
#undef SSD_CS
#undef SSD_LDT
    }
    __syncthreads();
}

__device__ __forceinline__ void ssd_gnorm(const Ctx& c, bf16* X2, const bf16* P, const float* g) {
    for (int row = c.gw; row < MT; row += c.NGW) {
        v4u* yr = (v4u*)(X2 + (size_t)row * 6144) + c.lane; const v4u* zr = (const v4u*)(P + (size_t)row * SSD_NP) + c.lane;
        float v[8][8]; float s = 0.f;
#pragma unroll
        for (int j = 0; j < 8; ++j) { const v4u y = yr[64 * j], z = zr[64 * j];
#pragma unroll
            for (int k = 0; k < 4; ++k) { const float a = bflo(y[k]) * siluf_(bflo(z[k])), b = bfhi(y[k]) * siluf_(bfhi(z[k])); v[j][2 * k] = a; v[j][2 * k + 1] = b; s += a * a + b * b; } }
        const float rs = rsqrtf(wave_sum(s) * (1.f / 4096.f) + EPS);
#pragma unroll
        for (int j = 0; j < 8; ++j) { const float* gg = g + (c.lane + 64 * j) * 8; const f32x4 g0 = *(const f32x4*)gg, g1 = *(const f32x4*)(gg + 4);
            v4u w; w.x = pk2(v[j][0] * rs * g0.x, v[j][1] * rs * g0.y); w.y = pk2(v[j][2] * rs * g0.z, v[j][3] * rs * g0.w); w.z = pk2(v[j][4] * rs * g1.x, v[j][5] * rs * g1.y); w.w = pk2(v[j][6] * rs * g1.z, v[j][7] * rs * g1.w);
            yr[64 * j] = w; }
    }
}

__device__ __forceinline__ void sgu_ln(const Ctx& c, bf16* P, const float* g) {
    for (int row = c.gw; row < MT; row += c.NGW) {
        v4u* vr = (v4u*)(P + (size_t)row * 8192 + 4096) + c.lane;
        float v[8][8]; float s = 0.f;
#pragma unroll
        for (int j = 0; j < 8; ++j) { const v4u y = vr[64 * j];
#pragma unroll
            for (int k = 0; k < 4; ++k) { v[j][2 * k] = bflo(y[k]); v[j][2 * k + 1] = bfhi(y[k]); s += v[j][2 * k] + v[j][2 * k + 1]; } }
        const float mu = wave_sum(s) * (1.f / 4096.f); float q = 0.f;
#pragma unroll
        for (int j = 0; j < 8; ++j)
#pragma unroll
            for (int k = 0; k < 8; ++k) { v[j][k] -= mu; q += v[j][k] * v[j][k]; }
        const float rs = rsqrtf(wave_sum(q) * (1.f / 4096.f) + EPS);
#pragma unroll
        for (int j = 0; j < 8; ++j) { const float* gg = g + (c.lane + 64 * j) * 8; const f32x4 g0 = *(const f32x4*)gg, g1 = *(const f32x4*)(gg + 4);
            v4u w; w.x = pk2(v[j][0] * rs * g0.x, v[j][1] * rs * g0.y); w.y = pk2(v[j][2] * rs * g0.z, v[j][3] * rs * g0.w); w.z = pk2(v[j][4] * rs * g1.x, v[j][5] * rs * g1.y); w.w = pk2(v[j][6] * rs * g1.z, v[j][7] * rs * g1.w);
            vr[64 * j] = w; }
    }
}
__device__ __forceinline__ void sgu_spatial(const Ctx& c, const bf16* P, const float* Wsp, const float* bsp, bf16* ACT) {
    LAS unsigned char* Vs = c.lds;
    for (int u = c.vcu; u < NB * 32 * 8; u += c.G) {
        const int g = u & 7, bc = u >> 3; const size_t row0 = (size_t)bc * 128;
        __syncthreads();
        for (int i = c.tid; i < 128 * 64; i += 512) { const int s = i >> 6, d8 = i & 63; *(LAS v4u*)(Vs + s * 1024 + d8 * 16) = *(const v4u*)(P + (row0 + s) * 8192 + 4096 + g * 512 + d8 * 8); }
        __syncthreads();
        const int d8 = c.lane;
        for (int i = 0; i < 16; ++i) {
            const int t = c.wave + 8 * i; const float* wrow = Wsp + ((size_t)g * 128 + t) * 128;
            float acc[8];
#pragma unroll
            for (int j = 0; j < 8; ++j) acc[j] = 0.f;
            for (int s = 0; s <= t; ++s) { const float w = wrow[s]; const v4u v = *(const LAS v4u*)(Vs + s * 1024 + d8 * 16);
#pragma unroll
                for (int j = 0; j < 4; ++j) { acc[2 * j] += w * bflo(v[j]); acc[2 * j + 1] += w * bfhi(v[j]); } }
            const float bb = bsp[g * 128 + t]; const v4u uu = *(const v4u*)(P + (row0 + t) * 8192 + g * 512 + d8 * 8);
            v4u w; w.x = pk2(bflo(uu.x) * (acc[0] + bb), bfhi(uu.x) * (acc[1] + bb)); w.y = pk2(bflo(uu.y) * (acc[2] + bb), bfhi(uu.y) * (acc[3] + bb));
            w.z = pk2(bflo(uu.z) * (acc[4] + bb), bfhi(uu.z) * (acc[5] + bb)); w.w = pk2(bflo(uu.w) * (acc[6] + bb), bfhi(uu.w) * (acc[7] + bb));
            *(v4u*)(ACT + (row0 + t) * 4096 + g * 512 + d8 * 8) = w;
        }
    }
    __syncthreads();
}

__device__ __forceinline__ void sgu_spatial_mfma(const Ctx& c, const bf16* P, const float* Wsp, const float* bsp, bf16* ACT) {
    constexpr int RS = 528, WB = 128 * RS, WRS = 272;
    LAS unsigned char* L = c.lds; const int tid = c.tid, l15 = c.lane & 15, lg = c.lane >> 4, w = c.wave;
    for (int u_ = c.vcu; u_ < (PROBE == 22 ? 2 : 1) * NB * 32 * 8; u_ += c.G) {
        const int u = u_ & (NB * 32 * 8 - 1); const int g = u & 7, bc = u >> 3; const size_t row0 = (size_t)bc * 128;
        __syncthreads();
#pragma unroll
        for (int e = 0; e < 4; ++e) { const int cc = tid + 512 * e, t = cc >> 4, s8 = cc & 15; const float* wp = Wsp + ((size_t)g * 128 + t) * 128 + s8 * 8; f32x4 a = *(const f32x4*)wp, b = *(const f32x4*)(wp + 4);
#pragma unroll
            for (int j = 0; j < 4; ++j) { if (s8 * 8 + j > t) a[j] = 0.f; if (s8 * 8 + 4 + j > t) b[j] = 0.f; }
            v4u q; q.x = pk2(a[0], a[1]); q.y = pk2(a[2], a[3]); q.z = pk2(b[0], b[1]); q.w = pk2(b[2], b[3]); *(LAS v4u*)(L + WB + t * WRS + s8 * 16) = q; }
        for (int half = 0; half < 2; ++half) {
            if (half) __syncthreads();
#pragma unroll
            for (int e = 0; e < 8; ++e) { const int cc = tid + 512 * e, sr = cc >> 5, d8 = cc & 31; *(LAS v4u*)(L + sr * RS + d8 * 16) = *(const v4u*)(P + (row0 + sr) * 8192 + 4096 + g * 512 + 256 * half + d8 * 8); }
            __syncthreads();
            bf16x8 Wf[4];
#pragma unroll
            for (int ks = 0; ks < 4; ++ks) Wf[ks] = *(const LAS bf16x8*)(L + WB + (16 * w + l15) * WRS + (32 * ks + 8 * lg) * 2);
            const int nks = (w >> 1) + 1; const int t = 16 * w + l15; const float bb = bsp[g * 128 + t];
            const LAS unsigned char* vb = L + (8 * lg + (l15 >> 2)) * RS + (l15 & 3) * 8;
            v2u uv[16];
#pragma unroll
            for (int dt = 0; dt < 16; ++dt) uv[dt] = *(const v2u*)(P + (row0 + t) * 8192 + (size_t)g * 512 + 256 * half + 16 * dt + 4 * lg);
#pragma unroll
            for (int dt = 0; dt < 16; ++dt) {
                f32x4 acc = (f32x4){0.f, 0.f, 0.f, 0.f};
#pragma unroll
                for (int ks = 0; ks < 4; ++ks) if (ks < nks) {
                    const s16x4 a0 = __builtin_amdgcn_ds_read_tr16_b64_v4i16((LAS s16x4*)(vb + ks * 32 * RS + dt * 32)), a1 = __builtin_amdgcn_ds_read_tr16_b64_v4i16((LAS s16x4*)(vb + ks * 32 * RS + 4 * RS + dt * 32));
                    bf16x8 af; af[0] = a0[0]; af[1] = a0[1]; af[2] = a0[2]; af[3] = a0[3]; af[4] = a1[0]; af[5] = a1[1]; af[6] = a1[2]; af[7] = a1[3];
                    acc = __builtin_amdgcn_mfma_f32_16x16x32_bf16(af, Wf[ks], acc, 0, 0, 0); }
                const size_t col = (size_t)g * 512 + 256 * half + 16 * dt + 4 * lg;
                const v2u uu = uv[dt];
                v2u o; o.x = pk2(bflo(uu.x) * (acc[0] + bb), bfhi(uu.x) * (acc[1] + bb)); o.y = pk2(bflo(uu.y) * (acc[2] + bb), bfhi(uu.y) * (acc[3] + bb));
                *(v2u*)(ACT + (row0 + t) * 4096 + col) = o;
            }
        }
    }
    __syncthreads();
}

template <int WIN> __device__ __forceinline__ f32x4 pool_sum(const float* zp, int t) {
    f32x4 v[WIN];
#pragma unroll
    for (int j = 1; j < WIN; ++j) v[j] = (j <= t) ? *(const f32x4*)(zp - (size_t)j * DM) : (f32x4){0.f, 0.f, 0.f, 0.f};
    f32x4 s = (f32x4){0.f, 0.f, 0.f, 0.f};
#pragma unroll
    for (int j = 1; j < WIN; ++j) s += v[j];
    return s;
}
__device__ __forceinline__ void pool_pool(const Ctx& c, const float* Z, bf16* O) {
    for (int it = c.vcu * 512 + c.tid; it < MT * 512; it += c.G * 512) {
        const int row = it >> 9, c4 = (it & 511) * 4, gi = __builtin_amdgcn_readfirstlane(c4 >> 9), win = 2 << gi, t = row & (SEQ - 1), cnt = (t + 1 < win) ? t + 1 : win;
        const float* zp = Z + (size_t)row * DM + c4; const f32x4 z0 = *(const f32x4*)zp; f32x4 s;
        if (gi == 0) s = pool_sum<2>(zp, t); else if (gi == 1) s = pool_sum<4>(zp, t); else if (gi == 2) s = pool_sum<8>(zp, t); else s = pool_sum<16>(zp, t);
        s += z0;
        const float ic = 1.f / (float)cnt; v2u o; o.x = pk2(s.x * ic - z0.x, s.y * ic - z0.y); o.y = pk2(s.z * ic - z0.z, s.w * ic - z0.w);
        *(v2u*)(O + (size_t)row * DM + c4) = o;
    }
}

__device__ __forceinline__ void xa_attn(const Ctx& c, const bf16* Q, const bf16* KV, bf16* O) {
    LAS unsigned char* Ks = c.lds; LAS unsigned char* Vs = c.lds + 69632; LAS float* qs = (LAS float*)(c.lds + 135168 + c.wave * 1536); LAS float* ps = qs + 128;
    const int lane = c.lane; const float scale = 0.08838834764831845f;
    for (int u = c.vcu; u < 256; u += c.G) {
        const int bh = u >> 4, chunk = u & 15, b = bh >> 2, hd = bh & 3;
        __syncthreads();
        for (int i = c.tid; i < 256 * 16; i += 512) { const int key = i >> 4, d8 = i & 15; const bf16* src = KV + (size_t)(b * 256 + key) * 1024 + hd * 128 + d8 * 8;
            *(LAS v4u*)(Ks + key * 272 + d8 * 16) = *(const v4u*)src; *(LAS v4u*)(Vs + key * 256 + d8 * 16) = *(const v4u*)(src + 512); }
        __syncthreads();
        for (int i = 0; i < 32; ++i) {
            const size_t row = (size_t)b * SEQ + chunk * 256 + c.wave * 32 + i;
            const unsigned qq = *(const unsigned*)(Q + row * 512 + hd * 128 + 2 * lane);
            qs[2 * lane] = bflo(qq); qs[2 * lane + 1] = bfhi(qq);
            LDS_WAIT();
            float sc[4] = {0.f, 0.f, 0.f, 0.f};
#pragma unroll 2
            for (int d8 = 0; d8 < 16; ++d8) { const f32x4 q0 = *(const LAS f32x4*)(qs + d8 * 8), q1 = *(const LAS f32x4*)(qs + d8 * 8 + 4);
#pragma unroll
                for (int r = 0; r < 4; ++r) { const v4u kv = *(const LAS v4u*)(Ks + (lane + 64 * r) * 272 + d8 * 16);
                    sc[r] += bflo(kv.x) * q0.x + bfhi(kv.x) * q0.y + bflo(kv.y) * q0.z + bfhi(kv.y) * q0.w + bflo(kv.z) * q1.x + bfhi(kv.z) * q1.y + bflo(kv.w) * q1.z + bfhi(kv.w) * q1.w; } }
#pragma unroll
            for (int r = 0; r < 4; ++r) sc[r] *= scale;
            const float m = wave_max(fmaxf(fmaxf(sc[0], sc[1]), fmaxf(sc[2], sc[3])));
            float l = 0.f;
#pragma unroll
            for (int r = 0; r < 4; ++r) { const float p = __expf(sc[r] - m); l += p; ps[lane + 64 * r] = p; }
            l = wave_sum(l);
            LDS_WAIT();
            float o0 = 0.f, o1 = 0.f;
#pragma unroll 8
            for (int key = 0; key < 256; ++key) { const float p = ps[key]; const unsigned vv = *(const LAS unsigned*)(Vs + key * 256 + lane * 4); o0 += p * bflo(vv); o1 += p * bfhi(vv); }
            const float il = 1.f / l;
            *(unsigned*)(O + row * 512 + hd * 128 + 2 * lane) = pk2(o0 * il, o1 * il);
            LDS_WAIT();
        }
    }
    __syncthreads();
}

__device__ __forceinline__ void nsa_posbias(const Ctx& c, const float* pos, const float* w1, float* PBP) {
    for (int o = ((c.gw & 3) == 3) ? (c.gw >> 2) : 512; o < 512; o += (c.NGW >> 2)) { const int ten = o >> 8, nb = (o >> 6) & 3, ks = o & 63, n = nb * 64 + c.lane; float a = 0.f;
#pragma unroll 16
        for (int k = 0; k < 64; ++k) a += pos[ten * 4096 + ks * 64 + k] * w1[((size_t)ten * 4096 + ks * 64 + k) * 256 + n];
        PBP[(ten * 64 + ks) * 256 + n] = a; }
}
__device__ __forceinline__ void nsa_posbias_reduce(const Ctx& c, const float* PBP, float* PB) {
    if (c.vcu == 0) { const int ten = c.tid >> 8, n = c.tid & 255; float a = 0.f;
#pragma unroll 16
        for (int ks = 0; ks < 64; ++ks) a += PBP[(ten * 64 + ks) * 256 + n];
        PB[c.tid] = a; }
}
__device__ __forceinline__ void nsa_w2(const Ctx& c, const bf16* HID, const float* w2, float* KC) {
    for (int it = c.vcu * 512 + c.tid; it < 8192 * 128; it += c.G * 512) {
        const int r = it >> 7, d = it & 127, ten = r >> 12; const bf16* hrow = HID + (size_t)r * 256; const float* w = w2 + (size_t)ten * 256 * 128 + d; float a = 0.f;
#pragma unroll 8
        for (int h = 0; h < 256; ++h) a += bflo((unsigned)hrow[h]) * w[h * 128];
        KC[it] = a;
    }
}
__device__ __forceinline__ void nsa_block(const bf16* Kb, const bf16* Vb, bool valid, const LAS float* qs, LAS float* ps, int lane, float (&m)[4], float (&l)[4], float (&o)[4][2]) {
    const float scale = 0.08838834764831845f;
    float sc[4] = {0.f, 0.f, 0.f, 0.f};
    const v4u* kr = (const v4u*)(Kb + (size_t)lane * 128);
#pragma unroll 4
    for (int d8 = 0; d8 < 16; ++d8) { const v4u kv = kr[d8]; float k[8];
#pragma unroll
        for (int j = 0; j < 4; ++j) { k[2 * j] = bflo(kv[j]); k[2 * j + 1] = bfhi(kv[j]); }
#pragma unroll
        for (int h = 0; h < 4; ++h) { const f32x4 q0 = *(const LAS f32x4*)(qs + h * 128 + d8 * 8), q1 = *(const LAS f32x4*)(qs + h * 128 + d8 * 8 + 4);
            sc[h] += k[0] * q0.x + k[1] * q0.y + k[2] * q0.z + k[3] * q0.w + k[4] * q1.x + k[5] * q1.y + k[6] * q1.z + k[7] * q1.w; } }
    float alpha[4];
#pragma unroll
    for (int h = 0; h < 4; ++h) { const float s = valid ? sc[h] * scale : -1e30f; const float mn = fmaxf(m[h], wave_max(s)); const float p = valid ? __expf(s - mn) : 0.f;
        alpha[h] = __expf(m[h] - mn); m[h] = mn; l[h] = l[h] * alpha[h] + wave_sum(p); ps[h * 64 + lane] = p; o[h][0] *= alpha[h]; o[h][1] *= alpha[h]; }
    LDS_WAIT();
#pragma unroll 4
    for (int s = 0; s < 64; ++s) { const unsigned vv = *(const unsigned*)(Vb + (size_t)s * 128 + 2 * lane); const float v0 = bflo(vv), v1 = bfhi(vv);
#pragma unroll
        for (int h = 0; h < 4; ++h) { const float p = ps[h * 64 + s]; o[h][0] += p * v0; o[h][1] += p * v1; } }
    LDS_WAIT();
}
__device__ __forceinline__ void nsa_attn(const Ctx& c, const bf16* Q, const bf16* T, const float* KC, const float* Gt, bf16* OUT) {
    LAS float* qs = (LAS float*)(c.lds + c.wave * 8192);
    LAS float* ps = qs + 512;
    LAS float* psum = ps + 1024;
    const int lane = c.lane; const float scale = 0.08838834764831845f;
    for (int task = c.gw; task < MT * 4; task += c.NGW) {
        const int g = task & 3, row = task >> 2, b = row >> 12, t = row & 4095, bg = b * 4 + g;
        { const v4u qv = *(const v4u*)(Q + (size_t)row * 2048 + g * 512 + lane * 8); LAS float* qd = qs + lane * 8;
#pragma unroll
          for (int j = 0; j < 4; ++j) { qd[2 * j] = bflo(qv[j]); qd[2 * j + 1] = bfhi(qv[j]); } }
        LDS_WAIT();
        const int nv = (t >= 31) ? ((t - 31) >> 4) + 1 : 0;
        float oc[4][2] = {{0.f, 0.f}, {0.f, 0.f}, {0.f, 0.f}, {0.f, 0.f}};
        const float* kcb = KC + (size_t)bg * 256 * 128; const float* vcb = KC + (size_t)(16 + bg) * 256 * 128;
        psum[lane] = 0.f; psum[lane + 64] = 0.f; psum[lane + 128] = 0.f; psum[lane + 192] = 0.f;
        if (nv > 0) {
            float sc[4][4];
#pragma unroll
            for (int r = 0; r < 4; ++r) { const int i = lane + 64 * r;
#pragma unroll
                for (int h = 0; h < 4; ++h) sc[h][r] = 0.f;
                if (i < nv) { const f32x4* kr = (const f32x4*)(kcb + (size_t)i * 128);
#pragma unroll 4
                    for (int d4 = 0; d4 < 32; ++d4) { const f32x4 kv = kr[d4];
#pragma unroll
                        for (int h = 0; h < 4; ++h) { const f32x4 q0 = *(const LAS f32x4*)(qs + h * 128 + d4 * 4); sc[h][r] += kv.x * q0.x + kv.y * q0.y + kv.z * q0.z + kv.w * q0.w; } } } }
            float ps_r[4] = {0.f, 0.f, 0.f, 0.f};
#pragma unroll
            for (int h = 0; h < 4; ++h) { float mx = -1e30f;
#pragma unroll
                for (int r = 0; r < 4; ++r) { const bool ok = (lane + 64 * r) < nv; sc[h][r] = ok ? sc[h][r] * scale : -1e30f; mx = fmaxf(mx, sc[h][r]); }
                mx = wave_max(mx); float sm = 0.f;
#pragma unroll
                for (int r = 0; r < 4; ++r) { const bool ok = (lane + 64 * r) < nv; sc[h][r] = ok ? __expf(sc[h][r] - mx) : 0.f; sm += sc[h][r]; }
                sm = wave_sum(sm); const float inv = 1.f / sm;
#pragma unroll
                for (int r = 0; r < 4; ++r) { const float p = sc[h][r] * inv; ps[h * 256 + lane + 64 * r] = p; ps_r[r] += p; } }
#pragma unroll
            for (int r = 0; r < 4; ++r) psum[lane + 64 * r] = ps_r[r];
            LDS_WAIT();
            for (int i = 0; i < nv; ++i) { const f32x2 vv = *(const f32x2*)(vcb + (size_t)i * 128 + 2 * lane);
#pragma unroll
                for (int h = 0; h < 4; ++h) { const float p = ps[h * 256 + i]; oc[h][0] += p * vv.x; oc[h][1] += p * vv.y; } }
        }
        LDS_WAIT();
        const int cur = t >> 6;
        float imp = 0.f;
        { const int i0 = (4 * lane - 1) < 0 ? 0 : 4 * lane - 1, i1 = (4 * lane + 3) > 254 ? 254 : 4 * lane + 3;
          for (int i = i0; i <= i1; ++i) imp += psum[i]; }
        const bool forced = (lane == 0) || (lane <= cur && lane > cur - 3), future = lane > cur;
        const float score = forced ? 1e30f : (future ? -1e30f : imp);
        int rank = 0;
        for (int k = 0; k < 64; ++k) { const float sk = __shfl(score, k); rank += (sk > score || (sk == score && k < lane)) ? 1 : 0; }
        const unsigned long long selmask = __ballot(rank < 16);
        LDS_WAIT();
        float m1[4] = {-1e30f, -1e30f, -1e30f, -1e30f}, l1[4] = {0.f, 0.f, 0.f, 0.f}, o1[4][2] = {{0.f, 0.f}, {0.f, 0.f}, {0.f, 0.f}, {0.f, 0.f}};
        const bf16* ksb = T + 2 * NT_STRIDE + (size_t)bg * 4096 * 128; const bf16* vsb = T + 3 * NT_STRIDE + (size_t)bg * 4096 * 128;
        for (int k = 0; k <= cur; ++k) { if (!((selmask >> k) & 1ull)) continue;
            nsa_block(ksb + (size_t)k * 64 * 128, vsb + (size_t)k * 64 * 128, (k * 64 + lane) <= t, qs, ps, lane, m1, l1, o1); }
        float m2[4] = {-1e30f, -1e30f, -1e30f, -1e30f}, l2[4] = {0.f, 0.f, 0.f, 0.f}, o2[4][2] = {{0.f, 0.f}, {0.f, 0.f}, {0.f, 0.f}, {0.f, 0.f}};
        const bf16* kwb = T + 4 * NT_STRIDE + (size_t)bg * 4096 * 128; const bf16* vwb = T + 5 * NT_STRIDE + (size_t)bg * 4096 * 128;
        const int lo = (t - 511) < 0 ? 0 : (t - 511);
        for (int k = lo >> 6; k <= cur; ++k) { const int pos = k * 64 + lane;
            nsa_block(kwb + (size_t)k * 64 * 128, vwb + (size_t)k * 64 * 128, pos <= t && pos >= lo, qs, ps, lane, m2, l2, o2); }
#pragma unroll
        for (int h = 0; h < 4; ++h) { const float* gl = Gt + (size_t)row * 48 + (g * 4 + h) * 3; const float g0 = sigmoidf_(gl[0]), g1 = sigmoidf_(gl[1]), g2 = sigmoidf_(gl[2]);
            const float i1 = 1.f / l1[h], i2 = 1.f / l2[h];
            const float a = g0 * oc[h][0] + g1 * o1[h][0] * i1 + g2 * o2[h][0] * i2, bq = g0 * oc[h][1] + g1 * o1[h][1] * i1 + g2 * o2[h][1] * i2;
            *(unsigned*)(OUT + (size_t)row * 2048 + (g * 4 + h) * 128 + 2 * lane) = pk2(a, bq); }
        LDS_WAIT();
    }
}


namespace fa {
constexpr int KS_STRIDE = 272, VT_STRIDE = 144, KS_BYTES = 64 * KS_STRIDE, VT_BYTES = 128 * VT_STRIDE, BUF_BYTES = KS_BYTES + VT_BYTES;
constexpr int PS_OFF = 2 * BUF_BYTES, PS_STRIDE = 260, SM_OFF = PS_OFF + 64 * PS_STRIDE * 4;
constexpr float C2 = 0.08838834764831845f * 1.4426950408889634f;
struct Src { const bf16* K; size_t kstride; const bf16* Vt; size_t vstride; };
struct Stage { v4u k[2], v[2]; };
template <bool WITH_V> __device__ __forceinline__ void load_tile(const Src& s, int key0, int tid, Stage& st) {
#pragma unroll
    for (int e = 0; e < 2; ++e) { const int cc = tid + 512 * e;
        st.k[e] = *(const v4u*)(s.K + (size_t)(key0 + (cc >> 4)) * s.kstride + (cc & 15) * 8);
        if constexpr (WITH_V) st.v[e] = *(const v4u*)(s.Vt + (size_t)(cc >> 3) * s.vstride + key0 + (cc & 7) * 8); }
}
template <bool WITH_V> __device__ __forceinline__ void store_tile(LAS unsigned char* buf, int tid, const Stage& st) {
#pragma unroll
    for (int e = 0; e < 2; ++e) { const int cc = tid + 512 * e;
        *(LAS v4u*)(buf + (cc >> 4) * KS_STRIDE + (cc & 15) * 16) = st.k[e];
        if constexpr (WITH_V) *(LAS v4u*)(buf + KS_BYTES + (cc >> 3) * VT_STRIDE + (cc & 7) * 16) = st.v[e]; }
}
struct NoMask { __device__ __forceinline__ bool valid(int, int, int) const { return true; } __device__ __forceinline__ bool need(int) const { return false; } };
struct CmpMask { int nvq[2]; __device__ __forceinline__ bool valid(int kb, int ko, int mi) const { return kb * 64 + ko < nvq[mi]; } __device__ __forceinline__ bool need(int kb) const { return !__all(kb * 64 + 64 <= nvq[0] && kb * 64 + 64 <= nvq[1]); } };
struct SelMask { int tq[2]; unsigned long long sm[2]; int qb; __device__ __forceinline__ bool valid(int kb, int ko, int mi) const { return ((sm[mi] >> kb) & 1ull) && (kb * 64 + ko <= tq[mi]); }
    __device__ __forceinline__ bool need(int kb) const { return kb == qb || !__all((int)((sm[0] >> kb) & (sm[1] >> kb) & 1ull)); } };
struct WinMask { int tq[2]; int qb; __device__ __forceinline__ bool valid(int kb, int ko, int mi) const { const int kp = kb * 64 + ko; return kp <= tq[mi] && kp + 511 >= tq[mi]; } __device__ __forceinline__ bool need(int kb) const { return kb == qb || kb + 8 <= qb; } };

template <int MODE, class MaskF>
__device__ __forceinline__ void tile_qk(const LAS unsigned char* buf, const bf16x8 (&Qf)[2][4], f32x4 (&O)[8][2], float (&m)[2], float (&l)[2], const float (&invl)[2],
                                        int kb, const MaskF& mf, LAS float* PS, int wave, int l15, int lg, bf16x8 (&Pf)[2][2], f32x4 (&OL)[2]) {
    f32x4 S[4][2];
#pragma unroll
    for (int nt = 0; nt < 4; ++nt)
#pragma unroll
        for (int mi = 0; mi < 2; ++mi) S[nt][mi] = (f32x4){0.f, 0.f, 0.f, 0.f};
    const LAS unsigned char* kbase = buf + l15 * KS_STRIDE + lg * 16;
    bf16x8 kf[2][2];
#pragma unroll
    for (int q = 0; q < 2; ++q) kf[0][q] = *(const LAS bf16x8*)(kbase + q * 16 * KS_STRIDE);
#pragma unroll
    for (int h = 0; h < 8; ++h) { const int ks = h >> 1, n0 = (h & 1) * 2;
        if (h < 7) { const int ks1 = (h + 1) >> 1, n1 = ((h + 1) & 1) * 2;
#pragma unroll
            for (int q = 0; q < 2; ++q) kf[(h + 1) & 1][q] = *(const LAS bf16x8*)(kbase + (n1 + q) * 16 * KS_STRIDE + ks1 * 64); }
        __builtin_amdgcn_sched_barrier(0);
        __builtin_amdgcn_s_setprio(1);
#pragma unroll
        for (int q = 0; q < 2; ++q)
#pragma unroll
            for (int mi = 0; mi < 2; ++mi) S[n0 + q][mi] = __builtin_amdgcn_mfma_f32_16x16x32_bf16(kf[h & 1][q], Qf[mi][ks], S[n0 + q][mi], 0, 0, 0);
        __builtin_amdgcn_s_setprio(0);
        __builtin_amdgcn_sched_barrier(0);
    }
    const float NEG = -__builtin_inff();
    float mx[2] = {NEG, NEG};
    if (mf.need(kb)) {
#pragma unroll
        for (int nt = 0; nt < 4; ++nt)
#pragma unroll
            for (int mi = 0; mi < 2; ++mi)
#pragma unroll
                for (int r = 0; r < 4; ++r) { const float sv = mf.valid(kb, 16 * nt + 4 * lg + r, mi) ? S[nt][mi][r] : NEG; S[nt][mi][r] = sv; mx[mi] = fmaxf(mx[mi], sv); }
    } else {
#pragma unroll
        for (int nt = 0; nt < 4; ++nt)
#pragma unroll
            for (int mi = 0; mi < 2; ++mi)
#pragma unroll
                for (int r = 0; r < 4; ++r) mx[mi] = fmaxf(mx[mi], S[nt][mi][r]);
    }
#pragma unroll
    for (int mi = 0; mi < 2; ++mi) {
        float ref;
        if constexpr (MODE == 2) { ref = m[mi]; }
        else { float t = fmaxf(mx[mi], __shfl_xor(mx[mi], 16)); t = fmaxf(t, __shfl_xor(t, 32)); t *= C2;
            if (__all(t <= m[mi] + 6.0f)) { ref = m[mi]; }
            else { const float mn = fmaxf(m[mi], t); const float alpha = __builtin_amdgcn_exp2f(m[mi] - mn); m[mi] = mn; ref = mn;
                if constexpr (MODE == 0) { OL[mi] *= alpha;
#pragma unroll
                    for (int dt = 0; dt < 8; ++dt) O[dt][mi] *= alpha; }
                else l[mi] *= alpha; } }
        float ps = 0.f;
#pragma unroll
        for (int nt = 0; nt < 4; ++nt)
#pragma unroll
            for (int r = 0; r < 4; ++r) { float p = __builtin_amdgcn_exp2f(__builtin_fmaf(S[nt][mi][r], C2, -ref)); if constexpr (MODE == 2) p *= invl[mi]; S[nt][mi][r] = p; if constexpr (MODE == 1) ps += p; }
        if constexpr (MODE == 1) l[mi] += ps;
    }
    if constexpr (MODE == 2) {
#pragma unroll
        for (int nt = 0; nt < 4; ++nt)
#pragma unroll
            for (int mi = 0; mi < 2; ++mi) { f32x4 v = S[nt][mi];
#pragma unroll
                for (int r = 0; r < 4; ++r) { v[r] += __shfl_xor(v[r], 1); v[r] += __shfl_xor(v[r], 2); }
                if ((l15 & 3) == 0) *(LAS f32x4*)(PS + ((32 * wave + 16 * mi + l15) >> 2) * PS_STRIDE + 64 * kb + 16 * nt + 4 * lg) = v; }
    }
    if constexpr (MODE != 1) {
#pragma unroll
        for (int mi = 0; mi < 2; ++mi)
#pragma unroll
            for (int k2 = 0; k2 < 2; ++k2) { v4u w; w.x = pg8::cvt_pk_bf16(S[2 * k2][mi][0], S[2 * k2][mi][1]); w.y = pg8::cvt_pk_bf16(S[2 * k2][mi][2], S[2 * k2][mi][3]);
                w.z = pg8::cvt_pk_bf16(S[2 * k2 + 1][mi][0], S[2 * k2 + 1][mi][1]); w.w = pg8::cvt_pk_bf16(S[2 * k2 + 1][mi][2], S[2 * k2 + 1][mi][3]); Pf[mi][k2] = __builtin_bit_cast(bf16x8, w); }
    }
}
__device__ __forceinline__ void tile_pv(const LAS unsigned char* buf, const bf16x8 (&Pf)[2][2], f32x4 (&O)[8][2], int l15, int lg, f32x4 (&OL)[2], bool with_l) {
    if (with_l) { v4u ow; ow.x = ow.y = ow.z = ow.w = 0x3F803F80u; const bf16x8 ones = __builtin_bit_cast(bf16x8, ow);
#pragma unroll
        for (int k2 = 0; k2 < 2; ++k2)
#pragma unroll
            for (int mi = 0; mi < 2; ++mi) OL[mi] = __builtin_amdgcn_mfma_f32_16x16x32_bf16(ones, Pf[mi][k2], OL[mi], 0, 0, 0); }
    const LAS unsigned char* vbase = buf + KS_BYTES + l15 * VT_STRIDE + lg * 8;
    v2u va[2][2][2];
#define FA_LDV(slot_, g_) do { _Pragma("unroll") for (int q = 0; q < 2; ++q) { const int dt_ = ((g_) & 3) * 2 + q, k2_ = (g_) >> 2; \
        va[slot_][q][0] = *(const LAS v2u*)(vbase + dt_ * 16 * VT_STRIDE + k2_ * 64); va[slot_][q][1] = *(const LAS v2u*)(vbase + dt_ * 16 * VT_STRIDE + k2_ * 64 + 32); } } while (0)
    FA_LDV(0, 0);
#pragma unroll
    for (int g = 0; g < 8; ++g) {
        if (g < 7) FA_LDV((g + 1) & 1, g + 1);
        __builtin_amdgcn_sched_barrier(0);
        __builtin_amdgcn_s_setprio(1);
#pragma unroll
        for (int q = 0; q < 2; ++q) { const int dt = (g & 3) * 2 + q, k2 = g >> 2; v4u w; w.x = va[g & 1][q][0].x; w.y = va[g & 1][q][0].y; w.z = va[g & 1][q][1].x; w.w = va[g & 1][q][1].y; const bf16x8 vf = __builtin_bit_cast(bf16x8, w);
#pragma unroll
            for (int mi = 0; mi < 2; ++mi) O[dt][mi] = __builtin_amdgcn_mfma_f32_16x16x32_bf16(vf, Pf[mi][k2], O[dt][mi], 0, 0, 0); }
        __builtin_amdgcn_s_setprio(0);
        __builtin_amdgcn_sched_barrier(0);
    }
#undef FA_LDV
}
template <int MODE, class MaskF>
__device__ __forceinline__ void run(LAS unsigned char* lds, const Src& src, unsigned long long tiles, const bf16x8 (&Qf)[2][4], f32x4 (&O)[8][2], float (&m)[2], float (&l)[2], const float (&invl)[2],
                                    const MaskF& mf, int tid, int wave, int l15, int lg) {
    if (tiles == 0ull) return;
    int kb = __builtin_ctzll(tiles); tiles &= tiles - 1ull; int cur = 0;
    f32x4 OL[2]; OL[0] = (f32x4){0.f, 0.f, 0.f, 0.f}; OL[1] = (f32x4){0.f, 0.f, 0.f, 0.f};
    { Stage st; load_tile<MODE != 1>(src, kb * 64, tid, st); store_tile<MODE != 1>(lds, tid, st); }
    __syncthreads();
    for (;;) {
        const bool more = tiles != 0ull; int nkb = 0;
        if (more) { nkb = __builtin_ctzll(tiles); tiles &= tiles - 1ull; }
        bf16x8 Pf[2][2];
        tile_qk<MODE>(lds + cur * BUF_BYTES, Qf, O, m, l, invl, kb, mf, (LAS float*)(lds + PS_OFF), wave, l15, lg, Pf, OL);
        __builtin_amdgcn_sched_barrier(0);
        Stage st;
        if (more) load_tile<MODE != 1>(src, nkb * 64, tid, st);
        if constexpr (MODE != 1) tile_pv(lds + cur * BUF_BYTES, Pf, O, l15, lg, OL, MODE == 0);
        if (more) store_tile<MODE != 1>(lds + (cur ^ 1) * BUF_BYTES, tid, st);
        __syncthreads();
        if (!more) break;
        kb = nkb; cur ^= 1;
    }
    if constexpr (MODE == 0) { l[0] = OL[0][0] * 0.25f; l[1] = OL[1][0] * 0.25f; }
}
}

__device__ __forceinline__ void xa_attn_fa(const Ctx& c, const bf16* Q, const bf16* KV, const bf16* XVT, bf16* Oo) {
    const int l15 = c.lane & 15, lg = c.lane >> 4;
    for (int u_ = c.vcu; u_ < (PROBE == 12 ? 512 : 256); u_ += c.G) {
        const int u = u_ & 255; const int bh = u >> 4, chunk = u & 15, b = bh >> 2, hd = bh & 3;
        bf16x8 Qf[2][4]; size_t grow[2];
#pragma unroll
        for (int mi = 0; mi < 2; ++mi) { grow[mi] = (size_t)b * SEQ + chunk * 256 + 32 * c.wave + 16 * mi + l15;
#pragma unroll
            for (int ks = 0; ks < 4; ++ks) Qf[mi][ks] = *(const bf16x8*)(Q + grow[mi] * 512 + hd * 128 + 32 * ks + 8 * lg); }
        f32x4 O[8][2]; float m[2] = {-1e30f, -1e30f}, l[2] = {0.f, 0.f}; const float invl[2] = {0.f, 0.f};
#pragma unroll
        for (int dt = 0; dt < 8; ++dt) { O[dt][0] = (f32x4){0.f, 0.f, 0.f, 0.f}; O[dt][1] = (f32x4){0.f, 0.f, 0.f, 0.f}; }
        fa::Src src{KV + (size_t)b * 256 * 1024 + hd * 128, 1024, XVT + (size_t)bh * 128 * 256, 256};
        fa::run<0>(c.lds, src, 0xFull, Qf, O, m, l, invl, fa::NoMask{}, c.tid, c.wave, l15, lg);
#pragma unroll
        for (int mi = 0; mi < 2; ++mi) { float lt = l[mi]; lt += __shfl_xor(lt, 16); lt += __shfl_xor(lt, 32); const float il = 1.f / lt;
#pragma unroll
            for (int dt = 0; dt < 8; ++dt) { const f32x4 o = O[dt][mi] * il; v2u w; w.x = pk2(o[0], o[1]); w.y = pk2(o[2], o[3]);
                *(v2u*)(Oo + grow[mi] * 512 + hd * 128 + 16 * dt + 4 * lg) = w; } }
    }
}
__device__ __forceinline__ void xa_vt(const Ctx& c, const bf16* KV, bf16* XVT) {
    for (int it = c.vcu * 512 + c.tid; it < 16 * 128 * 32; it += c.G * 512) {
        const int m8 = it & 31, d = (it >> 5) & 127, bh = it >> 12, b = bh >> 2, hd = bh & 3; unsigned short v[8];
#pragma unroll
        for (int j = 0; j < 8; ++j) v[j] = KV[(size_t)(b * 256 + m8 * 8 + j) * 1024 + 512 + hd * 128 + d];
        v4u w; w.x = v[0] | ((unsigned)v[1] << 16); w.y = v[2] | ((unsigned)v[3] << 16); w.z = v[4] | ((unsigned)v[5] << 16); w.w = v[6] | ((unsigned)v[7] << 16);
        *(v4u*)(XVT + ((size_t)bh * 128 + d) * 256 + m8 * 8) = w;
    }
}
__device__ __forceinline__ void nsa_vt(const Ctx& c, const bf16* T, bf16* VT) {
    LAS unsigned short* Tt = (LAS unsigned short*)c.lds;
    for (int it = c.vcu; it < 2 * 16 * 64; it += c.G) {
        const int tb = it & 63, bg = (it >> 6) & 15, which = it >> 10; const bf16* src = T + (size_t)(3 + 2 * which) * NT_STRIDE + ((size_t)bg * 4096 + tb * 64) * 128;
        __syncthreads();
#pragma unroll
        for (int e = 0; e < 2; ++e) { const int cc = c.tid + 512 * e, key = cc >> 4, d8 = cc & 15; const v4u v = *(const v4u*)(src + (size_t)key * 128 + d8 * 8);
#pragma unroll
            for (int j = 0; j < 4; ++j) { Tt[(d8 * 8 + 2 * j) * 72 + key] = (unsigned short)(v[j] & 0xffffu); Tt[(d8 * 8 + 2 * j + 1) * 72 + key] = (unsigned short)(v[j] >> 16); } }
        __syncthreads();
#pragma unroll
        for (int e = 0; e < 2; ++e) { const int cc = c.tid + 512 * e, d = cc >> 3, k8 = cc & 7;
            *(v4u*)(VT + ((size_t)(which * 16 + bg) * 128 + d) * 4096 + tb * 64 + k8 * 8) = *(const LAS v4u*)((const LAS unsigned char*)Tt + d * 144 + k8 * 16); }
    }
    __syncthreads();
}
__device__ __forceinline__ void nsa_hidreduce(const Ctx& c, const float* HIDP, const float* pb, bf16* HID) {
    for (int it = c.vcu * 512 + c.tid; it < 8192 * 32; it += c.G * 512) {
        const int r = it >> 5, h0 = (it & 31) * 8, ten = r >> 12; const float* hrow = HIDP + (size_t)r * 2048 + h0;
        f32x4 a0 = *(const f32x4*)(pb + ten * 256 + h0), a1 = *(const f32x4*)(pb + ten * 256 + h0 + 4);
#pragma unroll
        for (int sp = 0; sp < 8; ++sp) { a0 += *(const f32x4*)(hrow + sp * 256); a1 += *(const f32x4*)(hrow + sp * 256 + 4); }
        v4u o; o.x = pk2(gelu_tanh(a0.x), gelu_tanh(a0.y)); o.y = pk2(gelu_tanh(a0.z), gelu_tanh(a0.w)); o.z = pk2(gelu_tanh(a1.x), gelu_tanh(a1.y)); o.w = pk2(gelu_tanh(a1.z), gelu_tanh(a1.w));
        *(v4u*)(HID + (size_t)r * 256 + h0) = o;
    }
}
__device__ __forceinline__ void nsa_w2b(const Ctx& c, const bf16* HID, const float* w2, bf16* KCb, bf16* VCT) {
    for (int it = c.vcu * 512 + c.tid; it < 8192 * 16; it += c.G * 512) {
        const int r = it >> 4, d0 = (it & 15) * 8, ten = r >> 12, bg = (r >> 8) & 15, i = r & 255; const bf16* hrow = HID + (size_t)r * 256; const float* w = w2 + (size_t)ten * 256 * 128 + d0;
        float a[8];
#pragma unroll
        for (int j = 0; j < 8; ++j) a[j] = 0.f;
#pragma unroll 4
        for (int h8 = 0; h8 < 32; ++h8) { const v4u hv = *(const v4u*)(hrow + h8 * 8);
#pragma unroll
            for (int q = 0; q < 8; ++q) { const float hf = (q & 1) ? bfhi(hv[q >> 1]) : bflo(hv[q >> 1]); const f32x4 w0 = *(const f32x4*)(w + (size_t)(h8 * 8 + q) * 128), w1 = *(const f32x4*)(w + (size_t)(h8 * 8 + q) * 128 + 4);
                a[0] += hf * w0.x; a[1] += hf * w0.y; a[2] += hf * w0.z; a[3] += hf * w0.w; a[4] += hf * w1.x; a[5] += hf * w1.y; a[6] += hf * w1.z; a[7] += hf * w1.w; } }
        if (ten == 0) { v4u o; o.x = pk2(a[0], a[1]); o.y = pk2(a[2], a[3]); o.z = pk2(a[4], a[5]); o.w = pk2(a[6], a[7]); *(v4u*)(KCb + ((size_t)bg * 256 + i) * 128 + d0) = o; }
        else {
#pragma unroll
            for (int j = 0; j < 8; ++j) VCT[((size_t)bg * 128 + d0 + j) * 256 + i] = (bf16)f2bf(a[j]); }
    }
}
#define NSA_UNIT_PROLOGUE \
        const int ui = uu >> 8, slot = uu & 255; \
        const int bg = 2 * (slot >> 5) + (slot & 1), x = (slot & 31) >> 1, qb = (ui == 0) ? x : (ui == 1) ? 31 - x : (ui == 2) ? 32 + x : 63 - x;   \
        const int b = bg >> 2, g = bg & 3, t0 = qb * 64; \
        bf16x8 Qf[2][4]; int grow[2]; int tq[2], hcol[2]; \
        _Pragma("unroll") for (int mi = 0; mi < 2; ++mi) { const int qrow = 32 * c.wave + 16 * mi + l15, tl = qrow >> 2, j = qrow & 3; tq[mi] = t0 + tl; grow[mi] = b * SEQ + tq[mi]; hcol[mi] = (g * 4 + j) * 128; \
            _Pragma("unroll") for (int ks = 0; ks < 4; ++ks) Qf[mi][ks] = *(const bf16x8*)(Q + (size_t)grow[mi] * 2048 + hcol[mi] + 32 * ks + 8 * lg); }
__device__ __forceinline__ void nsa_attn_cmp(const Ctx& c, const bf16* Q, const bf16* KCb, const bf16* VCT, const float* Gt, float* NACC, unsigned long long* SMg) {
    const int l15 = c.lane & 15, lg = c.lane >> 4, lane = c.lane;
    LAS float* PS = (LAS float*)(c.lds + fa::PS_OFF);
#if PROBE == 9
#pragma unroll 1
    for (int rep_ = 0; rep_ < 2; ++rep_)
#endif
    for (int uu = c.vcu; uu < 1024; uu += c.G) {
        NSA_UNIT_PROLOGUE
        f32x4 O[8][2]; float m[2], l[2], invl[2] = {0.f, 0.f};
        const int tmax = t0 + 63, nvmax = tmax >= 31 ? ((tmax - 31) >> 4) + 1 : 0, ntile = (nvmax + 63) >> 6;
        { const unsigned long long tiles = (1ull << ntile) - 1ull;
          fa::CmpMask mk; mk.nvq[0] = tq[0] >= 31 ? ((tq[0] - 31) >> 4) + 1 : 0; mk.nvq[1] = tq[1] >= 31 ? ((tq[1] - 31) >> 4) + 1 : 0;
          fa::Src src{KCb + (size_t)bg * 256 * 128, 128, VCT + (size_t)bg * 128 * 256, 256};
          m[0] = m[1] = -1e30f; l[0] = l[1] = 0.f;
          fa::run<1>(c.lds, src, tiles, Qf, O, m, l, invl, mk, c.tid, c.wave, l15, lg);
#pragma unroll
          for (int mi = 0; mi < 2; ++mi) { float lt = l[mi]; lt += __shfl_xor(lt, 16); lt += __shfl_xor(lt, 32); invl[mi] = lt > 0.f ? 1.f / lt : 0.f; }
#pragma unroll
          for (int dt = 0; dt < 8; ++dt) { O[dt][0] = (f32x4){0.f, 0.f, 0.f, 0.f}; O[dt][1] = (f32x4){0.f, 0.f, 0.f, 0.f}; }
          fa::run<2>(c.lds, src, tiles, Qf, O, m, l, invl, mk, c.tid, c.wave, l15, lg);
#pragma unroll
          for (int mi = 0; mi < 2; ++mi) { const float g0 = sigmoidf_(Gt[(size_t)grow[mi] * 48 + (hcol[mi] >> 7) * 3 + 0]);
#pragma unroll
              for (int dt = 0; dt < 8; ++dt) *(f32x4*)(NACC + (size_t)grow[mi] * 2048 + hcol[mi] + 16 * dt + 4 * lg) = O[dt][mi] * g0; }
        }
        __syncthreads();
        for (int i = 0; i < 8; ++i) { const int tl = 8 * c.wave + i; const LAS float* pr = PS + tl * fa::PS_STRIDE; float imp = 0.f;
            { const int i0 = (4 * lane - 1) < 0 ? 0 : 4 * lane - 1; int i1 = (4 * lane + 3) > 254 ? 254 : 4 * lane + 3; if (i1 > 64 * ntile - 1) i1 = 64 * ntile - 1; for (int q = i0; q <= i1; ++q) imp += pr[q]; }
            const bool forced = (lane == 0) || (lane <= qb && lane > qb - 3), future = lane > qb;
            const float score = forced ? 1e30f : (future ? -1e30f : imp); int rank = 0;
            for (int k = 0; k < 64; ++k) { const float sk = __shfl(score, k); rank += (sk > score || (sk == score && k < lane)) ? 1 : 0; }
            const unsigned long long sel = __ballot(rank < 16); if (lane == 0) SMg[(size_t)bg * SEQ + t0 + tl] = sel; }
        __syncthreads();
    }
}
__device__ __forceinline__ void nsa_attn_sw(const Ctx& c, const bf16* Q, const bf16* T, const bf16* VT, const float* Gt, const float* NACC, float* NACC2, const unsigned long long* SMg, bf16* OUT) {
    const int l15 = c.lane & 15, lg = c.lane >> 4, lane = c.lane;
    for (int uu_ = c.vcu; uu_ < (PROBE == 21 ? 2048 : 1024); uu_ += c.G) { const int uu = uu_ & 1023;
        NSA_UNIT_PROLOGUE
        unsigned long long um = SMg[(size_t)bg * SEQ + t0 + lane];
#pragma unroll
        for (int o = 1; o < 64; o <<= 1) { const unsigned lo_ = __shfl_xor((unsigned)um, o), hi_ = __shfl_xor((unsigned)(um >> 32), o); um |= ((unsigned long long)hi_ << 32) | lo_; }
        const unsigned long long umu = ((unsigned long long)__builtin_amdgcn_readfirstlane((unsigned)(um >> 32)) << 32) | (unsigned)__builtin_amdgcn_readfirstlane((unsigned)um);
        f32x4 O[8][2]; float m[2], l[2]; const float invl[2] = {0.f, 0.f};
        { fa::SelMask mk; mk.qb = qb; mk.tq[0] = tq[0]; mk.tq[1] = tq[1]; mk.sm[0] = SMg[(size_t)bg * SEQ + tq[0]]; mk.sm[1] = SMg[(size_t)bg * SEQ + tq[1]];
          const unsigned long long tiles = umu & ((2ull << qb) - 1ull);
          fa::Src src{T + 2 * NT_STRIDE + (size_t)bg * 4096 * 128, 128, VT + (size_t)bg * 128 * 4096, 4096};
          m[0] = m[1] = -1e30f; l[0] = l[1] = 0.f;
#pragma unroll
          for (int dt = 0; dt < 8; ++dt) { O[dt][0] = (f32x4){0.f, 0.f, 0.f, 0.f}; O[dt][1] = (f32x4){0.f, 0.f, 0.f, 0.f}; }
          fa::run<0>(c.lds, src, tiles, Qf, O, m, l, invl, mk, c.tid, c.wave, l15, lg);
#pragma unroll
          for (int mi = 0; mi < 2; ++mi) { float lt = l[mi]; lt += __shfl_xor(lt, 16); lt += __shfl_xor(lt, 32); const float sc = sigmoidf_(Gt[(size_t)grow[mi] * 48 + (hcol[mi] >> 7) * 3 + 1]) / lt;
#pragma unroll
              for (int dt = 0; dt < 8; ++dt) { const size_t off = (size_t)grow[mi] * 2048 + hcol[mi] + 16 * dt + 4 * lg; *(f32x4*)(NACC2 + off) = *(const f32x4*)(NACC + off) + O[dt][mi] * sc; } }
        }
        { fa::WinMask mk; mk.qb = qb; mk.tq[0] = tq[0]; mk.tq[1] = tq[1];
          const int kb0 = qb - 8 < 0 ? 0 : qb - 8; const unsigned long long tiles = ((2ull << qb) - 1ull) & ~((1ull << kb0) - 1ull);
          fa::Src src{T + 4 * NT_STRIDE + (size_t)bg * 4096 * 128, 128, VT + (size_t)(16 + bg) * 128 * 4096, 4096};
          m[0] = m[1] = -1e30f; l[0] = l[1] = 0.f;
#pragma unroll
          for (int dt = 0; dt < 8; ++dt) { O[dt][0] = (f32x4){0.f, 0.f, 0.f, 0.f}; O[dt][1] = (f32x4){0.f, 0.f, 0.f, 0.f}; }
          fa::run<0>(c.lds, src, tiles, Qf, O, m, l, invl, mk, c.tid, c.wave, l15, lg);
#pragma unroll
          for (int mi = 0; mi < 2; ++mi) { float lt = l[mi]; lt += __shfl_xor(lt, 16); lt += __shfl_xor(lt, 32); const float sc = sigmoidf_(Gt[(size_t)grow[mi] * 48 + (hcol[mi] >> 7) * 3 + 2]) / lt;
#pragma unroll
              for (int dt = 0; dt < 8; ++dt) { const f32x4 a = *(const f32x4*)(NACC2 + (size_t)grow[mi] * 2048 + hcol[mi] + 16 * dt + 4 * lg) + O[dt][mi] * sc; v2u w_; w_.x = pk2(a[0], a[1]); w_.y = pk2(a[2], a[3]);
                  *(v2u*)(OUT + (size_t)grow[mi] * 2048 + hcol[mi] + 16 * dt + 4 * lg) = w_; } }
        }
    }
}

struct Args { const float* in[35]; float* out; unsigned char* ws; int ph_lo, ph_hi; };
constexpr int NPH = 16, N_PHASES = 4 * NPH;


#define IN(k) (lo <= (k) && (k) < hi)
#if MK_MULTI
#define SEAM(k) do { } while (0)
#else
#if PROBE == 4
#define SEAM(k) do { if (IN(k) && IN((k) + 1)) { xcd_barrier(bar); xcd_barrier(bar); } } while (0)
#else
#define SEAM(k) do { if (IN(k) && IN((k) + 1)) xcd_barrier(bar); } while (0)
#endif
#endif
template <int L>
__device__ __forceinline__ void layer_body(const Ctx& c, const Args& args, const XcdBarrier& bar, int lo, int hi) {
    constexpr int P0 = L * NPH;
    unsigned char* ws = args.ws;
    const float* x_in = args.in[0]; const float* mem = args.in[1]; const float* norm_pre = args.in[2]; const float* norm_post = args.in[3]; const float* norm_mem = args.in[4];
    float* X = args.out;
    bf16* XB = (bf16*)(ws + WS_H); float* RS = (float*)(ws + WS_PB + 256 * 1024); bf16* POOLED = (bf16*)(ws + WS_ACT + 64 * MiB); (void)POOLED; bf16* PROJ = (bf16*)(ws + WS_PROJ); float* MF = (float*)(ws + WS_PROJ); bf16* MFb = (bf16*)(ws + WS_PROJ); bf16* ACT = (bf16*)(ws + WS_ACT);
    bf16* XQ = (bf16*)(ws + WS_Q); bf16* XO = (bf16*)(ws + WS_O); bf16* KV = (bf16*)(ws + WS_KV); bf16* MEMN = (bf16*)(ws + WS_MEMN); float* DT = (float*)(ws + WS_DT); float* PB = (float*)(ws + WS_PB); float* PBP = (float*)(ws + WS_PB + 4096); (void)PBP;
    bf16* NQ = (bf16*)(ws + WS_NQ); bf16* NT = (bf16*)(ws + WS_NT); bf16* NHID = (bf16*)(ws + WS_NHID); float* NKC = (float*)(ws + WS_NKC); float* NG = (float*)(ws + WS_NG);
    bf16* Wmi = (bf16*)(ws + W_MIX_IN); bf16* Wmo = (bf16*)(ws + W_MIX_OUT); bf16* Wmx = (bf16*)(ws + W_MIX_X);
    bf16* Wxq = (bf16*)(ws + W_XQ); bf16* Wxkv = (bf16*)(ws + W_XKV); bf16* Wxo = (bf16*)(ws + W_XO); bf16* Wup = (bf16*)(ws + W_UP); bf16* Wdn = (bf16*)(ws + W_DOWN);
    const int cid = (int)blockIdx.x;
    bf16* NVT = (bf16*)(ws + WS_NVT); bf16* XVT = (bf16*)(ws + WS_XVT); bf16* KCb = (bf16*)(ws + WS_NKC); bf16* VCT = (bf16*)(ws + WS_NKC + 1 * MiB); unsigned long long* SMg = (unsigned long long*)(ws + WS_NKC + 2 * MiB);
    (void)x_in; (void)DT; (void)PB; (void)NQ; (void)NT; (void)NHID; (void)NKC; (void)NG; (void)Wmx; (void)NVT; (void)KCb; (void)VCT; (void)SMg;

        if (IN(P0 + 0))
#if PROBE == 11
#pragma unroll 1
        for (int rep_ = 0; rep_ < 2; ++rep_)
#endif
        {
            if constexpr (L == 0) { conv_w(opq(c), args.in[5], 2048, SSD_IN, SSD_NP, Wmi, norm_pre + (L * 3) * DM); conv_w(opq(c), args.in[12], 4096, 2048, 2048, Wmo); }
            if constexpr (L == 1) nsa_posbias(opq(c), args.in[14], args.in[15], PBP);
            conv_w(opq(c), args.in[28] + (size_t)L * 2048 * 512, 2048, 512, 512, Wxq, norm_pre + (L * 3 + 1) * DM, false, c.gw, c.NGW);
            conv_w(opq(c), args.in[29] + (size_t)L * 2048 * 1024, 2048, 1024, 1024, Wxkv, nullptr, false, (c.gw + c.NGW - 256) % c.NGW, c.NGW);
            conv_w(opq(c), args.in[30] + (size_t)L * 512 * 2048, 512, 2048, 2048, Wxo, nullptr, false, (c.gw + c.NGW - 768) % c.NGW, c.NGW);
            for (int r = (c.gw + c.NGW - 1024) % c.NGW; r < 1024; r += c.NGW) rms_row_bf16(opq(c), mem + (size_t)r * DM, norm_mem + L * DM, MEMN + (size_t)r * DM, nullptr);
            if constexpr (L == 0) x_to_xb(opq(c), x_in, XB, RS);
        }
        SEAM(P0 + 0);
        if (IN(P0 + 1)) {
            constexpr int NA = (L == 0) ? 11 : (L == 1) ? 6 : (L == 2) ? 8 : 2, NBU = (L == 0) ? 10 : (L == 1) ? 5 : (L == 2) ? 8 : 2;
            if ((cid >> 3) & 1) { const int ga = ((cid & 7) | ((cid >> 4) << 3)) * 8 + c.wave;
                conv_w(opq(c), args.in[31] + (size_t)L * 2048 * FF2, 2048, FF2, FF2, Wup, norm_pre + (L * 3 + 2) * DM, true, ga, 1024);
                conv_w(opq(c), args.in[34] + (size_t)L * FFH * 2048, FFH, 2048, 2048, Wdn, nullptr, false, ga, 1024); __syncthreads(); }
            if constexpr (L == 0) { pg8::ProbSplit S; S.init(XB, Wmi, 2048, 2048, 2048, 64, SSD_NP / 256, c.G, cid); S.nA = NA; S.nB = NBU; pg8::EpiP<StBf16> E{{PROJ, SSD_NP}, RS}; pg8::gemm_phase(c.lds, S, E); }
            else if constexpr (L == 1) { nsa_posbias_reduce(opq(c), PBP, PB); pg8::ProbSplit S; S.init(XB, Wmi, 2048, 2048, 2048, 64, NSA_NP / 256, c.G, cid); S.nA = NA; S.nB = NBU; pg8::EpiP<StNsa> E{{NQ, NT, NG}, RS}; pg8::gemm_phase(c.lds, S, E); }
            else if constexpr (L == 2) { pg8::ProbSplit S; S.init(XB, Wmi, 2048, 2048, 2048, 64, 32, c.G, cid); S.nA = NA; S.nB = NBU; pg8::EpiP<StBf16BiasGelu> E{{PROJ, 8192, args.in[19]}, RS}; pg8::gemm_phase(c.lds, S, E); }
            else { pg8::ProbSplit S; S.init(XB, Wmi, 2048, 2048, 2048, 64, 8, c.G, cid); S.nA = NA; S.nB = NBU; pg8::EpiN<StF32> E{{MF, 2048}, RS}; pg8::gemm_phase(c.lds, S, E); }
        }
        SEAM(P0 + 1);
        if (IN(P0 + 2)) {
            if constexpr (L == 0) { ssd_conv(opq(c), PROJ, args.in[6], args.in[7], args.in[8], ACT, DT);
#if PROBE == 11
                ssd_conv(opq(c), PROJ, args.in[6], args.in[7], args.in[8], ACT, DT);
#endif
            }
            else if constexpr (L == 1) { pg8::ProbC S; S.init(NT, Wmx, 2048, 4096, 512, 32, 8, c.G, cid); S.a_tile_stride = (size_t)4096 * 128;
                pg8::EpiN<StF32> E{{(float*)(ws + WS_ACT), 2048}, nullptr}; pg8::gemm_phase(c.lds, S, E); nsa_vt(opq(c), NT, NVT);
#if PROBE == 11
                nsa_vt(opq(c), NT, NVT);
#endif
            }
            else if constexpr (L == 2) sgu_ln(opq(c), PROJ, args.in[20]);
            else { pool_pool(opq(c), MF, POOLED);
#if PROBE == 11
                pool_pool(opq(c), MF, POOLED);
#endif
            }
        }
        SEAM(P0 + 2);
        if (IN(P0 + 3)) {
            if constexpr (L == 0) {
#if PROBE == 10
                ssd_scan_mfma(opq(c), ACT, DT, args.in[9], args.in[10], lo < 0);
#endif
                ssd_scan_mfma(opq(c), ACT, DT, args.in[9], args.in[10], true); }
            else if constexpr (L == 1) { nsa_hidreduce(opq(c), (const float*)(ws + WS_ACT), PB, NHID); if (IN(P0 + 3) && IN(P0 + 4)) xcd_barrier(bar); nsa_w2b(opq(c), NHID, args.in[16], KCb, VCT);
#if PROBE == 11
                nsa_hidreduce(opq(c), (const float*)(ws + WS_ACT), PB, NHID); if (IN(P0 + 3) && IN(P0 + 4)) xcd_barrier(bar); nsa_w2b(opq(c), NHID, args.in[16], KCb, VCT);
#endif
            }
            else if constexpr (L == 2) sgu_spatial_mfma(opq(c), PROJ, args.in[21], args.in[22], ACT);
            else { pg8::Prob S; S.init(POOLED, Wmx, 2048, 512, 512, 64, 8, c.G, cid); S.a_group_shift = 1; S.a_group_cols = 512; pg8::EpiP<StBf16Scale> E{{ACT, 2048, args.in[26]}, nullptr}; pg8::gemm_phase(c.lds, S, E); }
        }
        SEAM(P0 + 3);
        if (IN(P0 + 4)) {
            if constexpr (L == 0) ssd_gnorm(opq(c), ACT, PROJ, args.in[11]);
            else if constexpr (L == 1) nsa_attn_cmp(opq(c), NQ, KCb, VCT, NG, MF, SMg);
        }
        if constexpr (L <= 1) SEAM(P0 + 4);
        if (IN(P0 + 5)) {
            if constexpr (L == 1) { nsa_attn_sw(opq(c), NQ, NT, NVT, NG, MF, (float*)(ws + WS_ACT + 64 * MiB), SMg, ACT);
#if PROBE == 1
                nsa_attn_sw(opq(c), NQ, NT, NVT, NG, MF, (float*)(ws + WS_ACT + 64 * MiB), SMg, ACT);
#endif
            }
        }
        if constexpr (L == 1) SEAM(P0 + 5);
        if (IN(P0 + 6)) {
            if constexpr (L == 0) { pg8::Prob S; S.init(ACT, Wmo, 6144, 4096, 4096, 64, 8, c.G, cid); pg8::EpiP<StBf16> E{{MFb, 2048}, nullptr}; pg8::gemm_phase(c.lds, S, E); }
            else if constexpr (L == 2) { pg8::Prob S; S.init(ACT, Wmo, 4096, 4096, 4096, 64, 8, c.G, cid); pg8::EpiP<StBf16> E{{MFb, 2048}, nullptr}; pg8::gemm_phase(c.lds, S, E); }
            else { pg8::Prob S; S.init(ACT, Wmo, 2048, 2048, 2048, 64, 8, c.G, cid); pg8::EpiP<StBf16> E{{MFb, 2048}, nullptr}; pg8::gemm_phase(c.lds, S, E); }
        }
        SEAM(P0 + 6);
        if (IN(P0 + 7)) postnorm(opq(c), MFb, XB, RS, norm_post + (L * 3 + 0) * DM, nullptr);
        SEAM(P0 + 7);
        if (IN(P0 + 8)) {
            { pg8::Prob S; S.init(XB, Wxq, 2048, 2048, 2048, 64, 2, c.G, cid); pg8::EpiP<StBf16> E{{XQ, 512}, RS}; pg8::gemm_phase(c.lds, S, E); }
            { pg8::Prob S; S.init(MEMN, Wxkv, 2048, 2048, 2048, 4, 4, c.G, (cid + c.G - 128) % c.G); pg8::EpiP<StKv> E{{KV, XVT}, nullptr}; pg8::gemm_phase(c.lds, S, E); }
            if (cid >= 144 && c.G == 256) { const int ga = (cid - 144) * 8 + c.wave; constexpr int NG_ = 112 * 8;
                if constexpr (L == 0) { conv_w(opq(c), args.in[13], 2048, NSA_IN, NSA_NP, Wmi, norm_pre + ((L + 1) * 3) * DM, false, ga, NG_); conv_w(opq(c), args.in[17], 2048, 2048, 2048, Wmo, nullptr, false, ga, NG_);
                    conv_w(opq(c), args.in[15], 4096, 256, 256, Wmx, nullptr, false, ga, NG_); conv_w(opq(c), args.in[15] + (size_t)4096 * 256, 4096, 256, 256, Wmx + (size_t)256 * 4096, nullptr, false, ga, NG_); }
                else if constexpr (L == 1) { conv_w(opq(c), args.in[18], 2048, 8192, 8192, Wmi, norm_pre + ((L + 1) * 3) * DM, false, ga, NG_); conv_w(opq(c), args.in[23], 4096, 2048, 2048, Wmo, nullptr, false, ga, NG_); }
                else if constexpr (L == 2) { conv_w(opq(c), args.in[24], 2048, 2048, 2048, Wmi, norm_pre + ((L + 1) * 3) * DM, false, ga, NG_); conv_w(opq(c), args.in[27], 2048, 2048, 2048, Wmo, nullptr, false, ga, NG_);
#pragma unroll 1
                    for (int g = 0; g < 4; ++g) conv_w(opq(c), args.in[25] + (size_t)g * 512 * 512, 512, 512, 512, Wmx + (size_t)g * 512 * 512, nullptr, false, ga, NG_); }
            }
        }
        SEAM(P0 + 8);
        if (IN(P0 + 9)) xa_attn_fa(opq(c), XQ, KV, XVT, XO);
        SEAM(P0 + 9);
        if (IN(P0 + 10)) { pg8::Prob S; S.init(XO, Wxo, 512, 512, 512, 64, 8, c.G, cid); pg8::EpiP<StBf16> E{{MFb, 2048}, nullptr}; pg8::gemm_phase(c.lds, S, E); }
        SEAM(P0 + 10);
        if (IN(P0 + 11)) postnorm(opq(c), MFb, XB, RS, norm_post + (L * 3 + 1) * DM, nullptr);
        SEAM(P0 + 11);
        if (IN(P0 + 12)) { pg8::ProbR S; S.init(XB, Wup, 2048, 2048, 2048, 64, 44, c.G, cid); EpiFfn E{ACT, (bf16*)(ws + WS_SXT), RS, args.in[32] + (size_t)L * 3 * FF2, args.in[33] + (size_t)L * FF2}; pg8::gemm_phase(c.lds, S, E); }
        SEAM(P0 + 12);
        if (IN(P0 + 13)) ffn_fixup(opq(c), (const bf16*)(ws + WS_SXT), args.in[32] + (size_t)L * 3 * FF2, args.in[33] + (size_t)L * FF2, ACT);
        SEAM(P0 + 13);
        if (IN(P0 + 14)) { pg8::Prob S; S.init(ACT, Wdn, FFH, FFH, FFH, 64, 8, c.G, cid); pg8::EpiP<StBf16> E{{MFb, 2048}, nullptr}; pg8::gemm_phase(c.lds, S, E); }
        SEAM(P0 + 14);
        if (IN(P0 + 15)) postnorm(opq(c), MFb, XB, RS, norm_post + (L * 3 + 2) * DM, (L == 3) ? X : nullptr);
    }
#undef IN
#undef SEAM

__global__ void __launch_bounds__(512, 2) mega_fwd(Args args) {
    extern __shared__ __attribute__((aligned(16))) unsigned char lds_raw[];
    Ctx c; c.lds = (LAS unsigned char*)lds_raw; c.tid = threadIdx.x; c.lane = c.tid & 63; c.wave = __builtin_amdgcn_readfirstlane(c.tid >> 6);
    c.G = gridDim.x; { const int bx = blockIdx.x; c.vcu = (c.G % 8 == 0) ? (bx % 8) * (c.G / 8) + bx / 8 : bx; }
    c.gw = c.vcu * 8 + c.wave; c.NGW = c.G * 8;
    volatile LAS unsigned* MISC = (volatile LAS unsigned*)(c.lds + MISC_OFF);
    if (c.tid < 64) MISC[c.tid] = 0u;
    __syncthreads();
    unsigned char* ws = args.ws;
    unsigned* ctl = (unsigned*)(ws + WS_CTL);
    XcdBarrier bar; bar.bar = ctl + CW_BAR; bar.x = 0; bar.st = nullptr;
#if !MK_MULTI
    bar = xcd_barrier_post(ctl + CW_BAR, MISC + 8);
#endif
    const int lo = args.ph_lo, hi = args.ph_hi;
    layer_body<0>(c, args, bar, lo, hi);
    layer_body<1>(c, args, bar, lo, hi);
    layer_body<2>(c, args, bar, lo, hi);
    layer_body<3>(c, args, bar, lo, hi);
}

extern "C" void kernel_launch(void* const* d_in, const int* in_sizes, int n_in, void* d_out, int out_size, void* d_ws, size_t ws_size, hipStream_t stream) {
    static int grid = 0;
    if (grid == 0) {
        if (n_in != 35 || out_size != MT * DM || ws_size < WS_END) { fprintf(stderr, "kernel_launch: unexpected shapes: n_in %d out %d ws %zu (need %zu)\n", n_in, out_size, ws_size, (size_t)WS_END); grid = -1; return; }
        int dev = 0, cus = 0, per_cu = 0;
        if (hipGetDevice(&dev) != hipSuccess || hipDeviceGetAttribute(&cus, hipDeviceAttributeMultiprocessorCount, dev) != hipSuccess) { grid = -1; return; }
        if (hipFuncSetAttribute((const void*)mega_fwd, hipFuncAttributeMaxDynamicSharedMemorySize, LDS_BYTES) != hipSuccess) { fprintf(stderr, "kernel_launch: hipFuncSetAttribute failed\n"); grid = -1; return; }
        if (hipOccupancyMaxActiveBlocksPerMultiprocessor(&per_cu, (const void*)mega_fwd, 512, LDS_BYTES) != hipSuccess || per_cu < 1) { fprintf(stderr, "kernel_launch: occupancy query says %d\n", per_cu); grid = -1; return; }
        (void)hipGetLastError();
        if (cus < 256) { fprintf(stderr, "kernel_launch: needs >= 256 CUs (got %d)\n", cus); grid = -1; return; }
        grid = 256;
    }
    if (grid < 0) return;
    (void)hipMemsetAsync((char*)d_ws + WS_CTL, 0, CTL_ZERO_BYTES, stream);
    Args a{};
    for (int i = 0; i < 35; ++i) a.in[i] = (const float*)d_in[i];
    a.out = (float*)d_out; a.ws = (unsigned char*)d_ws;
#if MK_MULTI
    for (int p = 0; p < N_PHASES; ++p) { a.ph_lo = p; a.ph_hi = p + 1; hipLaunchKernelGGL(mega_fwd, dim3(grid), dim3(512), LDS_BYTES, stream, a); }
#else
    a.ph_lo = 0; a.ph_hi = N_PHASES;
    hipLaunchKernelGGL(mega_fwd, dim3(grid), dim3(512), LDS_BYTES, stream, a);
#endif
}
```

```cpp
#include <hip/hip_runtime.h>
#include <cstdio>
#include <cstdint>

#ifndef MK_MULTI
#define MK_MULTI 0
#endif
#ifndef PROBE
#define PROBE 0
#endif

#define GAS __attribute__((address_space(1)))
#define LAS __attribute__((address_space(3)))
typedef unsigned short bf16;
typedef unsigned v4u __attribute__((ext_vector_type(4)));
typedef unsigned v2u __attribute__((ext_vector_type(2)));
typedef float f32x4 __attribute__((ext_vector_type(4)));
typedef float f32x2 __attribute__((ext_vector_type(2)));
typedef short bf16x8 __attribute__((ext_vector_type(8)));
typedef short s16x4 __attribute__((ext_vector_type(4)));
#define LDS_WAIT() asm volatile("s_waitcnt lgkmcnt(0)" ::: "memory")

constexpr int DM = 2048, NB = 4, SEQ = 4096, MT = NB * SEQ;
constexpr int SSD_NP = 10496, SSD_IN = 10304;
constexpr int NSA_NP = 5376, NSA_IN = 5168;
constexpr int FFH = 5632, FF2 = 11264;
constexpr float EPS = 1e-6f;

constexpr size_t MiB = 1u << 20;
constexpr size_t WS_CTL = 0, CTL_ZERO_BYTES = 64 * 1024;
constexpr size_t WS_W = 1 * MiB;
constexpr size_t W_MIX_IN = WS_W + 0, W_MIX_OUT = WS_W + 44 * MiB, W_MIX_X = WS_W + 62 * MiB;
constexpr size_t W_XQ = WS_W + 68 * MiB, W_XKV = WS_W + 71 * MiB, W_XO = WS_W + 76 * MiB, W_UP = WS_W + 79 * MiB, W_DOWN = WS_W + 123 * MiB;
constexpr size_t WS_H = 148 * MiB;
constexpr size_t WS_PROJ = 212 * MiB;
constexpr size_t WS_ACT = 564 * MiB;
constexpr size_t WS_Q = 756 * MiB, WS_O = 772 * MiB, WS_KV = 788 * MiB, WS_MEMN = 790 * MiB, WS_DT = 794 * MiB, WS_PB = 798 * MiB;
constexpr size_t WS_SXT = 800 * MiB;
constexpr size_t WS_SBT = 928 * MiB;
constexpr size_t WS_END = 960 * MiB;
constexpr size_t WS_NQ = WS_PROJ + 128 * MiB;
constexpr size_t WS_NT = WS_NQ + 64 * MiB;
constexpr size_t NT_STRIDE = (size_t)16 * 4096 * 128;
constexpr size_t WS_NHID = WS_NT + 97 * MiB;
constexpr size_t WS_NKC = WS_NHID + 4 * MiB;
constexpr size_t WS_NG = WS_NKC + 4 * MiB;
constexpr size_t WS_NVT = WS_NG + 3 * MiB;
static_assert(WS_NVT + 32 * MiB <= WS_ACT, "nsa map");
constexpr size_t WS_XVT = 799 * MiB;
constexpr int CW_BAR = 4096;

constexpr int LDS_BYTES = 159744;
constexpr int MISC_OFF = LDS_BYTES - 256;

__device__ __forceinline__ unsigned f2bf(float f) { unsigned u = __builtin_bit_cast(unsigned, f); return (u + 0x7fffu + ((u >> 16) & 1u)) >> 16; }
__device__ __forceinline__ unsigned pk2(float lo, float hi) { return f2bf(lo) | (f2bf(hi) << 16); }
__device__ __forceinline__ float bflo(unsigned u) { return __builtin_bit_cast(float, u << 16); }
__device__ __forceinline__ float bfhi(unsigned u) { return __builtin_bit_cast(float, u & 0xffff0000u); }
__device__ __forceinline__ float wave_sum(float v) {
#pragma unroll
    for (int o = 1; o < 64; o <<= 1) v += __shfl_xor(v, o);
    return v;
}
__device__ __forceinline__ float wave_max(float v) {
#pragma unroll
    for (int o = 1; o < 64; o <<= 1) v = fmaxf(v, __shfl_xor(v, o));
    return v;
}
__device__ __forceinline__ float sigmoidf_(float x) { return 1.f / (1.f + __expf(-x)); }
__device__ __forceinline__ float silu_fast(float x) { return x * __builtin_amdgcn_rcpf(1.f + __builtin_amdgcn_exp2f(-1.4426950408889634f * x)); }
__device__ __forceinline__ float siluf_(float x) { return x * sigmoidf_(x); }
__device__ __forceinline__ float gelu_tanh(float x) { return x * __builtin_amdgcn_rcpf(1.f + __builtin_amdgcn_exp2f(x * __builtin_fmaf(-1.029432396e-01f, x * x, -2.302208198e+00f))); }

#define XB_TMO      128
#define XB_XCNT(j)  (256  + 64 * (j))
#define XB_XSUB(j)  (1280 + 64 * (j))
#define XB_XGEN(j)  (2304 + 64 * (j))
#define XB_TOP      3328
#define XB_TOPGEN   3392
#define XCD_BAR_WORDS 3456
#define XB_SPIN_CAP (1u << 22)

__device__ __forceinline__ unsigned xb_ld(unsigned* p)              { return __hip_atomic_load(p, __ATOMIC_RELAXED, __HIP_MEMORY_SCOPE_AGENT); }
__device__ __forceinline__ unsigned xb_add(unsigned* p, unsigned v) { return __hip_atomic_fetch_add(p, v, __ATOMIC_RELAXED, __HIP_MEMORY_SCOPE_AGENT); }
__device__ __forceinline__ unsigned xb_xcc_id() { return (unsigned)__builtin_amdgcn_s_getreg((3 << 11) | 20) & 0xFu; }
#define XB_SPIN(cond, bar) do { unsigned _sp = 0; while (cond) { __builtin_amdgcn_s_sleep(1); \
    if ((++_sp & 255u) == 0u) { if (xb_ld(&(bar)[XB_TMO])) break; if (_sp > XB_SPIN_CAP) { atomicAdd(&(bar)[XB_TMO], 1u); break; } } } } while (0)

struct XcdBarrier { unsigned* bar; unsigned x; volatile LAS unsigned* st; };

__device__ __forceinline__ XcdBarrier xcd_barrier_post(unsigned* bar, volatile LAS unsigned* st) {
    XcdBarrier b; b.bar = bar; b.x = xb_xcc_id(); b.st = st;
    if (threadIdx.x == 0) (void)xb_add(&bar[XB_XCNT(b.x)], 1u);
    return b;
}
__device__ __forceinline__ void xcd_barrier_complete(unsigned* bar, unsigned x, unsigned& nloc, unsigned& nx) {
    const unsigned G = gridDim.x * gridDim.y * gridDim.z;
    unsigned sum, cnt, mine, sp = 0u;
    for (;;) {
        sum = 0u; cnt = 0u; mine = 0u;
#pragma unroll
        for (unsigned j = 0; j < 16; ++j) { const unsigned c = xb_ld(&bar[XB_XCNT(j)]); sum += c; cnt += (c > 0u) ? 1u : 0u; mine = (j == x) ? c : mine; }
        if (sum == G) break;
        __builtin_amdgcn_s_sleep(1);
        if ((++sp & 255u) == 0u) { if (xb_ld(&bar[XB_TMO])) break; if (sp > XB_SPIN_CAP) { atomicAdd(&bar[XB_TMO], 1u); break; } }
    }
    nloc = mine > 0u ? mine : 1u; nx = cnt > 0u ? cnt : 1u;
}
__device__ __forceinline__ void xcd_barrier(const XcdBarrier& b) {
    asm volatile("s_waitcnt vmcnt(0)" ::: "memory");
    __syncthreads();
    if (threadIdx.x == 0) {
        unsigned* bar = b.bar;
        __builtin_amdgcn_s_waitcnt(0);
        unsigned nloc = b.st[0], nx = b.st[1];
        if (nloc == 0u) { xcd_barrier_complete(bar, b.x, nloc, nx); b.st[0] = nloc; b.st[1] = nx; }
        const unsigned old = xb_add(&bar[XB_XSUB(b.x)], 1u);
        const unsigned gen = old / nloc;
        if (old + 1u == (gen + 1u) * nloc) {
            __builtin_amdgcn_fence(__ATOMIC_RELEASE, "agent");
            asm volatile("s_waitcnt vmcnt(0)" ::: "memory");
            const unsigned og = xb_add(&bar[XB_TOP], 1u);
            const unsigned tg = og / nx;
            if (og + 1u == (tg + 1u) * nx) xb_add(&bar[XB_TOPGEN], 1u);
            else XB_SPIN(xb_ld(&bar[XB_TOPGEN]) == tg, bar);
            __builtin_amdgcn_fence(__ATOMIC_ACQUIRE, "agent");
            xb_add(&bar[XB_XGEN(b.x)], 1u);
            asm volatile("s_waitcnt vmcnt(0)" ::: "memory");
        } else {
            XB_SPIN(xb_ld(&bar[XB_XGEN(b.x)]) == gen, bar);
            __builtin_amdgcn_fence(__ATOMIC_ACQUIRE, "agent");
            asm volatile("s_waitcnt vmcnt(0)" ::: "memory");
        }
    }
    __syncthreads();
}

namespace pg8 {
constexpr int BM = 256, BK = 64, HALF = 128, HTB = HALF * BK * 2, STAGE_BYTES = 8 * HTB, NXCD = 8, WGM = 8;
__device__ __forceinline__ int lds_byte(int r, int c) { const int st = (r >> 4) * 2 + (c >> 5), rr = r & 15, cc = c & 31, ob = rr * 64 + cc * 2; return st * 1024 + (ob ^ (((ob >> 9) & 1) << 5)); }
__device__ __forceinline__ void stage_rc(int b, int& R, int& C) { const int st = b / 1024, sb = b % 1024, swz = sb ^ (((sb >> 9) & 1) << 5); R = (st >> 1) * 16 + swz / 64; C = (st & 1) * 32 + (swz % 64) / 2; }
__device__ __forceinline__ int perm32(int rho) { const int n = rho >> 4, i = rho & 15; return 8 * (i >> 2) + 4 * n + (i & 3); }
struct Unit { int pm, pn; };
struct Prob {
    static constexpr bool ROWPERM = false;
    const bf16* A; const bf16* Bt; int lda, ldb, K, nM, nN, G, c; int a_group_shift, a_group_cols;
    size_t a_tile_stride, b_tile_stride;
    __device__ __forceinline__ void init(const bf16* A_, const bf16* Bt_, int lda_, int ldb_, int K_, int nM_, int nN_, int G_, int c_) {
        A = A_; Bt = Bt_; lda = lda_; ldb = ldb_; K = K_; nM = nM_; nN = nN_; G = G_; c = c_; a_group_shift = 0; a_group_cols = 0; a_tile_stride = (size_t)256 * lda_; b_tile_stride = (size_t)256 * ldb_; }
    __device__ __forceinline__ bool next(int i, Unit& u) const {
        const int nwg = nM * nN; const long L = (long)i * G + c; if (L >= nwg) return false;
        int wgid = (int)L; { const int q = nwg / NXCD, r = nwg % NXCD, xcd = wgid % NXCD, off = wgid / NXCD; wgid = (xcd < r ? xcd * (q + 1) : r * (q + 1) + (xcd - r) * q) + off; }
        const int nig = WGM * nN, gid = wgid / nig, fm = gid * WGM, gsz = (nM - fm) < WGM ? (nM - fm) : WGM;
        u.pm = fm + ((wgid % nig) % gsz); u.pn = (wgid % nig) / gsz; return true;
    }
    __device__ __forceinline__ const char* pa(const Unit& u) const { return (const char*)(A + (size_t)u.pm * a_tile_stride + (size_t)((u.pn >> a_group_shift) * a_group_cols)); }
    __device__ __forceinline__ const char* pb(const Unit& u) const { return (const char*)(Bt + (size_t)u.pn * b_tile_stride); }
};
struct ProbR : Prob { static constexpr bool ROWPERM = true; };
struct ProbSplit : Prob { int nA, nB;
    __device__ __forceinline__ bool next(int i, Unit& u) const {
        const int nwg = nM * nN, a = (c & 7) | ((c >> 4) << 3), grp = (c >> 3) & 1;
        if (i >= (grp ? nB : nA)) return false;
        const int L = (grp ? 128 * nA : 0) + i * 128 + a; if (L >= nwg) return false;
        int wgid = L; { const int q = nwg / NXCD, r = nwg % NXCD, xcd = wgid % NXCD, off = wgid / NXCD; wgid = (xcd < r ? xcd * (q + 1) : r * (q + 1) + (xcd - r) * q) + off; }
        const int nig = WGM * nN, gid = wgid / nig, fm = gid * WGM, gsz = (nM - fm) < WGM ? (nM - fm) : WGM;
        u.pm = fm + ((wgid % nig) % gsz); u.pn = (wgid % nig) / gsz; return true;
    } };
struct ProbC : Prob {
    __device__ __forceinline__ const char* pa(const Unit& u) const { return (const char*)(A + (size_t)u.pm * a_tile_stride + (size_t)u.pn * 512); }
    __device__ __forceinline__ const char* pb(const Unit& u) const { return (const char*)(Bt + (size_t)(u.pm >> 4) * 256 * 4096 + (size_t)u.pn * 512); } };
__device__ __forceinline__ unsigned cvt_pk_bf16(float lo, float hi) { unsigned r; asm volatile("v_cvt_pk_bf16_f32 %0, %1, %2" : "=v"(r) : "v"(lo), "v"(hi)); return r; }

template <class F> struct EpiP {
    static constexpr bool PERM = true; F f; const float* rowscale;
    __device__ __forceinline__ void operator()(const f32x4 (&acc)[2][2][4][2], const Unit& u, int wr, int wc, int fr, int fq) const {
        const int row0 = u.pm * BM + wr * 64 + fr, col0 = u.pn * BM + wc * 32 + 8 * fq;
#pragma unroll
        for (int ai = 0; ai < 2; ++ai)
#pragma unroll
            for (int m = 0; m < 4; ++m) { const int row = row0 + ai * HALF + m * 16; const float rs = rowscale ? rowscale[row] : 1.f;
#pragma unroll
                for (int bj = 0; bj < 2; ++bj) f(row, col0 + bj * HALF, acc[ai][bj][m][0] * rs, acc[ai][bj][m][1] * rs); }
    }
};
template <class F> struct EpiN {
    static constexpr bool PERM = false; F f; const float* rowscale;
    __device__ __forceinline__ void operator()(const f32x4 (&acc)[2][2][4][2], const Unit& u, int wr, int wc, int fr, int fq) const {
        const int row0 = u.pm * BM + wr * 64 + fr, col0 = u.pn * BM + wc * 32 + 4 * fq;
#pragma unroll
        for (int ai = 0; ai < 2; ++ai)
#pragma unroll
            for (int m = 0; m < 4; ++m) { const int row = row0 + ai * HALF + m * 16; const float rs = rowscale ? rowscale[row] : 1.f;
#pragma unroll
                for (int bj = 0; bj < 2; ++bj)
#pragma unroll
                    for (int n = 0; n < 2; ++n) f(row, col0 + bj * HALF + n * 16, acc[ai][bj][m][n] * rs); }
    }
};

#ifndef GEMM_REP
#define GEMM_REP 1
#endif
template <class PT, class Epi> __device__ __forceinline__ void gemm_phase_once(LAS unsigned char* lds, const PT& S, const Epi& E, bool epi_on);
template <class PT, class Epi>
__device__ __forceinline__ void gemm_phase(LAS unsigned char* lds, const PT& S, const Epi& E) {
    gemm_phase_once(lds, S, E, true);
}
template <class PT, class Epi>
__device__ __forceinline__ void gemm_phase_once(LAS unsigned char* lds, const PT& S, const Epi& E, bool epi_on) {
    const int tid = threadIdx.x, wid = __builtin_amdgcn_readfirstlane(tid >> 6), lane = tid & 63, wr = wid >> 2, wc = wid & 3, fr = lane & 15, fq = lane >> 4;
    const int K = S.K, nt = K / BK, lda = S.lda, ldb = S.ldb;
    unsigned voffA[2], voffB[2];
#pragma unroll
    for (int i = 0; i < 2; ++i) { int R, C; stage_rc(tid * 16 + i * 8192, R, C); const int Rb = Epi::PERM ? ((R & ~31) + perm32(R & 31)) : R;
        const int Ra = PT::ROWPERM ? (128 * (R >> 6) + 8 * (R & 15) + ((R >> 4) & 3)) : R;
        voffA[i] = (unsigned)(Ra * lda + C) * 2u; voffB[i] = (unsigned)(Rb * ldb + C) * 2u; }
    const size_t kstep = (size_t)(BK * 2);
    const size_t hstepA = (size_t)(PT::ROWPERM ? 4 : HALF) * lda * 2, hstepB = (size_t)HALF * ldb * 2;
    const unsigned ldsw = (unsigned)wid * 1024u;
    const int aoff = lds_byte(wr * 64 + fr, fq * 8), boff = lds_byte(wc * 32 + fr, fq * 8);
#define PG8_SA(b, h) (((b) * 2 + (h)) * HTB)
#define PG8_SB(b, h) ((4 + (b) * 2 + (h)) * HTB)
#define PG8_STAGE(bufoff, gbase, voff) do { _Pragma("unroll") for (int _i = 0; _i < 2; ++_i) \
        __builtin_amdgcn_global_load_lds((const unsigned*)((const char*)(gbase) + (voff)[_i]), (LAS unsigned*)(lds + (bufoff) + ldsw + _i * 8192), 16, 0, 0); } while (0)
#define PG8_LDA(dst, b, h) do { _Pragma("unroll") for (int m = 0; m < 4; ++m) _Pragma("unroll") for (int k = 0; k < 2; ++k) dst[m][k] = *(const LAS bf16x8*)(lds + PG8_SA(b, h) + aoff + m * 2048 + k * 1024); } while (0)
#define PG8_LDB(dst, b, h) do { _Pragma("unroll") for (int n = 0; n < 2; ++n) _Pragma("unroll") for (int k = 0; k < 2; ++k) dst[n][k] = *(const LAS bf16x8*)(lds + PG8_SB(b, h) + boff + n * 2048 + k * 1024); } while (0)
#define PG8_MMA(ai, bj, At, Bt) do { __builtin_amdgcn_s_setprio(1); _Pragma("unroll") for (int m = 0; m < 4; ++m) _Pragma("unroll") for (int n = 0; n < 2; ++n) _Pragma("unroll") for (int k = 0; k < 2; ++k) \
        acc[ai][bj][m][n] = __builtin_amdgcn_mfma_f32_16x16x32_bf16(Bt[n][k], At[m][k], acc[ai][bj][m][n], 0, 0, 0); __builtin_amdgcn_s_setprio(0); } while (0)
#define PG8_WAIT_V(n) asm volatile("s_waitcnt vmcnt(" #n ")" ::: "memory")
#define PG8_WAIT_L(n) asm volatile("s_waitcnt lgkmcnt(" #n ")" ::: "memory")
#define PG8_BAR __builtin_amdgcn_s_barrier()
#define PG8_SCHED __builtin_amdgcn_sched_barrier(0)
    Unit cur, nxt; int ui = 0;
    if (!S.next(0, cur)) return;
    f32x4 acc[2][2][4][2];
#pragma unroll
    for (int a = 0; a < 2; ++a)
#pragma unroll
        for (int b = 0; b < 2; ++b)
#pragma unroll
            for (int m = 0; m < 4; ++m)
#pragma unroll
                for (int n = 0; n < 2; ++n) acc[a][b][m][n] = (f32x4){0.f, 0.f, 0.f, 0.f};
    bf16x8 At[4][2], B0[2][2], B1[2][2];
    const char* cA = S.pa(cur); const char* cB = S.pb(cur);
    PG8_STAGE(PG8_SB(0, 0), cB, voffB); PG8_STAGE(PG8_SA(0, 0), cA, voffA); PG8_STAGE(PG8_SB(0, 1), cB + hstepB, voffB); PG8_STAGE(PG8_SA(0, 1), cA + hstepA, voffA);
    if (wr == 1) PG8_BAR;
    PG8_WAIT_V(4); PG8_BAR;
    PG8_STAGE(PG8_SB(1, 0), cB + kstep, voffB); PG8_STAGE(PG8_SA(1, 0), cA + kstep, voffA); PG8_STAGE(PG8_SB(1, 1), cB + hstepB + kstep, voffB);
    PG8_WAIT_V(6); PG8_BAR;
    for (;;) {
        const bool has_next = S.next(ui + 1, nxt);
        const char* nA = has_next ? S.pa(nxt) : cA; const char* nB = has_next ? S.pb(nxt) : cB;
        for (int t = 0; t < nt; t += 2) {
            const bool last = (t == nt - 2);
            const char* a1 = cA + (size_t)(t + 1) * kstep;
            const char* a2 = last ? nA : cA + (size_t)(t + 2) * kstep; const char* b2 = last ? nB : cB + (size_t)(t + 2) * kstep;
            const char* a3 = a2 + kstep; const char* b3 = b2 + kstep;
            PG8_LDB(B0, 0, 0); PG8_SCHED; PG8_LDA(At, 0, 0); PG8_STAGE(PG8_SA(1, 1), a1 + hstepA, voffA);
            PG8_WAIT_L(8); PG8_BAR; PG8_WAIT_L(0); PG8_MMA(0, 0, At, B0); PG8_BAR; PG8_SCHED;
            PG8_LDB(B1, 0, 1); PG8_STAGE(PG8_SB(0, 0), b2, voffB);
            PG8_BAR; PG8_WAIT_L(0); PG8_MMA(0, 1, At, B1); PG8_BAR;
            PG8_LDA(At, 0, 1); PG8_STAGE(PG8_SA(0, 0), a2, voffA);
            PG8_BAR; PG8_WAIT_L(0); PG8_MMA(1, 0, At, B0); PG8_BAR; PG8_SCHED;
            PG8_STAGE(PG8_SB(0, 1), b2 + hstepB, voffB);
            PG8_WAIT_V(6); PG8_BAR; PG8_MMA(1, 1, At, B1); PG8_BAR;
            PG8_LDB(B0, 1, 0); PG8_SCHED; PG8_LDA(At, 1, 0); PG8_STAGE(PG8_SA(0, 1), a2 + hstepA, voffA);
            PG8_WAIT_L(8); PG8_BAR; PG8_WAIT_L(0); PG8_MMA(0, 0, At, B0); PG8_BAR; PG8_SCHED;
            PG8_LDB(B1, 1, 1); PG8_STAGE(PG8_SB(1, 0), b3, voffB);
            PG8_BAR; PG8_WAIT_L(0); PG8_MMA(0, 1, At, B1); PG8_BAR;
            PG8_LDA(At, 1, 1); PG8_STAGE(PG8_SA(1, 0), a3, voffA);
            PG8_BAR; PG8_WAIT_L(0); PG8_MMA(1, 0, At, B0); PG8_BAR; PG8_SCHED;
            PG8_STAGE(PG8_SB(1, 1), b3 + hstepB, voffB);
            PG8_WAIT_V(6); PG8_BAR; PG8_MMA(1, 1, At, B1); PG8_BAR;
        }
        if (epi_on) E(acc, cur, wr, wc, fr, fq);
        if (!has_next) break;
#pragma unroll
        for (int a = 0; a < 2; ++a)
#pragma unroll
            for (int b = 0; b < 2; ++b)
#pragma unroll
                for (int m = 0; m < 4; ++m)
#pragma unroll
                    for (int n = 0; n < 2; ++n) acc[a][b][m][n] = (f32x4){0.f, 0.f, 0.f, 0.f};
        cur = nxt; cA = nA; cB = nB; ++ui;
    }
    PG8_WAIT_V(0);
    if (wr == 0) PG8_BAR;
    PG8_BAR;
#undef PG8_SA
#undef PG8_SB
#undef PG8_STAGE
#undef PG8_LDA
#undef PG8_LDB
#undef PG8_MMA
#undef PG8_WAIT_V
#undef PG8_WAIT_L
#undef PG8_BAR
#undef PG8_SCHED
}
}

typedef const f32x4 __attribute__((address_space(4)))* CF4;
struct StBf16 { bf16* O; int ldc;
    __device__ __forceinline__ void operator()(int row, int col, f32x4 v0, f32x4 v1) const {
        v4u w; w.x = pg8::cvt_pk_bf16(v0[0], v0[1]); w.y = pg8::cvt_pk_bf16(v0[2], v0[3]); w.z = pg8::cvt_pk_bf16(v1[0], v1[1]); w.w = pg8::cvt_pk_bf16(v1[2], v1[3]);
        *(v4u*)(O + (size_t)row * ldc + col) = w; } };
struct StBf16BiasGelu { bf16* O; int ldc; const float* bias;
    __device__ __forceinline__ void operator()(int row, int col, f32x4 v0, f32x4 v1) const {
        const f32x4 b0 = *(CF4)(bias + col), b1 = *(CF4)(bias + col + 4);
#pragma unroll
        for (int j = 0; j < 4; ++j) { v0[j] = gelu_tanh(v0[j] + b0[j]); v1[j] = gelu_tanh(v1[j] + b1[j]); }
        v4u w; w.x = pg8::cvt_pk_bf16(v0[0], v0[1]); w.y = pg8::cvt_pk_bf16(v0[2], v0[3]); w.z = pg8::cvt_pk_bf16(v1[0], v1[1]); w.w = pg8::cvt_pk_bf16(v1[2], v1[3]);
        *(v4u*)(O + (size_t)row * ldc + col) = w; } };
struct StBf16Scale { bf16* O; int ldc; const float* scale;
    __device__ __forceinline__ void operator()(int row, int col, f32x4 v0, f32x4 v1) const {
        const f32x4 b0 = *(CF4)(scale + col), b1 = *(CF4)(scale + col + 4);
        v0 = v0 * b0; v1 = v1 * b1;
        v4u w; w.x = pg8::cvt_pk_bf16(v0[0], v0[1]); w.y = pg8::cvt_pk_bf16(v0[2], v0[3]); w.z = pg8::cvt_pk_bf16(v1[0], v1[1]); w.w = pg8::cvt_pk_bf16(v1[2], v1[3]);
        *(v4u*)(O + (size_t)row * ldc + col) = w; } };
struct StF32 { float* C; int ldc;
    __device__ __forceinline__ void operator()(int row, int col, f32x4 v) const { *(f32x4*)(C + (size_t)row * ldc + col) = v; } };
struct StNsa { bf16* Q; bf16* T; float* Gt;
    __device__ __forceinline__ void operator()(int row, int col, f32x4 v0, f32x4 v1) const {
        v4u w; w.x = pg8::cvt_pk_bf16(v0[0], v0[1]); w.y = pg8::cvt_pk_bf16(v0[2], v0[3]); w.z = pg8::cvt_pk_bf16(v1[0], v1[1]); w.w = pg8::cvt_pk_bf16(v1[2], v1[3]);
        if (col < 2048) { *(v4u*)(Q + (size_t)row * 2048 + col) = w; }
        else if (col < 5120) { const int c2 = col - 2048, ten = c2 >> 9, g = (c2 >> 7) & 3, d = c2 & 127, b = row >> 12, t = row & 4095;
            *(v4u*)(T + (size_t)ten * NT_STRIDE + ((size_t)((b * 4 + g) * 4096 + t)) * 128 + d) = w; }
        else if (col < 5168) { float* p = Gt + (size_t)row * 48 + (col - 5120); *(f32x4*)p = v0; *(f32x4*)(p + 4) = v1; }
    } };
struct StKv { bf16* KV; bf16* XVT;
    __device__ __forceinline__ void operator()(int row, int col, f32x4 v0, f32x4 v1) const {
        if (col < 512) { v4u w; w.x = pg8::cvt_pk_bf16(v0[0], v0[1]); w.y = pg8::cvt_pk_bf16(v0[2], v0[3]); w.z = pg8::cvt_pk_bf16(v1[0], v1[1]); w.w = pg8::cvt_pk_bf16(v1[2], v1[3]); *(v4u*)(KV + (size_t)row * 1024 + col) = w; }
        else { const int c2 = col - 512, b = row >> 8, m = row & 255; bf16* p = XVT + ((size_t)(b * 4 + (c2 >> 7)) * 128 + (c2 & 127)) * 256 + m;
#pragma unroll
            for (int j = 0; j < 4; ++j) { p[(size_t)j * 256] = (bf16)f2bf(v0[j]); p[(size_t)(4 + j) * 256] = (bf16)f2bf(v1[j]); } }
    } };
struct StHid { bf16* O; const float* pb;
    __device__ __forceinline__ void operator()(int row, int col, f32x4 v0, f32x4 v1) const {
        const int ten = row >> 12; const float* bias = pb + ten * 256 + col;
        const f32x4 b0 = *(const f32x4*)(bias), b1 = *(const f32x4*)(bias + 4);
#pragma unroll
        for (int j = 0; j < 4; ++j) { v0[j] = gelu_tanh(v0[j] + b0[j]); v1[j] = gelu_tanh(v1[j] + b1[j]); }
        v4u w; w.x = pg8::cvt_pk_bf16(v0[0], v0[1]); w.y = pg8::cvt_pk_bf16(v0[2], v0[3]); w.z = pg8::cvt_pk_bf16(v1[0], v1[1]); w.w = pg8::cvt_pk_bf16(v1[2], v1[3]);
        *(v4u*)(O + (size_t)row * 256 + col) = w; } };

struct Ctx { LAS unsigned char* lds; int tid, lane, wave, vcu, G, gw, NGW; };
__device__ __forceinline__ float dpp_shr1(float x) { return __builtin_bit_cast(float, __builtin_amdgcn_update_dpp(0, __builtin_bit_cast(int, x), 0x111, 0xf, 0xf, true)); }
struct EpiFfn {
    static constexpr bool PERM = true;
    bf16* ACT; bf16* HALO; const float* RS; const float* cw; const float* cb;
    __device__ __forceinline__ void operator()(const f32x4 (&acc)[2][2][4][2], const pg8::Unit& u, int wr, int wc, int fr, int fq) const {
        const int ch0 = 128 * u.pn + 32 * wc + 8 * fq, tok0 = 256 * u.pm + 128 * wr + 8 * fr;
        const f32x4 r0 = *(const f32x4*)(RS + tok0), r1 = *(const f32x4*)(RS + tok0 + 4);
        bf16* hb = HALO + ((size_t)((u.pm * 44 + u.pn) * 2 + wr) * 4) * 256 + 32 * wc + 8 * fq;
#pragma unroll
        for (int n = 0; n < 2; ++n) {
            float g[8][4], v[8][4];
#pragma unroll
            for (int e = 0; e < 8; ++e) { const float rs = (e < 4) ? r0[e & 3] : r1[e & 3];
#pragma unroll
                for (int jj = 0; jj < 4; ++jj) { g[e][jj] = acc[e >> 2][0][e & 3][n][jj] * rs; v[e][jj] = acc[e >> 2][1][e & 3][n][jj] * rs; } }
            if (fr == 0) {
#pragma unroll
                for (int q = 0; q < 2; ++q) { v2u a, b; a.x = pk2(g[q][0], g[q][1]); a.y = pk2(g[q][2], g[q][3]); b.x = pk2(v[q][0], v[q][1]); b.y = pk2(v[q][2], v[q][3]);
                    *(v2u*)(hb + (size_t)q * 256 + 4 * n) = a; *(v2u*)(hb + (size_t)q * 256 + 128 + 4 * n) = b; } }
            if (fr == 15) {
#pragma unroll
                for (int q = 0; q < 2; ++q) { v2u a, b; a.x = pk2(g[6 + q][0], g[6 + q][1]); a.y = pk2(g[6 + q][2], g[6 + q][3]); b.x = pk2(v[6 + q][0], v[6 + q][1]); b.y = pk2(v[6 + q][2], v[6 + q][3]);
                    *(v2u*)(hb + (size_t)(2 + q) * 256 + 4 * n) = a; *(v2u*)(hb + (size_t)(2 + q) * 256 + 128 + 4 * n) = b; } }
            const int cc = ch0 + 4 * n;
            const f32x4 wg0 = *(const f32x4*)(cw + cc), wg1 = *(const f32x4*)(cw + FF2 + cc), wg2 = *(const f32x4*)(cw + 2 * FF2 + cc), wv0 = *(const f32x4*)(cw + FFH + cc), wv1 = *(const f32x4*)(cw + FF2 + FFH + cc), wv2 = *(const f32x4*)(cw + 2 * FF2 + FFH + cc);
            const f32x4 bg = *(const f32x4*)(cb + cc), bv = *(const f32x4*)(cb + FFH + cc);
#pragma unroll
            for (int jj = 0; jj < 4; ++jj) {
                float g2 = dpp_shr1(g[6][jj]), g1 = dpp_shr1(g[7][jj]), v2 = dpp_shr1(v[6][jj]), v1 = dpp_shr1(v[7][jj]);
#pragma unroll
                for (int e = 0; e < 8; ++e) { const float g0 = g[e][jj], v0 = v[e][jj];
                    const float cg = bg[jj] + wg0[jj] * g2 + wg1[jj] * g1 + wg2[jj] * g0, cv = bv[jj] + wv0[jj] * v2 + wv1[jj] * v1 + wv2[jj] * v0;
                    g[e][jj] = silu_fast(cg) * cv; g2 = g1; g1 = g0; v2 = v1; v1 = v0; } }
#pragma unroll
            for (int e = 0; e < 8; ++e) { v2u w; w.x = pk2(g[e][0], g[e][1]); w.y = pk2(g[e][2], g[e][3]); *(v2u*)(ACT + (size_t)(tok0 + e) * FFH + cc) = w; }
        }
    }
};
__device__ __forceinline__ void ffn_fixup(const Ctx& c, const bf16* HALO, const float* cw, const float* cb, bf16* ACT) {
    for (int it = c.vcu * 512 + c.tid; it < 64 * 44 * 2 * 16; it += c.G * 512) {
        const int cg8 = it & 15, wr = (it >> 4) & 1, tile = it >> 5, pm = tile / 44, pn = tile % 44, ch0 = 128 * pn + 8 * cg8;
        const bf16* cur = HALO + ((size_t)(tile * 2 + wr) * 4) * 256 + 8 * cg8;
        const bool hasprev = wr == 1 || (pm & 15) != 0; const bf16* prv = wr == 1 ? HALO + ((size_t)(tile * 2) * 4 + 2) * 256 + 8 * cg8 : HALO + ((size_t)((tile - 44) * 2 + 1) * 4 + 2) * 256 + 8 * cg8;
        const v4u z4 = (v4u){0u, 0u, 0u, 0u};
        const v4u cg0 = *(const v4u*)cur, cv0 = *(const v4u*)(cur + 128), cg1 = *(const v4u*)(cur + 256), cv1 = *(const v4u*)(cur + 256 + 128);
        const v4u pg2 = hasprev ? *(const v4u*)prv : z4, pv2 = hasprev ? *(const v4u*)(prv + 128) : z4, pg3 = hasprev ? *(const v4u*)(prv + 256) : z4, pv3 = hasprev ? *(const v4u*)(prv + 256 + 128) : z4;
        float oa[8], ob[8];
#pragma unroll
        for (int j = 0; j < 8; ++j) { const int q = j >> 1; const bool hi = j & 1;
            const float wg0 = cw[ch0 + j], wg1 = cw[FF2 + ch0 + j], wg2 = cw[2 * FF2 + ch0 + j], wv0 = cw[FFH + ch0 + j], wv1 = cw[FF2 + FFH + ch0 + j], wv2 = cw[2 * FF2 + FFH + ch0 + j], bg = cb[ch0 + j], bv = cb[FFH + ch0 + j];
            const float gA2 = hi ? bfhi(pg2[q]) : bflo(pg2[q]), gA1 = hi ? bfhi(pg3[q]) : bflo(pg3[q]), gA0 = hi ? bfhi(cg0[q]) : bflo(cg0[q]), gB0 = hi ? bfhi(cg1[q]) : bflo(cg1[q]);
            const float vA2 = hi ? bfhi(pv2[q]) : bflo(pv2[q]), vA1 = hi ? bfhi(pv3[q]) : bflo(pv3[q]), vA0 = hi ? bfhi(cv0[q]) : bflo(cv0[q]), vB0 = hi ? bfhi(cv1[q]) : bflo(cv1[q]);
            oa[j] = siluf_(bg + wg0 * gA2 + wg1 * gA1 + wg2 * gA0) * (bv + wv0 * vA2 + wv1 * vA1 + wv2 * vA0);
            ob[j] = siluf_(bg + wg0 * gA1 + wg1 * gA0 + wg2 * gB0) * (bv + wv0 * vA1 + wv1 * vA0 + wv2 * vB0); }
        const size_t tok = (size_t)256 * pm + 128 * wr;
        v4u w; w.x = pk2(oa[0], oa[1]); w.y = pk2(oa[2], oa[3]); w.z = pk2(oa[4], oa[5]); w.w = pk2(oa[6], oa[7]); *(v4u*)(ACT + tok * FFH + ch0) = w;
        w.x = pk2(ob[0], ob[1]); w.y = pk2(ob[2], ob[3]); w.z = pk2(ob[4], ob[5]); w.w = pk2(ob[6], ob[7]); *(v4u*)(ACT + (tok + 1) * FFH + ch0) = w;
    }
}


__device__ __forceinline__ void conv_w(const Ctx& c, const float* W, int K, int N, int Npad, bf16* WT, const float* gain = nullptr, bool ffnmap = false, int gw_ = -1, int ngw_ = 0) {
    LAS float* scr = (LAS float*)(c.lds + c.wave * 16640);
    const int nblk = Npad / 64, items = (K / 64) * nblk, lane = c.lane;
#if PROBE == 5
#pragma unroll 1
    for (int rep_ = 0; rep_ < 2; ++rep_)
#endif
    const int gw0 = gw_ >= 0 ? gw_ : c.gw, ngw = gw_ >= 0 ? ngw_ : c.NGW;
    for (int it = gw0; it < items; it += ngw) {
        const int kb = it / nblk, nb = it % nblk, k0 = 64 * kb, n0 = 64 * nb, nq = (lane & 15) * 4, kr = lane >> 4; const bool ok = (n0 + nq) < N;
        f32x4 v[16];
#pragma unroll
        for (int i = 0; i < 16; ++i) v[i] = ok ? __builtin_nontemporal_load((const f32x4*)(W + (size_t)(k0 + 4 * i + kr) * N + n0 + nq)) : (f32x4){0.f, 0.f, 0.f, 0.f};
        if (gain) {
#pragma unroll
            for (int i = 0; i < 16; ++i) v[i] *= gain[k0 + 4 * i + kr]; }
#pragma unroll
        for (int i = 0; i < 16; ++i) { LAS float* d = scr + (4 * i + kr) * 65 + nq; d[0] = v[i].x; d[1] = v[i].y; d[2] = v[i].z; d[3] = v[i].w; }
        LDS_WAIT(); asm volatile("" ::: "memory");
        const int c8 = lane & 7; int d0 = n0;
        if (ffnmap) { const int bj = n0 >= FFH ? 1 : 0, chn = n0 - FFH * bj; d0 = 256 * (chn >> 7) + 128 * bj + (chn & 127); }
#pragma unroll
        for (int j = 0; j < 8; ++j) { const int n = (lane >> 3) + 8 * j; const LAS float* sp = scr + (8 * c8) * 65 + n;
            v4u o; o.x = pk2(sp[0 * 65], sp[1 * 65]); o.y = pk2(sp[2 * 65], sp[3 * 65]); o.z = pk2(sp[4 * 65], sp[5 * 65]); o.w = pk2(sp[6 * 65], sp[7 * 65]);
            *(v4u*)(WT + (size_t)(d0 + n) * K + k0 + 8 * c8) = o; }
        LDS_WAIT(); asm volatile("" ::: "memory");
    }
}

__device__ __forceinline__ void rms_row_bf16(const Ctx& c, const float* xrow, const float* gain, bf16* orow, float* copy) {
    const f32x4* xr = (const f32x4*)xrow + c.lane; f32x4 v[8]; float s = 0.f;
#pragma unroll
    for (int j = 0; j < 8; ++j) { v[j] = xr[64 * j]; s += (v[j].x * v[j].x + v[j].y * v[j].y) + (v[j].z * v[j].z + v[j].w * v[j].w); }
    const float rs = rsqrtf(wave_sum(s) * (1.f / DM) + EPS);
    if (copy) {
#pragma unroll
        for (int j = 0; j < 8; ++j) ((f32x4*)copy + c.lane)[64 * j] = v[j]; }
    const f32x4* gr = (const f32x4*)gain + c.lane; v2u* o8 = (v2u*)orow + c.lane;
#pragma unroll
    for (int j = 0; j < 8; ++j) { const f32x4 g = gr[64 * j]; v2u o; o.x = pk2(v[j].x * rs * g.x, v[j].y * rs * g.y); o.y = pk2(v[j].z * rs * g.z, v[j].w * rs * g.w); o8[64 * j] = o; }
}
__device__ __forceinline__ void postnorm(const Ctx& c, const bf16* MF, bf16* XB, float* RS, const float* gpost, float* OUT) {
    for (int row = c.gw; row < MT; row += c.NGW) {
        const v4u* mr = (const v4u*)(MF + (size_t)row * DM) + c.lane; v4u* xr = (v4u*)(XB + (size_t)row * DM) + c.lane;
        v4u mv[4], xv[4]; float v[4][8]; float s = 0.f;
#pragma unroll
        for (int j = 0; j < 4; ++j) { mv[j] = mr[64 * j]; xv[j] = xr[64 * j]; }
#pragma unroll
        for (int j = 0; j < 4; ++j)
#pragma unroll
            for (int k = 0; k < 4; ++k) { v[j][2 * k] = bflo(mv[j][k]); v[j][2 * k + 1] = bfhi(mv[j][k]); s += v[j][2 * k] * v[j][2 * k] + v[j][2 * k + 1] * v[j][2 * k + 1]; }
        const float rs = rsqrtf(wave_sum(s) * (1.f / DM) + EPS);
        float s2 = 0.f;
#pragma unroll
        for (int j = 0; j < 4; ++j) { const float* gp = gpost + (c.lane + 64 * j) * 8; const f32x4 g0 = *(const f32x4*)gp, g1 = *(const f32x4*)(gp + 4);
#pragma unroll
            for (int k = 0; k < 4; ++k) { const float ga = (k < 2) ? g0[2 * k] : g1[2 * k - 4], gb = (k < 2) ? g0[2 * k + 1] : g1[2 * k - 3];
                v[j][2 * k] = bflo(xv[j][k]) + v[j][2 * k] * rs * ga; v[j][2 * k + 1] = bfhi(xv[j][k]) + v[j][2 * k + 1] * rs * gb;
                s2 += v[j][2 * k] * v[j][2 * k] + v[j][2 * k + 1] * v[j][2 * k + 1]; } }
        if (OUT) {
#pragma unroll
            for (int j = 0; j < 4; ++j) { float* op = OUT + (size_t)row * DM + (c.lane + 64 * j) * 8; *(f32x4*)op = (f32x4){v[j][0], v[j][1], v[j][2], v[j][3]}; *(f32x4*)(op + 4) = (f32x4){v[j][4], v[j][5], v[j][6], v[j][7]}; }
        } else {
#pragma unroll
            for (int j = 0; j < 4; ++j) { v4u o; o.x = pk2(v[j][0], v[j][1]); o.y = pk2(v[j][2], v[j][3]); o.z = pk2(v[j][4], v[j][5]); o.w = pk2(v[j][6], v[j][7]); xr[64 * j] = o; }
            const float rs2 = rsqrtf(wave_sum(s2) * (1.f / DM) + EPS); if (c.lane == 0) RS[row] = rs2;
        }
    }
}
__device__ __forceinline__ void x_to_xb(const Ctx& c, const float* X, bf16* XB, float* RS) {
    for (int row = c.gw; row < MT; row += c.NGW) {
        const f32x4* xr = (const f32x4*)(X + (size_t)row * DM) + c.lane; f32x4 v[8]; float s = 0.f;
#pragma unroll
        for (int j = 0; j < 8; ++j) { v[j] = xr[64 * j]; s += (v[j].x * v[j].x + v[j].y * v[j].y) + (v[j].z * v[j].z + v[j].w * v[j].w); }
        const float rs = rsqrtf(wave_sum(s) * (1.f / DM) + EPS); if (c.lane == 0) RS[row] = rs;
        v2u* o8 = (v2u*)(XB + (size_t)row * DM) + c.lane;
#pragma unroll
        for (int j = 0; j < 8; ++j) { v2u o; o.x = pk2(v[j].x, v[j].y); o.y = pk2(v[j].z, v[j].w); o8[64 * j] = o; }
    }
}

__device__ __forceinline__ void ffn_convact(const Ctx& c, const bf16* U, const float* cw, const float* cb, bf16* ACT) {
    const int NCG = FFH / 8, items = (MT / 8) * NCG;
    for (int it = c.vcu * 512 + c.tid; it < items; it += c.G * 512) {
        const int rb = it / NCG, cg = it % NCG, c0 = cg * 8, row0 = rb * 8, t0 = row0 & (SEQ - 1);
        v4u ga[10], va[10];
#pragma unroll
        for (int i = 0; i < 10; ++i) { const bool ok = (i >= 2) || (t0 != 0); const size_t r = (size_t)(row0 + i - 2);
            ga[i] = ok ? *(const v4u*)(U + r * FF2 + c0) : (v4u){0u, 0u, 0u, 0u}; va[i] = ok ? *(const v4u*)(U + r * FF2 + FFH + c0) : (v4u){0u, 0u, 0u, 0u}; }
        float wg[3][8], wv[3][8], bg[8], bv[8];
#pragma unroll
        for (int k = 0; k < 3; ++k) { const f32x4 a0 = *(const f32x4*)(cw + k * FF2 + c0), a1 = *(const f32x4*)(cw + k * FF2 + c0 + 4), b0 = *(const f32x4*)(cw + k * FF2 + FFH + c0), b1 = *(const f32x4*)(cw + k * FF2 + FFH + c0 + 4);
#pragma unroll
            for (int j = 0; j < 4; ++j) { wg[k][j] = a0[j]; wg[k][4 + j] = a1[j]; wv[k][j] = b0[j]; wv[k][4 + j] = b1[j]; } }
        { const f32x4 a0 = *(const f32x4*)(cb + c0), a1 = *(const f32x4*)(cb + c0 + 4), b0 = *(const f32x4*)(cb + FFH + c0), b1 = *(const f32x4*)(cb + FFH + c0 + 4);
#pragma unroll
          for (int j = 0; j < 4; ++j) { bg[j] = a0[j]; bg[4 + j] = a1[j]; bv[j] = b0[j]; bv[4 + j] = b1[j]; } }
#pragma unroll
        for (int i = 0; i < 8; ++i) {
            float o[8];
#pragma unroll
            for (int j = 0; j < 8; ++j) { const int q = j >> 1;
                const float g2 = (j & 1) ? bfhi(ga[i][q]) : bflo(ga[i][q]), g1 = (j & 1) ? bfhi(ga[i + 1][q]) : bflo(ga[i + 1][q]), g0 = (j & 1) ? bfhi(ga[i + 2][q]) : bflo(ga[i + 2][q]);
                const float v2 = (j & 1) ? bfhi(va[i][q]) : bflo(va[i][q]), v1 = (j & 1) ? bfhi(va[i + 1][q]) : bflo(va[i + 1][q]), v0 = (j & 1) ? bfhi(va[i + 2][q]) : bflo(va[i + 2][q]);
                const float cgv = bg[j] + wg[0][j] * g2 + wg[1][j] * g1 + wg[2][j] * g0, cvv = bv[j] + wv[0][j] * v2 + wv[1][j] * v1 + wv[2][j] * v0;
                o[j] = siluf_(cgv) * cvv; }
            v4u w; w.x = pk2(o[0], o[1]); w.y = pk2(o[2], o[3]); w.z = pk2(o[4], o[5]); w.w = pk2(o[6], o[7]);
            *(v4u*)(ACT + (size_t)(row0 + i) * FFH + c0) = w;
        }
    }
}

__device__ __forceinline__ void ssd_conv(const Ctx& c, const bf16* P, const float* cw, const float* cb, const float* dtb, bf16* X2, float* DT) {
    const int NC = 6144, NCG = NC / 8, items = (MT / 8) * NCG;
    for (int it = c.vcu * 512 + c.tid; it < items; it += c.G * 512) {
        const int rb = it / NCG, cg = it % NCG, c0 = cg * 8, row0 = rb * 8, t0 = row0 & (SEQ - 1);
        v4u xa[11];
#pragma unroll
        for (int i = 0; i < 11; ++i) { const bool ok = (i >= 3) || (t0 != 0); xa[i] = ok ? *(const v4u*)(P + (size_t)(row0 + i - 3) * SSD_NP + 4096 + c0) : (v4u){0u, 0u, 0u, 0u}; }
        float w[4][8], bb[8];
#pragma unroll
        for (int k = 0; k < 4; ++k) { const f32x4 a0 = *(const f32x4*)(cw + k * NC + c0), a1 = *(const f32x4*)(cw + k * NC + c0 + 4);
#pragma unroll
            for (int j = 0; j < 4; ++j) { w[k][j] = a0[j]; w[k][4 + j] = a1[j]; } }
        { const f32x4 a0 = *(const f32x4*)(cb + c0), a1 = *(const f32x4*)(cb + c0 + 4);
#pragma unroll
          for (int j = 0; j < 4; ++j) { bb[j] = a0[j]; bb[4 + j] = a1[j]; } }
#pragma unroll
        for (int i = 0; i < 8; ++i) {
            float o[8];
#pragma unroll
            for (int j = 0; j < 8; ++j) { const int q = j >> 1; float y = bb[j];
#pragma unroll
                for (int k = 0; k < 4; ++k) y += w[k][j] * ((j & 1) ? bfhi(xa[i + k][q]) : bflo(xa[i + k][q]));
                o[j] = silu_fast(y); }
            v4u wv; wv.x = pk2(o[0], o[1]); wv.y = pk2(o[2], o[3]); wv.z = pk2(o[4], o[5]); wv.w = pk2(o[6], o[7]);
            *(v4u*)(X2 + (size_t)(row0 + i) * NC + c0) = wv;
        }
    }
    for (int it = c.vcu * 512 + c.tid; it < MT * 64; it += c.G * 512) {
        const int row = it >> 6, h = it & 63; const float raw = bflo((unsigned)P[(size_t)row * SSD_NP + 10240 + h]) + dtb[h];
        DT[it] = raw > 20.f ? raw : log1pf(expf(raw));
    }
}

__device__ __forceinline__ s16x4 tr16(const LAS unsigned char* p) { return __builtin_amdgcn_ds_read_tr16_b64_v4i16((LAS s16x4*)p); }
__device__ __forceinline__ bf16x8 cat8(s16x4 a, s16x4 b) { bf16x8 r; r[0] = a[0]; r[1] = a[1]; r[2] = a[2]; r[3] = a[3]; r[4] = b[0]; r[5] = b[1]; r[6] = b[2]; r[7] = b[3]; return r; }
__device__ __forceinline__ void ssd_scan_mfma(const Ctx& c, bf16* X2, const float* DT, const float* a_log, const float* dskip, bool do_store) {
    constexpr int SS_B = 0, SS_C = 17408, SS_XR = 34816, SS_XD = 44032, SS_XW = 53248, SS_SB = 62464  , SS_CS = 97280  , SS_DTS = 97792  ;
    LAS unsigned char* L = c.lds;
    const int tid = c.tid, lane = c.lane, l15 = lane & 15, lg = lane >> 4, w = c.wave, lt = w >> 1, ph = w & 1, tq = l15 >> 2, tp = l15 & 3;
    for (int u = c.vcu; u < NB * 64; u += c.G) {
        const int b = u >> 6, h = u & 63, g = h >> 3; const float Ah = -expf(a_log[h]), Dh = dskip[h];
        f32x4 ST[4];
#pragma unroll
        for (int i = 0; i < 4; ++i) ST[i] = (f32x4){0.f, 0.f, 0.f, 0.f};
        __syncthreads();
        for (int i = tid; i < 17408 / 16; i += 512) *(LAS v4u*)(L + SS_SB + i * 16) = (v4u){0u, 0u, 0u, 0u};
        v4u rB[2], rC[2], rXR; float rdt = 0.f;
        const bf16* x2b = X2 + (size_t)b * SEQ * 6144;
#define SSD_LOAD(t0_) do { _Pragma("unroll") for (int e = 0; e < 2; ++e) { const int cc = tid + 512 * e; \
            rB[e] = *(const v4u*)(x2b + (size_t)((t0_) + (cc >> 4)) * 6144 + 4096 + g * 128 + (cc & 15) * 8); rC[e] = *(const v4u*)(x2b + (size_t)((t0_) + (cc >> 4)) * 6144 + 5120 + g * 128 + (cc & 15) * 8); } \
            rXR = *(const v4u*)(x2b + (size_t)((t0_) + (tid >> 3)) * 6144 + h * 64 + (tid & 7) * 8); } while (0)
#define SSD_CS(buf_) do { if (w == 0) { float a = rdt * Ah; \
            _Pragma("unroll") for (int o = 1; o < 64; o <<= 1) { const float v = __shfl_up(a, o); if (lane >= o) a += v; } \
            ((LAS float*)(L + SS_CS))[(buf_) * 64 + lane] = a; ((LAS float*)(L + SS_DTS))[(buf_) * 64 + lane] = rdt; } } while (0)
#define SSD_LDT(t0_) do { if (w == 0) rdt = DT[((size_t)b * SEQ + (t0_) + lane) * 64 + h]; } while (0)
        SSD_LOAD(0); SSD_LDT(0); SSD_CS(0); SSD_LDT(64);
        for (int ch = 0; ch < SEQ / 64; ++ch) {
            const int t0 = ch * 64, cb = ch & 1; LAS float* CS = (LAS float*)(L + SS_CS) + cb * 64; LAS float* DTS = (LAS float*)(L + SS_DTS) + cb * 64;
            LAS unsigned char* SBr = L + SS_SB + cb * 17408; LAS unsigned char* SBw = L + SS_SB + (cb ^ 1) * 17408;
            __syncthreads();
#pragma unroll
            for (int e = 0; e < 2; ++e) { const int cc = tid + 512 * e;
                *(LAS v4u*)(L + SS_B + (cc >> 4) * 272 + (cc & 15) * 16) = rB[e]; *(LAS v4u*)(L + SS_C + (cc >> 4) * 272 + (cc & 15) * 16) = rC[e]; }
            *(LAS v4u*)(L + SS_XR + (tid >> 3) * 144 + (tid & 7) * 16) = rXR;
            { const int sr = tid >> 3, p8 = tid & 7; const float fd = DTS[sr], fw = fd * __expf(CS[63] - CS[sr]);
              float xv[8];
#pragma unroll
              for (int j = 0; j < 4; ++j) { xv[2 * j] = bflo(rXR[j]); xv[2 * j + 1] = bfhi(rXR[j]); }
              v4u o1, o2; o1.x = pk2(xv[0] * fd, xv[1] * fd); o1.y = pk2(xv[2] * fd, xv[3] * fd); o1.z = pk2(xv[4] * fd, xv[5] * fd); o1.w = pk2(xv[6] * fd, xv[7] * fd);
              o2.x = pk2(xv[0] * fw, xv[1] * fw); o2.y = pk2(xv[2] * fw, xv[3] * fw); o2.z = pk2(xv[4] * fw, xv[5] * fw); o2.w = pk2(xv[6] * fw, xv[7] * fw);
              *(LAS v4u*)(L + SS_XD + sr * 144 + p8 * 16) = o1; *(LAS v4u*)(L + SS_XW + sr * 144 + p8 * 16) = o2; }
            if (ch + 1 < SEQ / 64) { SSD_LOAD(t0 + 64); SSD_CS(cb ^ 1); if (ch + 2 < SEQ / 64) SSD_LDT(t0 + 128); }
            __syncthreads();
            {
                const float csl = CS[16 * lt + l15];
                bf16x8 Cf[4];
#pragma unroll
                for (int ks = 0; ks < 4; ++ks) Cf[ks] = *(const LAS bf16x8*)(L + SS_C + (16 * lt + l15) * 272 + (32 * ks + 8 * lg) * 2);
                f32x4 GT[4];
#pragma unroll
                for (int st = 0; st < 4; ++st) { GT[st] = (f32x4){0.f, 0.f, 0.f, 0.f};
                    if (st <= lt) {
#pragma unroll
                        for (int ks = 0; ks < 4; ++ks) { const bf16x8 bf = *(const LAS bf16x8*)(L + SS_B + (16 * st + l15) * 272 + (32 * ks + 8 * lg) * 2); GT[st] = __builtin_amdgcn_mfma_f32_16x16x32_bf16(bf, Cf[ks], GT[st], 0, 0, 0); }
                        const f32x4 css = *(const LAS f32x4*)(CS + 16 * st + 4 * lg);
#pragma unroll
                        for (int r = 0; r < 4; ++r) { const bool ok = (16 * st + 4 * lg + r) <= (16 * lt + l15); GT[st][r] = ok ? GT[st][r] * __expf(csl - css[r]) : 0.f; }
                    } }
                bf16x8 Lf[2];
#pragma unroll
                for (int k2 = 0; k2 < 2; ++k2) { v4u q; q.x = pg8::cvt_pk_bf16(GT[2 * k2][0], GT[2 * k2][1]); q.y = pg8::cvt_pk_bf16(GT[2 * k2][2], GT[2 * k2][3]); q.z = pg8::cvt_pk_bf16(GT[2 * k2 + 1][0], GT[2 * k2 + 1][1]); q.w = pg8::cvt_pk_bf16(GT[2 * k2 + 1][2], GT[2 * k2 + 1][3]);
                    Lf[k2] = __builtin_bit_cast(bf16x8, q); }
                const float el = __expf(csl);
                const LAS unsigned char* xdb = L + SS_XD + (4 * lg + tq) * 144 + tp * 8;
#pragma unroll
                for (int pp = 0; pp < 2; ++pp) { const int pt = 2 * ph + pp; f32x4 Y = (f32x4){0.f, 0.f, 0.f, 0.f}, Yo = (f32x4){0.f, 0.f, 0.f, 0.f};
#pragma unroll
                    for (int k2 = 0; k2 < 2; ++k2) if (2 * k2 <= lt) { const LAS unsigned char* xp = xdb + k2 * 32 * 144 + pt * 32;
                        Y = __builtin_amdgcn_mfma_f32_16x16x32_bf16(cat8(tr16(xp), tr16(xp + 16 * 144)), Lf[k2], Y, 0, 0, 0); }
#pragma unroll
                    for (int ks = 0; ks < 4; ++ks) { const bf16x8 sb = *(const LAS bf16x8*)(SBr + (16 * pt + l15) * 272 + (32 * ks + 8 * lg) * 2); Yo = __builtin_amdgcn_mfma_f32_16x16x32_bf16(sb, Cf[ks], Yo, 0, 0, 0); }
                    const v2u xr = *(const LAS v2u*)(L + SS_XR + (16 * lt + l15) * 144 + (16 * pt + 4 * lg) * 2);
                    const float y0 = Y[0] + el * Yo[0] + Dh * bflo(xr.x), y1 = Y[1] + el * Yo[1] + Dh * bfhi(xr.x), y2 = Y[2] + el * Yo[2] + Dh * bflo(xr.y), y3 = Y[3] + el * Yo[3] + Dh * bfhi(xr.y);
                    v2u o; o.x = pk2(y0, y1); o.y = pk2(y2, y3);
                    if (do_store) *(v2u*)(X2 + ((size_t)b * SEQ + t0 + 16 * lt + l15) * 6144 + h * 64 + 16 * pt + 4 * lg) = o; }
                const float e63 = __expf(CS[63]); const int pts = w >> 1;
                const LAS unsigned char* bb = L + SS_B + (8 * lg + tq) * 272 + tp * 8; const LAS unsigned char* xwb = L + SS_XW + (8 * lg + tq) * 144 + tp * 8 + pts * 32;
                bf16x8 Xf[2];
#pragma unroll
                for (int ks = 0; ks < 2; ++ks) Xf[ks] = cat8(tr16(xwb + ks * 32 * 144), tr16(xwb + ks * 32 * 144 + 4 * 144));
#pragma unroll
                for (int i = 0; i < 4; ++i) { const int nt = 4 * (w & 1) + i; ST[i] *= e63;
#pragma unroll
                    for (int ks = 0; ks < 2; ++ks) { const LAS unsigned char* bp = bb + ks * 32 * 272 + nt * 32;
                        ST[i] = __builtin_amdgcn_mfma_f32_16x16x32_bf16(cat8(tr16(bp), tr16(bp + 4 * 272)), Xf[ks], ST[i], 0, 0, 0); }
                    v2u q; q.x = pk2(ST[i][0], ST[i][1]); q.y = pk2(ST[i][2], ST[i][3]);
                    *(LAS v2u*)(SBw + (16 * pts + l15) * 272 + (16 * nt + 4 * lg) * 2) = q; }
            }
        }
#undef SSD_LOAD
#undef SSD_CS
#undef SSD_LDT
    }
    __syncthreads();
}

__device__ __forceinline__ void ssd_gnorm(const Ctx& c, bf16* X2, const bf16* P, const float* g) {
    for (int row = c.gw; row < MT; row += c.NGW) {
        v4u* yr = (v4u*)(X2 + (size_t)row * 6144) + c.lane; const v4u* zr = (const v4u*)(P + (size_t)row * SSD_NP) + c.lane;
        float v[8][8]; float s = 0.f;
#pragma unroll
        for (int j = 0; j < 8; ++j) { const v4u y = yr[64 * j], z = zr[64 * j];
#pragma unroll
            for (int k = 0; k < 4; ++k) { const float a = bflo(y[k]) * siluf_(bflo(z[k])), b = bfhi(y[k]) * siluf_(bfhi(z[k])); v[j][2 * k] = a; v[j][2 * k + 1] = b; s += a * a + b * b; } }
        const float rs = rsqrtf(wave_sum(s) * (1.f / 4096.f) + EPS);
#pragma unroll
        for (int j = 0; j < 8; ++j) { const float* gg = g + (c.lane + 64 * j) * 8; const f32x4 g0 = *(const f32x4*)gg, g1 = *(const f32x4*)(gg + 4);
            v4u w; w.x = pk2(v[j][0] * rs * g0.x, v[j][1] * rs * g0.y); w.y = pk2(v[j][2] * rs * g0.z, v[j][3] * rs * g0.w); w.z = pk2(v[j][4] * rs * g1.x, v[j][5] * rs * g1.y); w.w = pk2(v[j][6] * rs * g1.z, v[j][7] * rs * g1.w);
            yr[64 * j] = w; }
    }
}

__device__ __forceinline__ void sgu_ln(const Ctx& c, bf16* P, const float* g) {
    for (int row = c.gw; row < MT; row += c.NGW) {
        v4u* vr = (v4u*)(P + (size_t)row * 8192 + 4096) + c.lane;
        float v[8][8]; float s = 0.f;
#pragma unroll
        for (int j = 0; j < 8; ++j) { const v4u y = vr[64 * j];
#pragma unroll
            for (int k = 0; k < 4; ++k) { v[j][2 * k] = bflo(y[k]); v[j][2 * k + 1] = bfhi(y[k]); s += v[j][2 * k] + v[j][2 * k + 1]; } }
        const float mu = wave_sum(s) * (1.f / 4096.f); float q = 0.f;
#pragma unroll
        for (int j = 0; j < 8; ++j)
#pragma unroll
            for (int k = 0; k < 8; ++k) { v[j][k] -= mu; q += v[j][k] * v[j][k]; }
        const float rs = rsqrtf(wave_sum(q) * (1.f / 4096.f) + EPS);
#pragma unroll
        for (int j = 0; j < 8; ++j) { const float* gg = g + (c.lane + 64 * j) * 8; const f32x4 g0 = *(const f32x4*)gg, g1 = *(const f32x4*)(gg + 4);
            v4u w; w.x = pk2(v[j][0] * rs * g0.x, v[j][1] * rs * g0.y); w.y = pk2(v[j][2] * rs * g0.z, v[j][3] * rs * g0.w); w.z = pk2(v[j][4] * rs * g1.x, v[j][5] * rs * g1.y); w.w = pk2(v[j][6] * rs * g1.z, v[j][7] * rs * g1.w);
            vr[64 * j] = w; }
    }
}
__device__ __forceinline__ void sgu_spatial(const Ctx& c, const bf16* P, const float* Wsp, const float* bsp, bf16* ACT) {
    LAS unsigned char* Vs = c.lds;
    for (int u = c.vcu; u < NB * 32 * 8; u += c.G) {
        const int g = u & 7, bc = u >> 3; const size_t row0 = (size_t)bc * 128;
        __syncthreads();
        for (int i = c.tid; i < 128 * 64; i += 512) { const int s = i >> 6, d8 = i & 63; *(LAS v4u*)(Vs + s * 1024 + d8 * 16) = *(const v4u*)(P + (row0 + s) * 8192 + 4096 + g * 512 + d8 * 8); }
        __syncthreads();
        const int d8 = c.lane;
        for (int i = 0; i < 16; ++i) {
            const int t = c.wave + 8 * i; const float* wrow = Wsp + ((size_t)g * 128 + t) * 128;
            float acc[8];
#pragma unroll
            for (int j = 0; j < 8; ++j) acc[j] = 0.f;
            for (int s = 0; s <= t; ++s) { const float w = wrow[s]; const v4u v = *(const LAS v4u*)(Vs + s * 1024 + d8 * 16);
#pragma unroll
                for (int j = 0; j < 4; ++j) { acc[2 * j] += w * bflo(v[j]); acc[2 * j + 1] += w * bfhi(v[j]); } }
            const float bb = bsp[g * 128 + t]; const v4u uu = *(const v4u*)(P + (row0 + t) * 8192 + g * 512 + d8 * 8);
            v4u w; w.x = pk2(bflo(uu.x) * (acc[0] + bb), bfhi(uu.x) * (acc[1] + bb)); w.y = pk2(bflo(uu.y) * (acc[2] + bb), bfhi(uu.y) * (acc[3] + bb));
            w.z = pk2(bflo(uu.z) * (acc[4] + bb), bfhi(uu.z) * (acc[5] + bb)); w.w = pk2(bflo(uu.w) * (acc[6] + bb), bfhi(uu.w) * (acc[7] + bb));
            *(v4u*)(ACT + (row0 + t) * 4096 + g * 512 + d8 * 8) = w;
        }
    }
    __syncthreads();
}

__device__ __forceinline__ void sgu_spatial_mfma(const Ctx& c, const bf16* P, const float* Wsp, const float* bsp, bf16* ACT) {
    constexpr int RS = 528, WB = 128 * RS, WRS = 272;
    LAS unsigned char* L = c.lds; const int tid = c.tid, l15 = c.lane & 15, lg = c.lane >> 4, w = c.wave;
    for (int u_ = c.vcu; u_ < (PROBE == 22 ? 2 : 1) * NB * 32 * 8; u_ += c.G) {
        const int u = u_ & (NB * 32 * 8 - 1); const int g = u & 7, bc = u >> 3; const size_t row0 = (size_t)bc * 128;
        __syncthreads();
#pragma unroll
        for (int e = 0; e < 4; ++e) { const int cc = tid + 512 * e, t = cc >> 4, s8 = cc & 15; const float* wp = Wsp + ((size_t)g * 128 + t) * 128 + s8 * 8; f32x4 a = *(const f32x4*)wp, b = *(const f32x4*)(wp + 4);
#pragma unroll
            for (int j = 0; j < 4; ++j) { if (s8 * 8 + j > t) a[j] = 0.f; if (s8 * 8 + 4 + j > t) b[j] = 0.f; }
            v4u q; q.x = pk2(a[0], a[1]); q.y = pk2(a[2], a[3]); q.z = pk2(b[0], b[1]); q.w = pk2(b[2], b[3]); *(LAS v4u*)(L + WB + t * WRS + s8 * 16) = q; }
        for (int half = 0; half < 2; ++half) {
            if (half) __syncthreads();
#pragma unroll
            for (int e = 0; e < 8; ++e) { const int cc = tid + 512 * e, sr = cc >> 5, d8 = cc & 31; *(LAS v4u*)(L + sr * RS + d8 * 16) = *(const v4u*)(P + (row0 + sr) * 8192 + 4096 + g * 512 + 256 * half + d8 * 8); }
            __syncthreads();
            bf16x8 Wf[4];
#pragma unroll
            for (int ks = 0; ks < 4; ++ks) Wf[ks] = *(const LAS bf16x8*)(L + WB + (16 * w + l15) * WRS + (32 * ks + 8 * lg) * 2);
            const int nks = (w >> 1) + 1; const int t = 16 * w + l15; const float bb = bsp[g * 128 + t];
            const LAS unsigned char* vb = L + (8 * lg + (l15 >> 2)) * RS + (l15 & 3) * 8;
            v2u uv[16];
#pragma unroll
            for (int dt = 0; dt < 16; ++dt) uv[dt] = *(const v2u*)(P + (row0 + t) * 8192 + (size_t)g * 512 + 256 * half + 16 * dt + 4 * lg);
#pragma unroll
            for (int dt = 0; dt < 16; ++dt) {
                f32x4 acc = (f32x4){0.f, 0.f, 0.f, 0.f};
#pragma unroll
                for (int ks = 0; ks < 4; ++ks) if (ks < nks) {
                    const s16x4 a0 = __builtin_amdgcn_ds_read_tr16_b64_v4i16((LAS s16x4*)(vb + ks * 32 * RS + dt * 32)), a1 = __builtin_amdgcn_ds_read_tr16_b64_v4i16((LAS s16x4*)(vb + ks * 32 * RS + 4 * RS + dt * 32));
                    bf16x8 af; af[0] = a0[0]; af[1] = a0[1]; af[2] = a0[2]; af[3] = a0[3]; af[4] = a1[0]; af[5] = a1[1]; af[6] = a1[2]; af[7] = a1[3];
                    acc = __builtin_amdgcn_mfma_f32_16x16x32_bf16(af, Wf[ks], acc, 0, 0, 0); }
                const size_t col = (size_t)g * 512 + 256 * half + 16 * dt + 4 * lg;
                const v2u uu = uv[dt];
                v2u o; o.x = pk2(bflo(uu.x) * (acc[0] + bb), bfhi(uu.x) * (acc[1] + bb)); o.y = pk2(bflo(uu.y) * (acc[2] + bb), bfhi(uu.y) * (acc[3] + bb));
                *(v2u*)(ACT + (row0 + t) * 4096 + col) = o;
            }
        }
    }
    __syncthreads();
}

template <int WIN> __device__ __forceinline__ f32x4 pool_sum(const float* zp, int t) {
    f32x4 v[WIN];
#pragma unroll
    for (int j = 1; j < WIN; ++j) v[j] = (j <= t) ? *(const f32x4*)(zp - (size_t)j * DM) : (f32x4){0.f, 0.f, 0.f, 0.f};
    f32x4 s = (f32x4){0.f, 0.f, 0.f, 0.f};
#pragma unroll
    for (int j = 1; j < WIN; ++j) s += v[j];
    return s;
}
__device__ __forceinline__ void pool_pool(const Ctx& c, const float* Z, bf16* O) {
    for (int it = c.vcu * 512 + c.tid; it < MT * 512; it += c.G * 512) {
        const int row = it >> 9, c4 = (it & 511) * 4, gi = __builtin_amdgcn_readfirstlane(c4 >> 9), win = 2 << gi, t = row & (SEQ - 1), cnt = (t + 1 < win) ? t + 1 : win;
        const float* zp = Z + (size_t)row * DM + c4; const f32x4 z0 = *(const f32x4*)zp; f32x4 s;
        if (gi == 0) s = pool_sum<2>(zp, t); else if (gi == 1) s = pool_sum<4>(zp, t); else if (gi == 2) s = pool_sum<8>(zp, t); else s = pool_sum<16>(zp, t);
        s += z0;
        const float ic = 1.f / (float)cnt; v2u o; o.x = pk2(s.x * ic - z0.x, s.y * ic - z0.y); o.y = pk2(s.z * ic - z0.z, s.w * ic - z0.w);
        *(v2u*)(O + (size_t)row * DM + c4) = o;
    }
}

__device__ __forceinline__ void xa_attn(const Ctx& c, const bf16* Q, const bf16* KV, bf16* O) {
    LAS unsigned char* Ks = c.lds; LAS unsigned char* Vs = c.lds + 69632; LAS float* qs = (LAS float*)(c.lds + 135168 + c.wave * 1536); LAS float* ps = qs + 128;
    const int lane = c.lane; const float scale = 0.08838834764831845f;
    for (int u = c.vcu; u < 256; u += c.G) {
        const int bh = u >> 4, chunk = u & 15, b = bh >> 2, hd = bh & 3;
        __syncthreads();
        for (int i = c.tid; i < 256 * 16; i += 512) { const int key = i >> 4, d8 = i & 15; const bf16* src = KV + (size_t)(b * 256 + key) * 1024 + hd * 128 + d8 * 8;
            *(LAS v4u*)(Ks + key * 272 + d8 * 16) = *(const v4u*)src; *(LAS v4u*)(Vs + key * 256 + d8 * 16) = *(const v4u*)(src + 512); }
        __syncthreads();
        for (int i = 0; i < 32; ++i) {
            const size_t row = (size_t)b * SEQ + chunk * 256 + c.wave * 32 + i;
            const unsigned qq = *(const unsigned*)(Q + row * 512 + hd * 128 + 2 * lane);
            qs[2 * lane] = bflo(qq); qs[2 * lane + 1] = bfhi(qq);
            LDS_WAIT();
            float sc[4] = {0.f, 0.f, 0.f, 0.f};
#pragma unroll 2
            for (int d8 = 0; d8 < 16; ++d8) { const f32x4 q0 = *(const LAS f32x4*)(qs + d8 * 8), q1 = *(const LAS f32x4*)(qs + d8 * 8 + 4);
#pragma unroll
                for (int r = 0; r < 4; ++r) { const v4u kv = *(const LAS v4u*)(Ks + (lane + 64 * r) * 272 + d8 * 16);
                    sc[r] += bflo(kv.x) * q0.x + bfhi(kv.x) * q0.y + bflo(kv.y) * q0.z + bfhi(kv.y) * q0.w + bflo(kv.z) * q1.x + bfhi(kv.z) * q1.y + bflo(kv.w) * q1.z + bfhi(kv.w) * q1.w; } }
#pragma unroll
            for (int r = 0; r < 4; ++r) sc[r] *= scale;
            const float m = wave_max(fmaxf(fmaxf(sc[0], sc[1]), fmaxf(sc[2], sc[3])));
            float l = 0.f;
#pragma unroll
            for (int r = 0; r < 4; ++r) { const float p = __expf(sc[r] - m); l += p; ps[lane + 64 * r] = p; }
            l = wave_sum(l);
            LDS_WAIT();
            float o0 = 0.f, o1 = 0.f;
#pragma unroll 8
            for (int key = 0; key < 256; ++key) { const float p = ps[key]; const unsigned vv = *(const LAS unsigned*)(Vs + key * 256 + lane * 4); o0 += p * bflo(vv); o1 += p * bfhi(vv); }
            const float il = 1.f / l;
            *(unsigned*)(O + row * 512 + hd * 128 + 2 * lane) = pk2(o0 * il, o1 * il);
            LDS_WAIT();
        }
    }
    __syncthreads();
}

__device__ __forceinline__ void nsa_posbias(const Ctx& c, const float* pos, const float* w1, float* PBP) {
    for (int o = ((c.gw & 3) == 3) ? (c.gw >> 2) : 512; o < 512; o += (c.NGW >> 2)) { const int ten = o >> 8, nb = (o >> 6) & 3, ks = o & 63, n = nb * 64 + c.lane; float a = 0.f;
#pragma unroll 16
        for (int k = 0; k < 64; ++k) a += pos[ten * 4096 + ks * 64 + k] * w1[((size_t)ten * 4096 + ks * 64 + k) * 256 + n];
        PBP[(ten * 64 + ks) * 256 + n] = a; }
}
__device__ __forceinline__ void nsa_posbias_reduce(const Ctx& c, const float* PBP, float* PB) {
    if (c.vcu == 0) { const int ten = c.tid >> 8, n = c.tid & 255; float a = 0.f;
#pragma unroll 16
        for (int ks = 0; ks < 64; ++ks) a += PBP[(ten * 64 + ks) * 256 + n];
        PB[c.tid] = a; }
}
__device__ __forceinline__ void nsa_w2(const Ctx& c, const bf16* HID, const float* w2, float* KC) {
    for (int it = c.vcu * 512 + c.tid; it < 8192 * 128; it += c.G * 512) {
        const int r = it >> 7, d = it & 127, ten = r >> 12; const bf16* hrow = HID + (size_t)r * 256; const float* w = w2 + (size_t)ten * 256 * 128 + d; float a = 0.f;
#pragma unroll 8
        for (int h = 0; h < 256; ++h) a += bflo((unsigned)hrow[h]) * w[h * 128];
        KC[it] = a;
    }
}
__device__ __forceinline__ void nsa_block(const bf16* Kb, const bf16* Vb, bool valid, const LAS float* qs, LAS float* ps, int lane, float (&m)[4], float (&l)[4], float (&o)[4][2]) {
    const float scale = 0.08838834764831845f;
    float sc[4] = {0.f, 0.f, 0.f, 0.f};
    const v4u* kr = (const v4u*)(Kb + (size_t)lane * 128);
#pragma unroll 4
    for (int d8 = 0; d8 < 16; ++d8) { const v4u kv = kr[d8]; float k[8];
#pragma unroll
        for (int j = 0; j < 4; ++j) { k[2 * j] = bflo(kv[j]); k[2 * j + 1] = bfhi(kv[j]); }
#pragma unroll
        for (int h = 0; h < 4; ++h) { const f32x4 q0 = *(const LAS f32x4*)(qs + h * 128 + d8 * 8), q1 = *(const LAS f32x4*)(qs + h * 128 + d8 * 8 + 4);
            sc[h] += k[0] * q0.x + k[1] * q0.y + k[2] * q0.z + k[3] * q0.w + k[4] * q1.x + k[5] * q1.y + k[6] * q1.z + k[7] * q1.w; } }
    float alpha[4];
#pragma unroll
    for (int h = 0; h < 4; ++h) { const float s = valid ? sc[h] * scale : -1e30f; const float mn = fmaxf(m[h], wave_max(s)); const float p = valid ? __expf(s - mn) : 0.f;
        alpha[h] = __expf(m[h] - mn); m[h] = mn; l[h] = l[h] * alpha[h] + wave_sum(p); ps[h * 64 + lane] = p; o[h][0] *= alpha[h]; o[h][1] *= alpha[h]; }
    LDS_WAIT();
#pragma unroll 4
    for (int s = 0; s < 64; ++s) { const unsigned vv = *(const unsigned*)(Vb + (size_t)s * 128 + 2 * lane); const float v0 = bflo(vv), v1 = bfhi(vv);
#pragma unroll
        for (int h = 0; h < 4; ++h) { const float p = ps[h * 64 + s]; o[h][0] += p * v0; o[h][1] += p * v1; } }
    LDS_WAIT();
}
__device__ __forceinline__ void nsa_attn(const Ctx& c, const bf16* Q, const bf16* T, const float* KC, const float* Gt, bf16* OUT) {
    LAS float* qs = (LAS float*)(c.lds + c.wave * 8192);
    LAS float* ps = qs + 512;
    LAS float* psum = ps + 1024;
    const int lane = c.lane; const float scale = 0.08838834764831845f;
    for (int task = c.gw; task < MT * 4; task += c.NGW) {
        const int g = task & 3, row = task >> 2, b = row >> 12, t = row & 4095, bg = b * 4 + g;
        { const v4u qv = *(const v4u*)(Q + (size_t)row * 2048 + g * 512 + lane * 8); LAS float* qd = qs + lane * 8;
#pragma unroll
          for (int j = 0; j < 4; ++j) { qd[2 * j] = bflo(qv[j]); qd[2 * j + 1] = bfhi(qv[j]); } }
        LDS_WAIT();
        const int nv = (t >= 31) ? ((t - 31) >> 4) + 1 : 0;
        float oc[4][2] = {{0.f, 0.f}, {0.f, 0.f}, {0.f, 0.f}, {0.f, 0.f}};
        const float* kcb = KC + (size_t)bg * 256 * 128; const float* vcb = KC + (size_t)(16 + bg) * 256 * 128;
        psum[lane] = 0.f; psum[lane + 64] = 0.f; psum[lane + 128] = 0.f; psum[lane + 192] = 0.f;
        if (nv > 0) {
            float sc[4][4];
#pragma unroll
            for (int r = 0; r < 4; ++r) { const int i = lane + 64 * r;
#pragma unroll
                for (int h = 0; h < 4; ++h) sc[h][r] = 0.f;
                if (i < nv) { const f32x4* kr = (const f32x4*)(kcb + (size_t)i * 128);
#pragma unroll 4
                    for (int d4 = 0; d4 < 32; ++d4) { const f32x4 kv = kr[d4];
#pragma unroll
                        for (int h = 0; h < 4; ++h) { const f32x4 q0 = *(const LAS f32x4*)(qs + h * 128 + d4 * 4); sc[h][r] += kv.x * q0.x + kv.y * q0.y + kv.z * q0.z + kv.w * q0.w; } } } }
            float ps_r[4] = {0.f, 0.f, 0.f, 0.f};
#pragma unroll
            for (int h = 0; h < 4; ++h) { float mx = -1e30f;
#pragma unroll
                for (int r = 0; r < 4; ++r) { const bool ok = (lane + 64 * r) < nv; sc[h][r] = ok ? sc[h][r] * scale : -1e30f; mx = fmaxf(mx, sc[h][r]); }
                mx = wave_max(mx); float sm = 0.f;
#pragma unroll
                for (int r = 0; r < 4; ++r) { const bool ok = (lane + 64 * r) < nv; sc[h][r] = ok ? __expf(sc[h][r] - mx) : 0.f; sm += sc[h][r]; }
                sm = wave_sum(sm); const float inv = 1.f / sm;
#pragma unroll
                for (int r = 0; r < 4; ++r) { const float p = sc[h][r] * inv; ps[h * 256 + lane + 64 * r] = p; ps_r[r] += p; } }
#pragma unroll
            for (int r = 0; r < 4; ++r) psum[lane + 64 * r] = ps_r[r];
            LDS_WAIT();
            for (int i = 0; i < nv; ++i) { const f32x2 vv = *(const f32x2*)(vcb + (size_t)i * 128 + 2 * lane);
#pragma unroll
                for (int h = 0; h < 4; ++h) { const float p = ps[h * 256 + i]; oc[h][0] += p * vv.x; oc[h][1] += p * vv.y; } }
        }
        LDS_WAIT();
        const int cur = t >> 6;
        float imp = 0.f;
        { const int i0 = (4 * lane - 1) < 0 ? 0 : 4 * lane - 1, i1 = (4 * lane + 3) > 254 ? 254 : 4 * lane + 3;
          for (int i = i0; i <= i1; ++i) imp += psum[i]; }
        const bool forced = (lane == 0) || (lane <= cur && lane > cur - 3), future = lane > cur;
        const float score = forced ? 1e30f : (future ? -1e30f : imp);
        int rank = 0;
        for (int k = 0; k < 64; ++k) { const float sk = __shfl(score, k); rank += (sk > score || (sk == score && k < lane)) ? 1 : 0; }
        const unsigned long long selmask = __ballot(rank < 16);
        LDS_WAIT();
        float m1[4] = {-1e30f, -1e30f, -1e30f, -1e30f}, l1[4] = {0.f, 0.f, 0.f, 0.f}, o1[4][2] = {{0.f, 0.f}, {0.f, 0.f}, {0.f, 0.f}, {0.f, 0.f}};
        const bf16* ksb = T + 2 * NT_STRIDE + (size_t)bg * 4096 * 128; const bf16* vsb = T + 3 * NT_STRIDE + (size_t)bg * 4096 * 128;
        for (int k = 0; k <= cur; ++k) { if (!((selmask >> k) & 1ull)) continue;
            nsa_block(ksb + (size_t)k * 64 * 128, vsb + (size_t)k * 64 * 128, (k * 64 + lane) <= t, qs, ps, lane, m1, l1, o1); }
        float m2[4] = {-1e30f, -1e30f, -1e30f, -1e30f}, l2[4] = {0.f, 0.f, 0.f, 0.f}, o2[4][2] = {{0.f, 0.f}, {0.f, 0.f}, {0.f, 0.f}, {0.f, 0.f}};
        const bf16* kwb = T + 4 * NT_STRIDE + (size_t)bg * 4096 * 128; const bf16* vwb = T + 5 * NT_STRIDE + (size_t)bg * 4096 * 128;
        const int lo = (t - 511) < 0 ? 0 : (t - 511);
        for (int k = lo >> 6; k <= cur; ++k) { const int pos = k * 64 + lane;
            nsa_block(kwb + (size_t)k * 64 * 128, vwb + (size_t)k * 64 * 128, pos <= t && pos >= lo, qs, ps, lane, m2, l2, o2); }
#pragma unroll
        for (int h = 0; h < 4; ++h) { const float* gl = Gt + (size_t)row * 48 + (g * 4 + h) * 3; const float g0 = sigmoidf_(gl[0]), g1 = sigmoidf_(gl[1]), g2 = sigmoidf_(gl[2]);
            const float i1 = 1.f / l1[h], i2 = 1.f / l2[h];
            const float a = g0 * oc[h][0] + g1 * o1[h][0] * i1 + g2 * o2[h][0] * i2, bq = g0 * oc[h][1] + g1 * o1[h][1] * i1 + g2 * o2[h][1] * i2;
            *(unsigned*)(OUT + (size_t)row * 2048 + (g * 4 + h) * 128 + 2 * lane) = pk2(a, bq); }
        LDS_WAIT();
    }
}


namespace fa {
constexpr int KS_STRIDE = 272, VT_STRIDE = 144, KS_BYTES = 64 * KS_STRIDE, VT_BYTES = 128 * VT_STRIDE, BUF_BYTES = KS_BYTES + VT_BYTES;
constexpr int PS_OFF = 2 * BUF_BYTES, PS_STRIDE = 260, SM_OFF = PS_OFF + 64 * PS_STRIDE * 4;
constexpr float C2 = 0.08838834764831845f * 1.4426950408889634f;
struct Src { const bf16* K; size_t kstride; const bf16* Vt; size_t vstride; };
struct Stage { v4u k[2], v[2]; };
template <bool WITH_V> __device__ __forceinline__ void load_tile(const Src& s, int key0, int tid, Stage& st) {
#pragma unroll
    for (int e = 0; e < 2; ++e) { const int cc = tid + 512 * e;
        st.k[e] = *(const v4u*)(s.K + (size_t)(key0 + (cc >> 4)) * s.kstride + (cc & 15) * 8);
        if constexpr (WITH_V) st.v[e] = *(const v4u*)(s.Vt + (size_t)(cc >> 3) * s.vstride + key0 + (cc & 7) * 8); }
}
template <bool WITH_V> __device__ __forceinline__ void store_tile(LAS unsigned char* buf, int tid, const Stage& st) {
#pragma unroll
    for (int e = 0; e < 2; ++e) { const int cc = tid + 512 * e;
        *(LAS v4u*)(buf + (cc >> 4) * KS_STRIDE + (cc & 15) * 16) = st.k[e];
        if constexpr (WITH_V) *(LAS v4u*)(buf + KS_BYTES + (cc >> 3) * VT_STRIDE + (cc & 7) * 16) = st.v[e]; }
}
struct NoMask { __device__ __forceinline__ bool valid(int, int, int) const { return true; } __device__ __forceinline__ bool need(int) const { return false; } };
struct CmpMask { int nvq[2]; __device__ __forceinline__ bool valid(int kb, int ko, int mi) const { return kb * 64 + ko < nvq[mi]; } __device__ __forceinline__ bool need(int kb) const { return !__all(kb * 64 + 64 <= nvq[0] && kb * 64 + 64 <= nvq[1]); } };
struct SelMask { int tq[2]; unsigned long long sm[2]; int qb; __device__ __forceinline__ bool valid(int kb, int ko, int mi) const { return ((sm[mi] >> kb) & 1ull) && (kb * 64 + ko <= tq[mi]); }
    __device__ __forceinline__ bool need(int kb) const { return kb == qb || !__all((int)((sm[0] >> kb) & (sm[1] >> kb) & 1ull)); } };
struct WinMask { int tq[2]; int qb; __device__ __forceinline__ bool valid(int kb, int ko, int mi) const { const int kp = kb * 64 + ko; return kp <= tq[mi] && kp + 511 >= tq[mi]; } __device__ __forceinline__ bool need(int kb) const { return kb == qb || kb + 8 <= qb; } };

template <int MODE, class MaskF>
__device__ __forceinline__ void tile_qk(const LAS unsigned char* buf, const bf16x8 (&Qf)[2][4], f32x4 (&O)[8][2], float (&m)[2], float (&l)[2], const float (&invl)[2],
                                        int kb, const MaskF& mf, LAS float* PS, int wave, int l15, int lg, bf16x8 (&Pf)[2][2], f32x4 (&OL)[2]) {
    f32x4 S[4][2];
#pragma unroll
    for (int nt = 0; nt < 4; ++nt)
#pragma unroll
        for (int mi = 0; mi < 2; ++mi) S[nt][mi] = (f32x4){0.f, 0.f, 0.f, 0.f};
    const LAS unsigned char* kbase = buf + l15 * KS_STRIDE + lg * 16;
    bf16x8 kf[2][2];
#pragma unroll
    for (int q = 0; q < 2; ++q) kf[0][q] = *(const LAS bf16x8*)(kbase + q * 16 * KS_STRIDE);
#pragma unroll
    for (int h = 0; h < 8; ++h) { const int ks = h >> 1, n0 = (h & 1) * 2;
        if (h < 7) { const int ks1 = (h + 1) >> 1, n1 = ((h + 1) & 1) * 2;
#pragma unroll
            for (int q = 0; q < 2; ++q) kf[(h + 1) & 1][q] = *(const LAS bf16x8*)(kbase + (n1 + q) * 16 * KS_STRIDE + ks1 * 64); }
        __builtin_amdgcn_sched_barrier(0);
        __builtin_amdgcn_s_setprio(1);
#pragma unroll
        for (int q = 0; q < 2; ++q)
#pragma unroll
            for (int mi = 0; mi < 2; ++mi) S[n0 + q][mi] = __builtin_amdgcn_mfma_f32_16x16x32_bf16(kf[h & 1][q], Qf[mi][ks], S[n0 + q][mi], 0, 0, 0);
        __builtin_amdgcn_s_setprio(0);
        __builtin_amdgcn_sched_barrier(0);
    }
    const float NEG = -__builtin_inff();
    float mx[2] = {NEG, NEG};
    if (mf.need(kb)) {
#pragma unroll
        for (int nt = 0; nt < 4; ++nt)
#pragma unroll
            for (int mi = 0; mi < 2; ++mi)
#pragma unroll
                for (int r = 0; r < 4; ++r) { const float sv = mf.valid(kb, 16 * nt + 4 * lg + r, mi) ? S[nt][mi][r] : NEG; S[nt][mi][r] = sv; mx[mi] = fmaxf(mx[mi], sv); }
    } else {
#pragma unroll
        for (int nt = 0; nt < 4; ++nt)
#pragma unroll
            for (int mi = 0; mi < 2; ++mi)
#pragma unroll
                for (int r = 0; r < 4; ++r) mx[mi] = fmaxf(mx[mi], S[nt][mi][r]);
    }
#pragma unroll
    for (int mi = 0; mi < 2; ++mi) {
        float ref;
        if constexpr (MODE == 2) { ref = m[mi]; }
        else { float t = fmaxf(mx[mi], __shfl_xor(mx[mi], 16)); t = fmaxf(t, __shfl_xor(t, 32)); t *= C2;
            if (__all(t <= m[mi] + 6.0f)) { ref = m[mi]; }
            else { const float mn = fmaxf(m[mi], t); const float alpha = __builtin_amdgcn_exp2f(m[mi] - mn); m[mi] = mn; ref = mn;
                if constexpr (MODE == 0) { OL[mi] *= alpha;
#pragma unroll
                    for (int dt = 0; dt < 8; ++dt) O[dt][mi] *= alpha; }
                else l[mi] *= alpha; } }
        float ps = 0.f;
#pragma unroll
        for (int nt = 0; nt < 4; ++nt)
#pragma unroll
            for (int r = 0; r < 4; ++r) { float p = __builtin_amdgcn_exp2f(__builtin_fmaf(S[nt][mi][r], C2, -ref)); if constexpr (MODE == 2) p *= invl[mi]; S[nt][mi][r] = p; if constexpr (MODE == 1) ps += p; }
        if constexpr (MODE == 1) l[mi] += ps;
    }
    if constexpr (MODE == 2) {
#pragma unroll
        for (int nt = 0; nt < 4; ++nt)
#pragma unroll
            for (int mi = 0; mi < 2; ++mi) { f32x4 v = S[nt][mi];
#pragma unroll
                for (int r = 0; r < 4; ++r) { v[r] += __shfl_xor(v[r], 1); v[r] += __shfl_xor(v[r], 2); }
                if ((l15 & 3) == 0) *(LAS f32x4*)(PS + ((32 * wave + 16 * mi + l15) >> 2) * PS_STRIDE + 64 * kb + 16 * nt + 4 * lg) = v; }
    }
    if constexpr (MODE != 1) {
#pragma unroll
        for (int mi = 0; mi < 2; ++mi)
#pragma unroll
            for (int k2 = 0; k2 < 2; ++k2) { v4u w; w.x = pg8::cvt_pk_bf16(S[2 * k2][mi][0], S[2 * k2][mi][1]); w.y = pg8::cvt_pk_bf16(S[2 * k2][mi][2], S[2 * k2][mi][3]);
                w.z = pg8::cvt_pk_bf16(S[2 * k2 + 1][mi][0], S[2 * k2 + 1][mi][1]); w.w = pg8::cvt_pk_bf16(S[2 * k2 + 1][mi][2], S[2 * k2 + 1][mi][3]); Pf[mi][k2] = __builtin_bit_cast(bf16x8, w); }
    }
}
__device__ __forceinline__ void tile_pv(const LAS unsigned char* buf, const bf16x8 (&Pf)[2][2], f32x4 (&O)[8][2], int l15, int lg, f32x4 (&OL)[2], bool with_l) {
    if (with_l) { v4u ow; ow.x = ow.y = ow.z = ow.w = 0x3F803F80u; const bf16x8 ones = __builtin_bit_cast(bf16x8, ow);
#pragma unroll
        for (int k2 = 0; k2 < 2; ++k2)
#pragma unroll
            for (int mi = 0; mi < 2; ++mi) OL[mi] = __builtin_amdgcn_mfma_f32_16x16x32_bf16(ones, Pf[mi][k2], OL[mi], 0, 0, 0); }
    const LAS unsigned char* vbase = buf + KS_BYTES + l15 * VT_STRIDE + lg * 8;
    v2u va[2][2][2];
#define FA_LDV(slot_, g_) do { _Pragma("unroll") for (int q = 0; q < 2; ++q) { const int dt_ = ((g_) & 3) * 2 + q, k2_ = (g_) >> 2; \
        va[slot_][q][0] = *(const LAS v2u*)(vbase + dt_ * 16 * VT_STRIDE + k2_ * 64); va[slot_][q][1] = *(const LAS v2u*)(vbase + dt_ * 16 * VT_STRIDE + k2_ * 64 + 32); } } while (0)
    FA_LDV(0, 0);
#pragma unroll
    for (int g = 0; g < 8; ++g) {
        if (g < 7) FA_LDV((g + 1) & 1, g + 1);
        __builtin_amdgcn_sched_barrier(0);
        __builtin_amdgcn_s_setprio(1);
#pragma unroll
        for (int q = 0; q < 2; ++q) { const int dt = (g & 3) * 2 + q, k2 = g >> 2; v4u w; w.x = va[g & 1][q][0].x; w.y = va[g & 1][q][0].y; w.z = va[g & 1][q][1].x; w.w = va[g & 1][q][1].y; const bf16x8 vf = __builtin_bit_cast(bf16x8, w);
#pragma unroll
            for (int mi = 0; mi < 2; ++mi) O[dt][mi] = __builtin_amdgcn_mfma_f32_16x16x32_bf16(vf, Pf[mi][k2], O[dt][mi], 0, 0, 0); }
        __builtin_amdgcn_s_setprio(0);
        __builtin_amdgcn_sched_barrier(0);
    }
#undef FA_LDV
}
template <int MODE, class MaskF>
__device__ __forceinline__ void run(LAS unsigned char* lds, const Src& src, unsigned long long tiles, const bf16x8 (&Qf)[2][4], f32x4 (&O)[8][2], float (&m)[2], float (&l)[2], const float (&invl)[2],
                                    const MaskF& mf, int tid, int wave, int l15, int lg) {
    if (tiles == 0ull) return;
    int kb = __builtin_ctzll(tiles); tiles &= tiles - 1ull; int cur = 0;
    f32x4 OL[2]; OL[0] = (f32x4){0.f, 0.f, 0.f, 0.f}; OL[1] = (f32x4){0.f, 0.f, 0.f, 0.f};
    { Stage st; load_tile<MODE != 1>(src, kb * 64, tid, st); store_tile<MODE != 1>(lds, tid, st); }
    __syncthreads();
    for (;;) {
        const bool more = tiles != 0ull; int nkb = 0;
        if (more) { nkb = __builtin_ctzll(tiles); tiles &= tiles - 1ull; }
        bf16x8 Pf[2][2];
        tile_qk<MODE>(lds + cur * BUF_BYTES, Qf, O, m, l, invl, kb, mf, (LAS float*)(lds + PS_OFF), wave, l15, lg, Pf, OL);
        __builtin_amdgcn_sched_barrier(0);
        Stage st;
        if (more) load_tile<MODE != 1>(src, nkb * 64, tid, st);
        if constexpr (MODE != 1) tile_pv(lds + cur * BUF_BYTES, Pf, O, l15, lg, OL, MODE == 0);
        if (more) store_tile<MODE != 1>(lds + (cur ^ 1) * BUF_BYTES, tid, st);
        __syncthreads();
        if (!more) break;
        kb = nkb; cur ^= 1;
    }
    if constexpr (MODE == 0) { l[0] = OL[0][0] * 0.25f; l[1] = OL[1][0] * 0.25f; }
}
}

__device__ __forceinline__ void xa_attn_fa(const Ctx& c, const bf16* Q, const bf16* KV, const bf16* XVT, bf16* Oo) {
    const int l15 = c.lane & 15, lg = c.lane >> 4;
    for (int u_ = c.vcu; u_ < (PROBE == 12 ? 512 : 256); u_ += c.G) {
        const int u = u_ & 255; const int bh = u >> 4, chunk = u & 15, b = bh >> 2, hd = bh & 3;
        bf16x8 Qf[2][4]; size_t grow[2];
#pragma unroll
        for (int mi = 0; mi < 2; ++mi) { grow[mi] = (size_t)b * SEQ + chunk * 256 + 32 * c.wave + 16 * mi + l15;
#pragma unroll
            for (int ks = 0; ks < 4; ++ks) Qf[mi][ks] = *(const bf16x8*)(Q + grow[mi] * 512 + hd * 128 + 32 * ks + 8 * lg); }
        f32x4 O[8][2]; float m[2] = {-1e30f, -1e30f}, l[2] = {0.f, 0.f}; const float invl[2] = {0.f, 0.f};
#pragma unroll
        for (int dt = 0; dt < 8; ++dt) { O[dt][0] = (f32x4){0.f, 0.f, 0.f, 0.f}; O[dt][1] = (f32x4){0.f, 0.f, 0.f, 0.f}; }
        fa::Src src{KV + (size_t)b * 256 * 1024 + hd * 128, 1024, XVT + (size_t)bh * 128 * 256, 256};
        fa::run<0>(c.lds, src, 0xFull, Qf, O, m, l, invl, fa::NoMask{}, c.tid, c.wave, l15, lg);
#pragma unroll
        for (int mi = 0; mi < 2; ++mi) { float lt = l[mi]; lt += __shfl_xor(lt, 16); lt += __shfl_xor(lt, 32); const float il = 1.f / lt;
#pragma unroll
            for (int dt = 0; dt < 8; ++dt) { const f32x4 o = O[dt][mi] * il; v2u w; w.x = pk2(o[0], o[1]); w.y = pk2(o[2], o[3]);
                *(v2u*)(Oo + grow[mi] * 512 + hd * 128 + 16 * dt + 4 * lg) = w; } }
    }
}
__device__ __forceinline__ void xa_vt(const Ctx& c, const bf16* KV, bf16* XVT) {
    for (int it = c.vcu * 512 + c.tid; it < 16 * 128 * 32; it += c.G * 512) {
        const int m8 = it & 31, d = (it >> 5) & 127, bh = it >> 12, b = bh >> 2, hd = bh & 3; unsigned short v[8];
#pragma unroll
        for (int j = 0; j < 8; ++j) v[j] = KV[(size_t)(b * 256 + m8 * 8 + j) * 1024 + 512 + hd * 128 + d];
        v4u w; w.x = v[0] | ((unsigned)v[1] << 16); w.y = v[2] | ((unsigned)v[3] << 16); w.z = v[4] | ((unsigned)v[5] << 16); w.w = v[6] | ((unsigned)v[7] << 16);
        *(v4u*)(XVT + ((size_t)bh * 128 + d) * 256 + m8 * 8) = w;
    }
}
__device__ __forceinline__ void nsa_vt(const Ctx& c, const bf16* T, bf16* VT) {
    LAS unsigned short* Tt = (LAS unsigned short*)c.lds;
    for (int it = c.vcu; it < 2 * 16 * 64; it += c.G) {
        const int tb = it & 63, bg = (it >> 6) & 15, which = it >> 10; const bf16* src = T + (size_t)(3 + 2 * which) * NT_STRIDE + ((size_t)bg * 4096 + tb * 64) * 128;
        __syncthreads();
#pragma unroll
        for (int e = 0; e < 2; ++e) { const int cc = c.tid + 512 * e, key = cc >> 4, d8 = cc & 15; const v4u v = *(const v4u*)(src + (size_t)key * 128 + d8 * 8);
#pragma unroll
            for (int j = 0; j < 4; ++j) { Tt[(d8 * 8 + 2 * j) * 72 + key] = (unsigned short)(v[j] & 0xffffu); Tt[(d8 * 8 + 2 * j + 1) * 72 + key] = (unsigned short)(v[j] >> 16); } }
        __syncthreads();
#pragma unroll
        for (int e = 0; e < 2; ++e) { const int cc = c.tid + 512 * e, d = cc >> 3, k8 = cc & 7;
            *(v4u*)(VT + ((size_t)(which * 16 + bg) * 128 + d) * 4096 + tb * 64 + k8 * 8) = *(const LAS v4u*)((const LAS unsigned char*)Tt + d * 144 + k8 * 16); }
    }
    __syncthreads();
}
__device__ __forceinline__ void nsa_hidreduce(const Ctx& c, const float* HIDP, const float* pb, bf16* HID) {
    for (int it = c.vcu * 512 + c.tid; it < 8192 * 32; it += c.G * 512) {
        const int r = it >> 5, h0 = (it & 31) * 8, ten = r >> 12; const float* hrow = HIDP + (size_t)r * 2048 + h0;
        f32x4 a0 = *(const f32x4*)(pb + ten * 256 + h0), a1 = *(const f32x4*)(pb + ten * 256 + h0 + 4);
#pragma unroll
        for (int sp = 0; sp < 8; ++sp) { a0 += *(const f32x4*)(hrow + sp * 256); a1 += *(const f32x4*)(hrow + sp * 256 + 4); }
        v4u o; o.x = pk2(gelu_tanh(a0.x), gelu_tanh(a0.y)); o.y = pk2(gelu_tanh(a0.z), gelu_tanh(a0.w)); o.z = pk2(gelu_tanh(a1.x), gelu_tanh(a1.y)); o.w = pk2(gelu_tanh(a1.z), gelu_tanh(a1.w));
        *(v4u*)(HID + (size_t)r * 256 + h0) = o;
    }
}
__device__ __forceinline__ void nsa_w2b(const Ctx& c, const bf16* HID, const float* w2, bf16* KCb, bf16* VCT) {
    for (int it = c.vcu * 512 + c.tid; it < 8192 * 16; it += c.G * 512) {
        const int r = it >> 4, d0 = (it & 15) * 8, ten = r >> 12, bg = (r >> 8) & 15, i = r & 255; const bf16* hrow = HID + (size_t)r * 256; const float* w = w2 + (size_t)ten * 256 * 128 + d0;
        float a[8];
#pragma unroll
        for (int j = 0; j < 8; ++j) a[j] = 0.f;
#pragma unroll 4
        for (int h8 = 0; h8 < 32; ++h8) { const v4u hv = *(const v4u*)(hrow + h8 * 8);
#pragma unroll
            for (int q = 0; q < 8; ++q) { const float hf = (q & 1) ? bfhi(hv[q >> 1]) : bflo(hv[q >> 1]); const f32x4 w0 = *(const f32x4*)(w + (size_t)(h8 * 8 + q) * 128), w1 = *(const f32x4*)(w + (size_t)(h8 * 8 + q) * 128 + 4);
                a[0] += hf * w0.x; a[1] += hf * w0.y; a[2] += hf * w0.z; a[3] += hf * w0.w; a[4] += hf * w1.x; a[5] += hf * w1.y; a[6] += hf * w1.z; a[7] += hf * w1.w; } }
        if (ten == 0) { v4u o; o.x = pk2(a[0], a[1]); o.y = pk2(a[2], a[3]); o.z = pk2(a[4], a[5]); o.w = pk2(a[6], a[7]); *(v4u*)(KCb + ((size_t)bg * 256 + i) * 128 + d0) = o; }
        else {
#pragma unroll
            for (int j = 0; j < 8; ++j) VCT[((size_t)bg * 128 + d0 + j) * 256 + i] = (bf16)f2bf(a[j]); }
    }
}
#define NSA_UNIT_PROLOGUE \
        const int ui = uu >> 8, slot = uu & 255; \
        const int bg = 2 * (slot >> 5) + (slot & 1), x = (slot & 31) >> 1, qb = (ui == 0) ? x : (ui == 1) ? 31 - x : (ui == 2) ? 32 + x : 63 - x;   \
        const int b = bg >> 2, g = bg & 3, t0 = qb * 64; \
        bf16x8 Qf[2][4]; int grow[2]; int tq[2], hcol[2]; \
        _Pragma("unroll") for (int mi = 0; mi < 2; ++mi) { const int qrow = 32 * c.wave + 16 * mi + l15, tl = qrow >> 2, j = qrow & 3; tq[mi] = t0 + tl; grow[mi] = b * SEQ + tq[mi]; hcol[mi] = (g * 4 + j) * 128; \
            _Pragma("unroll") for (int ks = 0; ks < 4; ++ks) Qf[mi][ks] = *(const bf16x8*)(Q + (size_t)grow[mi] * 2048 + hcol[mi] + 32 * ks + 8 * lg); }
__device__ __forceinline__ void nsa_attn_cmp(const Ctx& c, const bf16* Q, const bf16* KCb, const bf16* VCT, const float* Gt, float* NACC, unsigned long long* SMg) {
    const int l15 = c.lane & 15, lg = c.lane >> 4, lane = c.lane;
    LAS float* PS = (LAS float*)(c.lds + fa::PS_OFF);
#if PROBE == 9
#pragma unroll 1
    for (int rep_ = 0; rep_ < 2; ++rep_)
#endif
    for (int uu = c.vcu; uu < 1024; uu += c.G) {
        NSA_UNIT_PROLOGUE
        f32x4 O[8][2]; float m[2], l[2], invl[2] = {0.f, 0.f};
        const int tmax = t0 + 63, nvmax = tmax >= 31 ? ((tmax - 31) >> 4) + 1 : 0, ntile = (nvmax + 63) >> 6;
        { const unsigned long long tiles = (1ull << ntile) - 1ull;
          fa::CmpMask mk; mk.nvq[0] = tq[0] >= 31 ? ((tq[0] - 31) >> 4) + 1 : 0; mk.nvq[1] = tq[1] >= 31 ? ((tq[1] - 31) >> 4) + 1 : 0;
          fa::Src src{KCb + (size_t)bg * 256 * 128, 128, VCT + (size_t)bg * 128 * 256, 256};
          m[0] = m[1] = -1e30f; l[0] = l[1] = 0.f;
          fa::run<1>(c.lds, src, tiles, Qf, O, m, l, invl, mk, c.tid, c.wave, l15, lg);
#pragma unroll
          for (int mi = 0; mi < 2; ++mi) { float lt = l[mi]; lt += __shfl_xor(lt, 16); lt += __shfl_xor(lt, 32); invl[mi] = lt > 0.f ? 1.f / lt : 0.f; }
#pragma unroll
          for (int dt = 0; dt < 8; ++dt) { O[dt][0] = (f32x4){0.f, 0.f, 0.f, 0.f}; O[dt][1] = (f32x4){0.f, 0.f, 0.f, 0.f}; }
          fa::run<2>(c.lds, src, tiles, Qf, O, m, l, invl, mk, c.tid, c.wave, l15, lg);
#pragma unroll
          for (int mi = 0; mi < 2; ++mi) { const float g0 = sigmoidf_(Gt[(size_t)grow[mi] * 48 + (hcol[mi] >> 7) * 3 + 0]);
#pragma unroll
              for (int dt = 0; dt < 8; ++dt) *(f32x4*)(NACC + (size_t)grow[mi] * 2048 + hcol[mi] + 16 * dt + 4 * lg) = O[dt][mi] * g0; }
        }
        __syncthreads();
        for (int i = 0; i < 8; ++i) { const int tl = 8 * c.wave + i; const LAS float* pr = PS + tl * fa::PS_STRIDE; float imp = 0.f;
            { const int i0 = (4 * lane - 1) < 0 ? 0 : 4 * lane - 1; int i1 = (4 * lane + 3) > 254 ? 254 : 4 * lane + 3; if (i1 > 64 * ntile - 1) i1 = 64 * ntile - 1; for (int q = i0; q <= i1; ++q) imp += pr[q]; }
            const bool forced = (lane == 0) || (lane <= qb && lane > qb - 3), future = lane > qb;
            const float score = forced ? 1e30f : (future ? -1e30f : imp); int rank = 0;
            for (int k = 0; k < 64; ++k) { const float sk = __shfl(score, k); rank += (sk > score || (sk == score && k < lane)) ? 1 : 0; }
            const unsigned long long sel = __ballot(rank < 16); if (lane == 0) SMg[(size_t)bg * SEQ + t0 + tl] = sel; }
        __syncthreads();
    }
}
__device__ __forceinline__ void nsa_attn_sw(const Ctx& c, const bf16* Q, const bf16* T, const bf16* VT, const float* Gt, const float* NACC, float* NACC2, const unsigned long long* SMg, bf16* OUT) {
    const int l15 = c.lane & 15, lg = c.lane >> 4, lane = c.lane;
    for (int uu_ = c.vcu; uu_ < (PROBE == 21 ? 2048 : 1024); uu_ += c.G) { const int uu = uu_ & 1023;
        NSA_UNIT_PROLOGUE
        unsigned long long um = SMg[(size_t)bg * SEQ + t0 + lane];
#pragma unroll
        for (int o = 1; o < 64; o <<= 1) { const unsigned lo_ = __shfl_xor((unsigned)um, o), hi_ = __shfl_xor((unsigned)(um >> 32), o); um |= ((unsigned long long)hi_ << 32) | lo_; }
        const unsigned long long umu = ((unsigned long long)__builtin_amdgcn_readfirstlane((unsigned)(um >> 32)) << 32) | (unsigned)__builtin_amdgcn_readfirstlane((unsigned)um);
        f32x4 O[8][2]; float m[2], l[2]; const float invl[2] = {0.f, 0.f};
        { fa::SelMask mk; mk.qb = qb; mk.tq[0] = tq[0]; mk.tq[1] = tq[1]; mk.sm[0] = SMg[(size_t)bg * SEQ + tq[0]]; mk.sm[1] = SMg[(size_t)bg * SEQ + tq[1]];
          const unsigned long long tiles = umu & ((2ull << qb) - 1ull);
          fa::Src src{T + 2 * NT_STRIDE + (size_t)bg * 4096 * 128, 128, VT + (size_t)bg * 128 * 4096, 4096};
          m[0] = m[1] = -1e30f; l[0] = l[1] = 0.f;
#pragma unroll
          for (int dt = 0; dt < 8; ++dt) { O[dt][0] = (f32x4){0.f, 0.f, 0.f, 0.f}; O[dt][1] = (f32x4){0.f, 0.f, 0.f, 0.f}; }
          fa::run<0>(c.lds, src, tiles, Qf, O, m, l, invl, mk, c.tid, c.wave, l15, lg);
#pragma unroll
          for (int mi = 0; mi < 2; ++mi) { float lt = l[mi]; lt += __shfl_xor(lt, 16); lt += __shfl_xor(lt, 32); const float sc = sigmoidf_(Gt[(size_t)grow[mi] * 48 + (hcol[mi] >> 7) * 3 + 1]) / lt;
#pragma unroll
              for (int dt = 0; dt < 8; ++dt) { const size_t off = (size_t)grow[mi] * 2048 + hcol[mi] + 16 * dt + 4 * lg; *(f32x4*)(NACC2 + off) = *(const f32x4*)(NACC + off) + O[dt][mi] * sc; } }
        }
        { fa::WinMask mk; mk.qb = qb; mk.tq[0] = tq[0]; mk.tq[1] = tq[1];
          const int kb0 = qb - 8 < 0 ? 0 : qb - 8; const unsigned long long tiles = ((2ull << qb) - 1ull) & ~((1ull << kb0) - 1ull);
          fa::Src src{T + 4 * NT_STRIDE + (size_t)bg * 4096 * 128, 128, VT + (size_t)(16 + bg) * 128 * 4096, 4096};
          m[0] = m[1] = -1e30f; l[0] = l[1] = 0.f;
#pragma unroll
          for (int dt = 0; dt < 8; ++dt) { O[dt][0] = (f32x4){0.f, 0.f, 0.f, 0.f}; O[dt][1] = (f32x4){0.f, 0.f, 0.f, 0.f}; }
          fa::run<0>(c.lds, src, tiles, Qf, O, m, l, invl, mk, c.tid, c.wave, l15, lg);
#pragma unroll
          for (int mi = 0; mi < 2; ++mi) { float lt = l[mi]; lt += __shfl_xor(lt, 16); lt += __shfl_xor(lt, 32); const float sc = sigmoidf_(Gt[(size_t)grow[mi] * 48 + (hcol[mi] >> 7) * 3 + 2]) / lt;
#pragma unroll
              for (int dt = 0; dt < 8; ++dt) { const f32x4 a = *(const f32x4*)(NACC2 + (size_t)grow[mi] * 2048 + hcol[mi] + 16 * dt + 4 * lg) + O[dt][mi] * sc; v2u w_; w_.x = pk2(a[0], a[1]); w_.y = pk2(a[2], a[3]);
                  *(v2u*)(OUT + (size_t)grow[mi] * 2048 + hcol[mi] + 16 * dt + 4 * lg) = w_; } }
        }
    }
}

struct Args { const float* in[35]; float* out; unsigned char* ws; int ph_lo, ph_hi; };
constexpr int NPH = 16, N_PHASES = 4 * NPH;


#define IN(k) (lo <= (k) && (k) < hi)
#if MK_MULTI
#define SEAM(k) do { } while (0)
#else
#if PROBE == 4
#define SEAM(k) do { if (IN(k) && IN((k) + 1)) { xcd_barrier(bar); xcd_barrier(bar); } } while (0)
#else
#define SEAM(k) do { if (IN(k) && IN((k) + 1)) xcd_barrier(bar); } while (0)
#endif
#endif
template <int L>
__device__ __forceinline__ void layer_body(const Ctx& c, const Args& args, const XcdBarrier& bar, int lo, int hi) {
    constexpr int P0 = L * NPH;
    unsigned char* ws = args.ws;
    const float* x_in = args.in[0]; const float* mem = args.in[1]; const float* norm_pre = args.in[2]; const float* norm_post = args.in[3]; const float* norm_mem = args.in[4];
    float* X = args.out;
    bf16* XB = (bf16*)(ws + WS_H); float* RS = (float*)(ws + WS_PB + 256 * 1024); bf16* POOLED = (bf16*)(ws + WS_ACT + 64 * MiB); (void)POOLED; bf16* PROJ = (bf16*)(ws + WS_PROJ); float* MF = (float*)(ws + WS_PROJ); bf16* MFb = (bf16*)(ws + WS_PROJ); bf16* ACT = (bf16*)(ws + WS_ACT);
    bf16* XQ = (bf16*)(ws + WS_Q); bf16* XO = (bf16*)(ws + WS_O); bf16* KV = (bf16*)(ws + WS_KV); bf16* MEMN = (bf16*)(ws + WS_MEMN); float* DT = (float*)(ws + WS_DT); float* PB = (float*)(ws + WS_PB); float* PBP = (float*)(ws + WS_PB + 4096); (void)PBP;
    bf16* NQ = (bf16*)(ws + WS_NQ); bf16* NT = (bf16*)(ws + WS_NT); bf16* NHID = (bf16*)(ws + WS_NHID); float* NKC = (float*)(ws + WS_NKC); float* NG = (float*)(ws + WS_NG);
    bf16* Wmi = (bf16*)(ws + W_MIX_IN); bf16* Wmo = (bf16*)(ws + W_MIX_OUT); bf16* Wmx = (bf16*)(ws + W_MIX_X);
    bf16* Wxq = (bf16*)(ws + W_XQ); bf16* Wxkv = (bf16*)(ws + W_XKV); bf16* Wxo = (bf16*)(ws + W_XO); bf16* Wup = (bf16*)(ws + W_UP); bf16* Wdn = (bf16*)(ws + W_DOWN);
    const int cid = (int)blockIdx.x;
    bf16* NVT = (bf16*)(ws + WS_NVT); bf16* XVT = (bf16*)(ws + WS_XVT); bf16* KCb = (bf16*)(ws + WS_NKC); bf16* VCT = (bf16*)(ws + WS_NKC + 1 * MiB); unsigned long long* SMg = (unsigned long long*)(ws + WS_NKC + 2 * MiB);
    (void)x_in; (void)DT; (void)PB; (void)NQ; (void)NT; (void)NHID; (void)NKC; (void)NG; (void)Wmx; (void)NVT; (void)KCb; (void)VCT; (void)SMg;

        if (IN(P0 + 0))
#if PROBE == 11
#pragma unroll 1
        for (int rep_ = 0; rep_ < 2; ++rep_)
#endif
        {
            if constexpr (L == 0) { conv_w(c, args.in[5], 2048, SSD_IN, SSD_NP, Wmi, norm_pre + (L * 3) * DM); conv_w(c, args.in[12], 4096, 2048, 2048, Wmo); }
            if constexpr (L == 1) nsa_posbias(c, args.in[14], args.in[15], PBP);
            conv_w(c, args.in[28] + (size_t)L * 2048 * 512, 2048, 512, 512, Wxq, norm_pre + (L * 3 + 1) * DM, false, c.gw, c.NGW);
            conv_w(c, args.in[29] + (size_t)L * 2048 * 1024, 2048, 1024, 1024, Wxkv, nullptr, false, (c.gw + c.NGW - 256) % c.NGW, c.NGW);
            conv_w(c, args.in[30] + (size_t)L * 512 * 2048, 512, 2048, 2048, Wxo, nullptr, false, (c.gw + c.NGW - 768) % c.NGW, c.NGW);
            for (int r = (c.gw + c.NGW - 1024) % c.NGW; r < 1024; r += c.NGW) rms_row_bf16(c, mem + (size_t)r * DM, norm_mem + L * DM, MEMN + (size_t)r * DM, nullptr);
            if constexpr (L == 0) x_to_xb(c, x_in, XB, RS);
        }
        SEAM(P0 + 0);
        if (IN(P0 + 1)) {
            constexpr int NA = (L == 0) ? 11 : (L == 1) ? 6 : (L == 2) ? 8 : 2, NBU = (L == 0) ? 10 : (L == 1) ? 5 : (L == 2) ? 8 : 2;
            if ((cid >> 3) & 1) { const int ga = ((cid & 7) | ((cid >> 4) << 3)) * 8 + c.wave;
                conv_w(c, args.in[31] + (size_t)L * 2048 * FF2, 2048, FF2, FF2, Wup, norm_pre + (L * 3 + 2) * DM, true, ga, 1024);
                conv_w(c, args.in[34] + (size_t)L * FFH * 2048, FFH, 2048, 2048, Wdn, nullptr, false, ga, 1024); __syncthreads(); }
            if constexpr (L == 0) { pg8::ProbSplit S; S.init(XB, Wmi, 2048, 2048, 2048, 64, SSD_NP / 256, c.G, cid); S.nA = NA; S.nB = NBU; pg8::EpiP<StBf16> E{{PROJ, SSD_NP}, RS}; pg8::gemm_phase(c.lds, S, E); }
            else if constexpr (L == 1) { nsa_posbias_reduce(c, PBP, PB); pg8::ProbSplit S; S.init(XB, Wmi, 2048, 2048, 2048, 64, NSA_NP / 256, c.G, cid); S.nA = NA; S.nB = NBU; pg8::EpiP<StNsa> E{{NQ, NT, NG}, RS}; pg8::gemm_phase(c.lds, S, E); }
            else if constexpr (L == 2) { pg8::ProbSplit S; S.init(XB, Wmi, 2048, 2048, 2048, 64, 32, c.G, cid); S.nA = NA; S.nB = NBU; pg8::EpiP<StBf16BiasGelu> E{{PROJ, 8192, args.in[19]}, RS}; pg8::gemm_phase(c.lds, S, E); }
            else { pg8::ProbSplit S; S.init(XB, Wmi, 2048, 2048, 2048, 64, 8, c.G, cid); S.nA = NA; S.nB = NBU; pg8::EpiN<StF32> E{{MF, 2048}, RS}; pg8::gemm_phase(c.lds, S, E); }
        }
        SEAM(P0 + 1);
        if (IN(P0 + 2)) {
            if constexpr (L == 0) { ssd_conv(c, PROJ, args.in[6], args.in[7], args.in[8], ACT, DT);
#if PROBE == 11
                ssd_conv(c, PROJ, args.in[6], args.in[7], args.in[8], ACT, DT);
#endif
            }
            else if constexpr (L == 1) { pg8::ProbC S; S.init(NT, Wmx, 2048, 4096, 512, 32, 8, c.G, cid); S.a_tile_stride = (size_t)4096 * 128;
                pg8::EpiN<StF32> E{{(float*)(ws + WS_ACT), 2048}, nullptr}; pg8::gemm_phase(c.lds, S, E); nsa_vt(c, NT, NVT);
#if PROBE == 11
                nsa_vt(c, NT, NVT);
#endif
            }
            else if constexpr (L == 2) sgu_ln(c, PROJ, args.in[20]);
            else { pool_pool(c, MF, POOLED);
#if PROBE == 11
                pool_pool(c, MF, POOLED);
#endif
            }
        }
        SEAM(P0 + 2);
        if (IN(P0 + 3)) {
            if constexpr (L == 0) {
#if PROBE == 10
                ssd_scan_mfma(c, ACT, DT, args.in[9], args.in[10], lo < 0);
#endif
                ssd_scan_mfma(c, ACT, DT, args.in[9], args.in[10], true); }
            else if constexpr (L == 1) { nsa_hidreduce(c, (const float*)(ws + WS_ACT), PB, NHID); if (IN(P0 + 3) && IN(P0 + 4)) xcd_barrier(bar); nsa_w2b(c, NHID, args.in[16], KCb, VCT);
#if PROBE == 11
                nsa_hidreduce(c, (const float*)(ws + WS_ACT), PB, NHID); if (IN(P0 + 3) && IN(P0 + 4)) xcd_barrier(bar); nsa_w2b(c, NHID, args.in[16], KCb, VCT);
#endif
            }
            else if constexpr (L == 2) sgu_spatial_mfma(c, PROJ, args.in[21], args.in[22], ACT);
            else { pg8::Prob S; S.init(POOLED, Wmx, 2048, 512, 512, 64, 8, c.G, cid); S.a_group_shift = 1; S.a_group_cols = 512; pg8::EpiP<StBf16Scale> E{{ACT, 2048, args.in[26]}, nullptr}; pg8::gemm_phase(c.lds, S, E); }
        }
        SEAM(P0 + 3);
        if (IN(P0 + 4)) {
            if constexpr (L == 0) ssd_gnorm(c, ACT, PROJ, args.in[11]);
            else if constexpr (L == 1) nsa_attn_cmp(c, NQ, KCb, VCT, NG, MF, SMg);
        }
        if constexpr (L <= 1) SEAM(P0 + 4);
        if (IN(P0 + 5)) {
            if constexpr (L == 1) { nsa_attn_sw(c, NQ, NT, NVT, NG, MF, (float*)(ws + WS_ACT + 64 * MiB), SMg, ACT);
#if PROBE == 1
                nsa_attn_sw(c, NQ, NT, NVT, NG, MF, (float*)(ws + WS_ACT + 64 * MiB), SMg, ACT);
#endif
            }
        }
        if constexpr (L == 1) SEAM(P0 + 5);
        if (IN(P0 + 6)) {
            if constexpr (L == 0) { pg8::Prob S; S.init(ACT, Wmo, 6144, 4096, 4096, 64, 8, c.G, cid); pg8::EpiP<StBf16> E{{MFb, 2048}, nullptr}; pg8::gemm_phase(c.lds, S, E); }
            else if constexpr (L == 2) { pg8::Prob S; S.init(ACT, Wmo, 4096, 4096, 4096, 64, 8, c.G, cid); pg8::EpiP<StBf16> E{{MFb, 2048}, nullptr}; pg8::gemm_phase(c.lds, S, E); }
            else { pg8::Prob S; S.init(ACT, Wmo, 2048, 2048, 2048, 64, 8, c.G, cid); pg8::EpiP<StBf16> E{{MFb, 2048}, nullptr}; pg8::gemm_phase(c.lds, S, E); }
        }
        SEAM(P0 + 6);
        if (IN(P0 + 7)) postnorm(c, MFb, XB, RS, norm_post + (L * 3 + 0) * DM, nullptr);
        SEAM(P0 + 7);
        if (IN(P0 + 8)) {
            { pg8::Prob S; S.init(XB, Wxq, 2048, 2048, 2048, 64, 2, c.G, cid); pg8::EpiP<StBf16> E{{XQ, 512}, RS}; pg8::gemm_phase(c.lds, S, E); }
            { pg8::Prob S; S.init(MEMN, Wxkv, 2048, 2048, 2048, 4, 4, c.G, (cid + c.G - 128) % c.G); pg8::EpiP<StKv> E{{KV, XVT}, nullptr}; pg8::gemm_phase(c.lds, S, E); }
            if (cid >= 144 && c.G == 256) { const int ga = (cid - 144) * 8 + c.wave; constexpr int NG_ = 112 * 8;
                if constexpr (L == 0) { conv_w(c, args.in[13], 2048, NSA_IN, NSA_NP, Wmi, norm_pre + ((L + 1) * 3) * DM, false, ga, NG_); conv_w(c, args.in[17], 2048, 2048, 2048, Wmo, nullptr, false, ga, NG_);
                    conv_w(c, args.in[15], 4096, 256, 256, Wmx, nullptr, false, ga, NG_); conv_w(c, args.in[15] + (size_t)4096 * 256, 4096, 256, 256, Wmx + (size_t)256 * 4096, nullptr, false, ga, NG_); }
                else if constexpr (L == 1) { conv_w(c, args.in[18], 2048, 8192, 8192, Wmi, norm_pre + ((L + 1) * 3) * DM, false, ga, NG_); conv_w(c, args.in[23], 4096, 2048, 2048, Wmo, nullptr, false, ga, NG_); }
                else if constexpr (L == 2) { conv_w(c, args.in[24], 2048, 2048, 2048, Wmi, norm_pre + ((L + 1) * 3) * DM, false, ga, NG_); conv_w(c, args.in[27], 2048, 2048, 2048, Wmo, nullptr, false, ga, NG_);
#pragma unroll 1
                    for (int g = 0; g < 4; ++g) conv_w(c, args.in[25] + (size_t)g * 512 * 512, 512, 512, 512, Wmx + (size_t)g * 512 * 512, nullptr, false, ga, NG_); }
            }
        }
        SEAM(P0 + 8);
        if (IN(P0 + 9)) xa_attn_fa(c, XQ, KV, XVT, XO);
        SEAM(P0 + 9);
        if (IN(P0 + 10)) { pg8::Prob S; S.init(XO, Wxo, 512, 512, 512, 64, 8, c.G, cid); pg8::EpiP<StBf16> E{{MFb, 2048}, nullptr}; pg8::gemm_phase(c.lds, S, E); }
        SEAM(P0 + 10);
        if (IN(P0 + 11)) postnorm(c, MFb, XB, RS, norm_post + (L * 3 + 1) * DM, nullptr);
        SEAM(P0 + 11);
        if (IN(P0 + 12)) { pg8::ProbR S; S.init(XB, Wup, 2048, 2048, 2048, 64, 44, c.G, cid); EpiFfn E{ACT, (bf16*)(ws + WS_SXT), RS, args.in[32] + (size_t)L * 3 * FF2, args.in[33] + (size_t)L * FF2}; pg8::gemm_phase(c.lds, S, E); }
        SEAM(P0 + 12);
        if (IN(P0 + 13)) ffn_fixup(c, (const bf16*)(ws + WS_SXT), args.in[32] + (size_t)L * 3 * FF2, args.in[33] + (size_t)L * FF2, ACT);
        SEAM(P0 + 13);
        if (IN(P0 + 14)) { pg8::Prob S; S.init(ACT, Wdn, FFH, FFH, FFH, 64, 8, c.G, cid); pg8::EpiP<StBf16> E{{MFb, 2048}, nullptr}; pg8::gemm_phase(c.lds, S, E); }
        SEAM(P0 + 14);
        if (IN(P0 + 15)) postnorm(c, MFb, XB, RS, norm_post + (L * 3 + 2) * DM, (L == 3) ? X : nullptr);
    }
#undef IN
#undef SEAM

__global__ void __launch_bounds__(512, 2) mega_fwd(Args args) {
    extern __shared__ __attribute__((aligned(16))) unsigned char lds_raw[];
    Ctx c; c.lds = (LAS unsigned char*)lds_raw; c.tid = threadIdx.x; c.lane = c.tid & 63; c.wave = __builtin_amdgcn_readfirstlane(c.tid >> 6);
    c.G = gridDim.x; { const int bx = blockIdx.x; c.vcu = (c.G % 8 == 0) ? (bx % 8) * (c.G / 8) + bx / 8 : bx; }
    c.gw = c.vcu * 8 + c.wave; c.NGW = c.G * 8;
    volatile LAS unsigned* MISC = (volatile LAS unsigned*)(c.lds + MISC_OFF);
    if (c.tid < 64) MISC[c.tid] = 0u;
    __syncthreads();
    unsigned char* ws = args.ws;
    unsigned* ctl = (unsigned*)(ws + WS_CTL);
    XcdBarrier bar; bar.bar = ctl + CW_BAR; bar.x = 0; bar.st = nullptr;
#if !MK_MULTI
    bar = xcd_barrier_post(ctl + CW_BAR, MISC + 8);
#endif
    const int lo = args.ph_lo, hi = args.ph_hi;
    layer_body<0>(c, args, bar, lo, hi);
    layer_body<1>(c, args, bar, lo, hi);
    layer_body<2>(c, args, bar, lo, hi);
    layer_body<3>(c, args, bar, lo, hi);
}

extern "C" void kernel_launch(void* const* d_in, const int* in_sizes, int n_in, void* d_out, int out_size, void* d_ws, size_t ws_size, hipStream_t stream) {
    static int grid = 0;
    if (grid == 0) {
        if (n_in != 35 || out_size != MT * DM || ws_size < WS_END) { fprintf(stderr, "kernel_launch: unexpected shapes: n_in %d out %d ws %zu (need %zu)\n", n_in, out_size, ws_size, (size_t)WS_END); grid = -1; return; }
        int dev = 0, cus = 0, per_cu = 0;
        if (hipGetDevice(&dev) != hipSuccess || hipDeviceGetAttribute(&cus, hipDeviceAttributeMultiprocessorCount, dev) != hipSuccess) { grid = -1; return; }
        if (hipFuncSetAttribute((const void*)mega_fwd, hipFuncAttributeMaxDynamicSharedMemorySize, LDS_BYTES) != hipSuccess) { fprintf(stderr, "kernel_launch: hipFuncSetAttribute failed\n"); grid = -1; return; }
        if (hipOccupancyMaxActiveBlocksPerMultiprocessor(&per_cu, (const void*)mega_fwd, 512, LDS_BYTES) != hipSuccess || per_cu < 1) { fprintf(stderr, "kernel_launch: occupancy query says %d\n", per_cu); grid = -1; return; }
        (void)hipGetLastError();
        if (cus < 256) { fprintf(stderr, "kernel_launch: needs >= 256 CUs (got %d)\n", cus); grid = -1; return; }
        grid = 256;
    }
    if (grid < 0) return;
    (void)hipMemsetAsync((char*)d_ws + WS_CTL, 0, CTL_ZERO_BYTES, stream);
    Args a{};
    for (int i = 0; i < 35; ++i) a.in[i] = (const float*)d_in[i];
    a.out = (float*)d_out; a.ws = (unsigned char*)d_ws;
#if MK_MULTI
    for (int p = 0; p < N_PHASES; ++p) { a.ph_lo = p; a.ph_hi = p + 1; hipLaunchKernelGGL(mega_fwd, dim3(grid), dim3(512), LDS_BYTES, stream, a); }
#else
    a.ph_lo = 0; a.ph_hi = N_PHASES;
    hipLaunchKernelGGL(mega_fwd, dim3(grid), dim3(512), LDS_BYTES, stream, a);
#endif
}
```

```cpp
#include <hip/hip_runtime.h>
#include <cstdio>
#include <cstdint>

#ifndef MK_MULTI
#define MK_MULTI 0
#endif
#ifndef PROBE
#define PROBE 0
#endif

#define GAS __attribute__((address_space(1)))
#define LAS __attribute__((address_space(3)))
typedef unsigned short bf16;
typedef unsigned v4u __attribute__((ext_vector_type(4)));
typedef unsigned v2u __attribute__((ext_vector_type(2)));
typedef float f32x4 __attribute__((ext_vector_type(4)));
typedef float f32x2 __attribute__((ext_vector_type(2)));
typedef short bf16x8 __attribute__((ext_vector_type(8)));
typedef short s16x4 __attribute__((ext_vector_type(4)));
#define LDS_WAIT() asm volatile("s_waitcnt lgkmcnt(0)" ::: "memory")

constexpr int DM = 2048, NB = 4, SEQ = 4096, MT = NB * SEQ;
constexpr int SSD_NP = 10496, SSD_IN = 10304;
constexpr int NSA_NP = 5376, NSA_IN = 5168;
constexpr int FFH = 5632, FF2 = 11264;
constexpr float EPS = 1e-6f;

constexpr size_t MiB = 1u << 20;
constexpr size_t WS_CTL = 0, CTL_ZERO_BYTES = 64 * 1024;
constexpr size_t WS_W = 1 * MiB;
constexpr size_t W_MIX_IN = WS_W + 0, W_MIX_OUT = WS_W + 44 * MiB, W_MIX_X = WS_W + 62 * MiB;
constexpr size_t W_XQ = WS_W + 68 * MiB, W_XKV = WS_W + 71 * MiB, W_XO = WS_W + 76 * MiB, W_UP = WS_W + 79 * MiB, W_DOWN = WS_W + 123 * MiB;
constexpr size_t WS_H = 148 * MiB;
constexpr size_t WS_PROJ = 212 * MiB;
constexpr size_t WS_ACT = 564 * MiB;
constexpr size_t WS_Q = 756 * MiB, WS_O = 772 * MiB, WS_KV = 788 * MiB, WS_MEMN = 790 * MiB, WS_DT = 794 * MiB, WS_PB = 798 * MiB;
constexpr size_t WS_SXT = 800 * MiB;
constexpr size_t WS_SBT = 928 * MiB;
constexpr size_t WS_END = 960 * MiB;
constexpr size_t WS_NQ = WS_PROJ + 128 * MiB;
constexpr size_t WS_NT = WS_NQ + 64 * MiB;
constexpr size_t NT_STRIDE = (size_t)16 * 4096 * 128;
constexpr size_t WS_NHID = WS_NT + 97 * MiB;
constexpr size_t WS_NKC = WS_NHID + 4 * MiB;
constexpr size_t WS_NG = WS_NKC + 4 * MiB;
constexpr size_t WS_NVT = WS_NG + 3 * MiB;
static_assert(WS_NVT + 32 * MiB <= WS_ACT, "nsa map");
constexpr size_t WS_XVT = 799 * MiB;
constexpr int CW_BAR = 4096;

constexpr int LDS_BYTES = 159744;
constexpr int MISC_OFF = LDS_BYTES - 256;

__device__ __forceinline__ unsigned f2bf(float f) { unsigned u = __builtin_bit_cast(unsigned, f); return (u + 0x7fffu + ((u >> 16) & 1u)) >> 16; }
__device__ __forceinline__ unsigned pk2(float lo, float hi) { return f2bf(lo) | (f2bf(hi) << 16); }
__device__ __forceinline__ float bflo(unsigned u) { return __builtin_bit_cast(float, u << 16); }
__device__ __forceinline__ float bfhi(unsigned u) { return __builtin_bit_cast(float, u & 0xffff0000u); }
__device__ __forceinline__ float wave_sum(float v) {
#pragma unroll
    for (int o = 1; o < 64; o <<= 1) v += __shfl_xor(v, o);
    return v;
}
__device__ __forceinline__ float wave_max(float v) {
#pragma unroll
    for (int o = 1; o < 64; o <<= 1) v = fmaxf(v, __shfl_xor(v, o));
    return v;
}
__device__ __forceinline__ float sigmoidf_(float x) { return 1.f / (1.f + __expf(-x)); }
__device__ __forceinline__ float silu_fast(float x) { return x * __builtin_amdgcn_rcpf(1.f + __builtin_amdgcn_exp2f(-1.4426950408889634f * x)); }
__device__ __forceinline__ float siluf_(float x) { return x * sigmoidf_(x); }
__device__ __forceinline__ float gelu_tanh(float x) { return x * __builtin_amdgcn_rcpf(1.f + __builtin_amdgcn_exp2f(x * __builtin_fmaf(-1.029432396e-01f, x * x, -2.302208198e+00f))); }

#define XB_TMO      128
#define XB_XCNT(j)  (256  + 64 * (j))
#define XB_XSUB(j)  (1280 + 64 * (j))
#define XB_XGEN(j)  (2304 + 64 * (j))
#define XB_TOP      3328
#define XB_TOPGEN   3392
#define XCD_BAR_WORDS 3456
#define XB_SPIN_CAP (1u << 22)

__device__ __forceinline__ unsigned xb_ld(unsigned* p)              { return __hip_atomic_load(p, __ATOMIC_RELAXED, __HIP_MEMORY_SCOPE_AGENT); }
__device__ __forceinline__ unsigned xb_add(unsigned* p, unsigned v) { return __hip_atomic_fetch_add(p, v, __ATOMIC_RELAXED, __HIP_MEMORY_SCOPE_AGENT); }
__device__ __forceinline__ unsigned xb_xcc_id() { return (unsigned)__builtin_amdgcn_s_getreg((3 << 11) | 20) & 0xFu; }
#define XB_SPIN(cond, bar) do { unsigned _sp = 0; while (cond) { __builtin_amdgcn_s_sleep(1); \
    if ((++_sp & 255u) == 0u) { if (xb_ld(&(bar)[XB_TMO])) break; if (_sp > XB_SPIN_CAP) { atomicAdd(&(bar)[XB_TMO], 1u); break; } } } } while (0)

struct XcdBarrier { unsigned* bar; unsigned x; volatile LAS unsigned* st; };

__device__ __forceinline__ XcdBarrier xcd_barrier_post(unsigned* bar, volatile LAS unsigned* st) {
    XcdBarrier b; b.bar = bar; b.x = xb_xcc_id(); b.st = st;
    if (threadIdx.x == 0) (void)xb_add(&bar[XB_XCNT(b.x)], 1u);
    return b;
}
__device__ __forceinline__ void xcd_barrier_complete(unsigned* bar, unsigned x, unsigned& nloc, unsigned& nx) {
    const unsigned G = gridDim.x * gridDim.y * gridDim.z;
    unsigned sum, cnt, mine, sp = 0u;
    for (;;) {
        sum = 0u; cnt = 0u; mine = 0u;
#pragma unroll
        for (unsigned j = 0; j < 16; ++j) { const unsigned c = xb_ld(&bar[XB_XCNT(j)]); sum += c; cnt += (c > 0u) ? 1u : 0u; mine = (j == x) ? c : mine; }
        if (sum == G) break;
        __builtin_amdgcn_s_sleep(1);
        if ((++sp & 255u) == 0u) { if (xb_ld(&bar[XB_TMO])) break; if (sp > XB_SPIN_CAP) { atomicAdd(&bar[XB_TMO], 1u); break; } }
    }
    nloc = mine > 0u ? mine : 1u; nx = cnt > 0u ? cnt : 1u;
}
__device__ __forceinline__ void xcd_barrier(const XcdBarrier& b) {
    asm volatile("s_waitcnt vmcnt(0)" ::: "memory");
    __syncthreads();
    if (threadIdx.x == 0) {
        unsigned* bar = b.bar;
        __builtin_amdgcn_s_waitcnt(0);
        unsigned nloc = b.st[0], nx = b.st[1];
        if (nloc == 0u) { xcd_barrier_complete(bar, b.x, nloc, nx); b.st[0] = nloc; b.st[1] = nx; }
        const unsigned old = xb_add(&bar[XB_XSUB(b.x)], 1u);
        const unsigned gen = old / nloc;
        if (old + 1u == (gen + 1u) * nloc) {
            __builtin_amdgcn_fence(__ATOMIC_RELEASE, "agent");
            asm volatile("s_waitcnt vmcnt(0)" ::: "memory");
            const unsigned og = xb_add(&bar[XB_TOP], 1u);
            const unsigned tg = og / nx;
            if (og + 1u == (tg + 1u) * nx) xb_add(&bar[XB_TOPGEN], 1u);
            else XB_SPIN(xb_ld(&bar[XB_TOPGEN]) == tg, bar);
            __builtin_amdgcn_fence(__ATOMIC_ACQUIRE, "agent");
            xb_add(&bar[XB_XGEN(b.x)], 1u);
            asm volatile("s_waitcnt vmcnt(0)" ::: "memory");
        } else {
            XB_SPIN(xb_ld(&bar[XB_XGEN(b.x)]) == gen, bar);
            __builtin_amdgcn_fence(__ATOMIC_ACQUIRE, "agent");
            asm volatile("s_waitcnt vmcnt(0)" ::: "memory");
        }
    }
    __syncthreads();
}

namespace pg8 {
constexpr int BM = 256, BK = 64, HALF = 128, HTB = HALF * BK * 2, STAGE_BYTES = 8 * HTB, NXCD = 8, WGM = 8;
__device__ __forceinline__ int lds_byte(int r, int c) { const int st = (r >> 4) * 2 + (c >> 5), rr = r & 15, cc = c & 31, ob = rr * 64 + cc * 2; return st * 1024 + (ob ^ (((ob >> 9) & 1) << 5)); }
__device__ __forceinline__ void stage_rc(int b, int& R, int& C) { const int st = b / 1024, sb = b % 1024, swz = sb ^ (((sb >> 9) & 1) << 5); R = (st >> 1) * 16 + swz / 64; C = (st & 1) * 32 + (swz % 64) / 2; }
__device__ __forceinline__ int perm32(int rho) { const int n = rho >> 4, i = rho & 15; return 8 * (i >> 2) + 4 * n + (i & 3); }
struct Unit { int pm, pn; };
struct Prob {
    static constexpr bool ROWPERM = false;
    const bf16* A; const bf16* Bt; int lda, ldb, K, nM, nN, G, c; int a_group_shift, a_group_cols;
    size_t a_tile_stride, b_tile_stride;
    __device__ __forceinline__ void init(const bf16* A_, const bf16* Bt_, int lda_, int ldb_, int K_, int nM_, int nN_, int G_, int c_) {
        A = A_; Bt = Bt_; lda = lda_; ldb = ldb_; K = K_; nM = nM_; nN = nN_; G = G_; c = c_; a_group_shift = 0; a_group_cols = 0; a_tile_stride = (size_t)256 * lda_; b_tile_stride = (size_t)256 * ldb_; }
    __device__ __forceinline__ bool next(int i, Unit& u) const {
        const int nwg = nM * nN; const long L = (long)i * G + c; if (L >= nwg) return false;
        int wgid = (int)L; { const int q = nwg / NXCD, r = nwg % NXCD, xcd = wgid % NXCD, off = wgid / NXCD; wgid = (xcd < r ? xcd * (q + 1) : r * (q + 1) + (xcd - r) * q) + off; }
        const int nig = WGM * nN, gid = wgid / nig, fm = gid * WGM, gsz = (nM - fm) < WGM ? (nM - fm) : WGM;
        u.pm = fm + ((wgid % nig) % gsz); u.pn = (wgid % nig) / gsz; return true;
    }
    __device__ __forceinline__ const char* pa(const Unit& u) const { return (const char*)(A + (size_t)u.pm * a_tile_stride + (size_t)((u.pn >> a_group_shift) * a_group_cols)); }
    __device__ __forceinline__ const char* pb(const Unit& u) const { return (const char*)(Bt + (size_t)u.pn * b_tile_stride); }
};
struct ProbR : Prob { static constexpr bool ROWPERM = true; };
struct ProbSplit : Prob { int nA, nB;
    __device__ __forceinline__ bool next(int i, Unit& u) const {
        const int nwg = nM * nN, a = (c & 7) | ((c >> 4) << 3), grp = (c >> 3) & 1;
        if (i >= (grp ? nB : nA)) return false;
        const int L = (grp ? 128 * nA : 0) + i * 128 + a; if (L >= nwg) return false;
        int wgid = L; { const int q = nwg / NXCD, r = nwg % NXCD, xcd = wgid % NXCD, off = wgid / NXCD; wgid = (xcd < r ? xcd * (q + 1) : r * (q + 1) + (xcd - r) * q) + off; }
        const int nig = WGM * nN, gid = wgid / nig, fm = gid * WGM, gsz = (nM - fm) < WGM ? (nM - fm) : WGM;
        u.pm = fm + ((wgid % nig) % gsz); u.pn = (wgid % nig) / gsz; return true;
    } };
struct ProbC : Prob {
    __device__ __forceinline__ const char* pa(const Unit& u) const { return (const char*)(A + (size_t)u.pm * a_tile_stride + (size_t)u.pn * 512); }
    __device__ __forceinline__ const char* pb(const Unit& u) const { return (const char*)(Bt + (size_t)(u.pm >> 4) * 256 * 4096 + (size_t)u.pn * 512); } };
__device__ __forceinline__ unsigned cvt_pk_bf16(float lo, float hi) { unsigned r; asm volatile("v_cvt_pk_bf16_f32 %0, %1, %2" : "=v"(r) : "v"(lo), "v"(hi)); return r; }

template <class F> struct EpiP {
    static constexpr bool PERM = true; F f; const float* rowscale;
    __device__ __forceinline__ void operator()(const f32x4 (&acc)[2][2][4][2], const Unit& u, int wr, int wc, int fr, int fq) const {
        const int row0 = u.pm * BM + wr * 64 + fr, col0 = u.pn * BM + wc * 32 + 8 * fq;
#pragma unroll
        for (int ai = 0; ai < 2; ++ai)
#pragma unroll
            for (int m = 0; m < 4; ++m) { const int row = row0 + ai * HALF + m * 16; const float rs = rowscale ? rowscale[row] : 1.f;
#pragma unroll
                for (int bj = 0; bj < 2; ++bj) f(row, col0 + bj * HALF, acc[ai][bj][m][0] * rs, acc[ai][bj][m][1] * rs); }
    }
};
template <class F> struct EpiN {
    static constexpr bool PERM = false; F f; const float* rowscale;
    __device__ __forceinline__ void operator()(const f32x4 (&acc)[2][2][4][2], const Unit& u, int wr, int wc, int fr, int fq) const {
        const int row0 = u.pm * BM + wr * 64 + fr, col0 = u.pn * BM + wc * 32 + 4 * fq;
#pragma unroll
        for (int ai = 0; ai < 2; ++ai)
#pragma unroll
            for (int m = 0; m < 4; ++m) { const int row = row0 + ai * HALF + m * 16; const float rs = rowscale ? rowscale[row] : 1.f;
#pragma unroll
                for (int bj = 0; bj < 2; ++bj)
#pragma unroll
                    for (int n = 0; n < 2; ++n) f(row, col0 + bj * HALF + n * 16, acc[ai][bj][m][n] * rs); }
    }
};

#ifndef GEMM_REP
#define GEMM_REP 1
#endif
template <class PT, class Epi> __device__ __forceinline__ void gemm_phase_once(LAS unsigned char* lds, const PT& S, const Epi& E, bool epi_on);
template <class PT, class Epi>
__device__ __forceinline__ void gemm_phase(LAS unsigned char* lds, const PT& S, const Epi& E) {
    gemm_phase_once(lds, S, E, true);
}
template <class PT, class Epi>
__device__ __forceinline__ void gemm_phase_once(LAS unsigned char* lds, const PT& S, const Epi& E, bool epi_on) {
    const int tid = threadIdx.x, wid = __builtin_amdgcn_readfirstlane(tid >> 6), lane = tid & 63, wr = wid >> 2, wc = wid & 3, fr = lane & 15, fq = lane >> 4;
    const int K = S.K, nt = K / BK, lda = S.lda, ldb = S.ldb;
    unsigned voffA[2], voffB[2];
#pragma unroll
    for (int i = 0; i < 2; ++i) { int R, C; stage_rc(tid * 16 + i * 8192, R, C); const int Rb = Epi::PERM ? ((R & ~31) + perm32(R & 31)) : R;
        const int Ra = PT::ROWPERM ? (128 * (R >> 6) + 8 * (R & 15) + ((R >> 4) & 3)) : R;
        voffA[i] = (unsigned)(Ra * lda + C) * 2u; voffB[i] = (unsigned)(Rb * ldb + C) * 2u; }
    const size_t kstep = (size_t)(BK * 2);
    const size_t hstepA = (size_t)(PT::ROWPERM ? 4 : HALF) * lda * 2, hstepB = (size_t)HALF * ldb * 2;
    const unsigned ldsw = (unsigned)wid * 1024u;
    const int aoff = lds_byte(wr * 64 + fr, fq * 8), boff = lds_byte(wc * 32 + fr, fq * 8);
#define PG8_SA(b, h) (((b) * 2 + (h)) * HTB)
#define PG8_SB(b, h) ((4 + (b) * 2 + (h)) * HTB)
#define PG8_STAGE(bufoff, gbase, voff) do { _Pragma("unroll") for (int _i = 0; _i < 2; ++_i) \
        __builtin_amdgcn_global_load_lds((const unsigned*)((const char*)(gbase) + (voff)[_i]), (LAS unsigned*)(lds + (bufoff) + ldsw + _i * 8192), 16, 0, 0); } while (0)
#define PG8_LDA(dst, b, h) do { _Pragma("unroll") for (int m = 0; m < 4; ++m) _Pragma("unroll") for (int k = 0; k < 2; ++k) dst[m][k] = *(const LAS bf16x8*)(lds + PG8_SA(b, h) + aoff + m * 2048 + k * 1024); } while (0)
#define PG8_LDB(dst, b, h) do { _Pragma("unroll") for (int n = 0; n < 2; ++n) _Pragma("unroll") for (int k = 0; k < 2; ++k) dst[n][k] = *(const LAS bf16x8*)(lds + PG8_SB(b, h) + boff + n * 2048 + k * 1024); } while (0)
#define PG8_MMA(ai, bj, At, Bt) do { __builtin_amdgcn_s_setprio(1); _Pragma("unroll") for (int m = 0; m < 4; ++m) _Pragma("unroll") for (int n = 0; n < 2; ++n) _Pragma("unroll") for (int k = 0; k < 2; ++k) \
        acc[ai][bj][m][n] = __builtin_amdgcn_mfma_f32_16x16x32_bf16(Bt[n][k], At[m][k], acc[ai][bj][m][n], 0, 0, 0); __builtin_amdgcn_s_setprio(0); } while (0)
#define PG8_WAIT_V(n) asm volatile("s_waitcnt vmcnt(" #n ")" ::: "memory")
#define PG8_WAIT_L(n) asm volatile("s_waitcnt lgkmcnt(" #n ")" ::: "memory")
#define PG8_BAR __builtin_amdgcn_s_barrier()
#define PG8_SCHED __builtin_amdgcn_sched_barrier(0)
    Unit cur, nxt; int ui = 0;
    if (!S.next(0, cur)) return;
    f32x4 acc[2][2][4][2];
#pragma unroll
    for (int a = 0; a < 2; ++a)
#pragma unroll
        for (int b = 0; b < 2; ++b)
#pragma unroll
            for (int m = 0; m < 4; ++m)
#pragma unroll
                for (int n = 0; n < 2; ++n) acc[a][b][m][n] = (f32x4){0.f, 0.f, 0.f, 0.f};
    bf16x8 At[4][2], B0[2][2], B1[2][2];
    const char* cA = S.pa(cur); const char* cB = S.pb(cur);
    PG8_STAGE(PG8_SB(0, 0), cB, voffB); PG8_STAGE(PG8_SA(0, 0), cA, voffA); PG8_STAGE(PG8_SB(0, 1), cB + hstepB, voffB); PG8_STAGE(PG8_SA(0, 1), cA + hstepA, voffA);
    if (wr == 1) PG8_BAR;
    PG8_WAIT_V(4); PG8_BAR;
    PG8_STAGE(PG8_SB(1, 0), cB + kstep, voffB); PG8_STAGE(PG8_SA(1, 0), cA + kstep, voffA); PG8_STAGE(PG8_SB(1, 1), cB + hstepB + kstep, voffB);
    PG8_WAIT_V(6); PG8_BAR;
    for (;;) {
        const bool has_next = S.next(ui + 1, nxt);
        const char* nA = has_next ? S.pa(nxt) : cA; const char* nB = has_next ? S.pb(nxt) : cB;
        for (int t = 0; t < nt; t += 2) {
            const bool last = (t == nt - 2);
            const char* a1 = cA + (size_t)(t + 1) * kstep;
            const char* a2 = last ? nA : cA + (size_t)(t + 2) * kstep; const char* b2 = last ? nB : cB + (size_t)(t + 2) * kstep;
            const char* a3 = a2 + kstep; const char* b3 = b2 + kstep;
            PG8_LDB(B0, 0, 0); PG8_SCHED; PG8_LDA(At, 0, 0); PG8_STAGE(PG8_SA(1, 1), a1 + hstepA, voffA);
            PG8_WAIT_L(8); PG8_BAR; PG8_WAIT_L(0); PG8_MMA(0, 0, At, B0); PG8_BAR; PG8_SCHED;
            PG8_LDB(B1, 0, 1); PG8_STAGE(PG8_SB(0, 0), b2, voffB);
            PG8_BAR; PG8_WAIT_L(0); PG8_MMA(0, 1, At, B1); PG8_BAR;
            PG8_LDA(At, 0, 1); PG8_STAGE(PG8_SA(0, 0), a2, voffA);
            PG8_BAR; PG8_WAIT_L(0); PG8_MMA(1, 0, At, B0); PG8_BAR; PG8_SCHED;
            PG8_STAGE(PG8_SB(0, 1), b2 + hstepB, voffB);
            PG8_WAIT_V(6); PG8_BAR; PG8_MMA(1, 1, At, B1); PG8_BAR;
            PG8_LDB(B0, 1, 0); PG8_SCHED; PG8_LDA(At, 1, 0); PG8_STAGE(PG8_SA(0, 1), a2 + hstepA, voffA);
            PG8_WAIT_L(8); PG8_BAR; PG8_WAIT_L(0); PG8_MMA(0, 0, At, B0); PG8_BAR; PG8_SCHED;
            PG8_LDB(B1, 1, 1); PG8_STAGE(PG8_SB(1, 0), b3, voffB);
            PG8_BAR; PG8_WAIT_L(0); PG8_MMA(0, 1, At, B1); PG8_BAR;
            PG8_LDA(At, 1, 1); PG8_STAGE(PG8_SA(1, 0), a3, voffA);
            PG8_BAR; PG8_WAIT_L(0); PG8_MMA(1, 0, At, B0); PG8_BAR; PG8_SCHED;
            PG8_STAGE(PG8_SB(1, 1), b3 + hstepB, voffB);
            PG8_WAIT_V(6); PG8_BAR; PG8_MMA(1, 1, At, B1); PG8_BAR;
        }
        if (epi_on) E(acc, cur, wr, wc, fr, fq);
        if (!has_next) break;
#pragma unroll
        for (int a = 0; a < 2; ++a)
#pragma unroll
            for (int b = 0; b < 2; ++b)
#pragma unroll
                for (int m = 0; m < 4; ++m)
#pragma unroll
                    for (int n = 0; n < 2; ++n) acc[a][b][m][n] = (f32x4){0.f, 0.f, 0.f, 0.f};
        cur = nxt; cA = nA; cB = nB; ++ui;
    }
    PG8_WAIT_V(0);
    if (wr == 0) PG8_BAR;
    PG8_BAR;
#undef PG8_SA
#undef PG8_SB
#undef PG8_STAGE
#undef PG8_LDA
#undef PG8_LDB
#undef PG8_MMA
#undef PG8_WAIT_V
#undef PG8_WAIT_L
#undef PG8_BAR
#undef PG8_SCHED
}
}

typedef const f32x4 __attribute__((address_space(4)))* CF4;
struct StBf16 { bf16* O; int ldc;
    __device__ __forceinline__ void operator()(int row, int col, f32x4 v0, f32x4 v1) const {
        v4u w; w.x = pg8::cvt_pk_bf16(v0[0], v0[1]); w.y = pg8::cvt_pk_bf16(v0[2], v0[3]); w.z = pg8::cvt_pk_bf16(v1[0], v1[1]); w.w = pg8::cvt_pk_bf16(v1[2], v1[3]);
        *(v4u*)(O + (size_t)row * ldc + col) = w; } };
struct StBf16BiasGelu { bf16* O; int ldc; const float* bias;
    __device__ __forceinline__ void operator()(int row, int col, f32x4 v0, f32x4 v1) const {
        const f32x4 b0 = *(CF4)(bias + col), b1 = *(CF4)(bias + col + 4);
#pragma unroll
        for (int j = 0; j < 4; ++j) { v0[j] = gelu_tanh(v0[j] + b0[j]); v1[j] = gelu_tanh(v1[j] + b1[j]); }
        v4u w; w.x = pg8::cvt_pk_bf16(v0[0], v0[1]); w.y = pg8::cvt_pk_bf16(v0[2], v0[3]); w.z = pg8::cvt_pk_bf16(v1[0], v1[1]); w.w = pg8::cvt_pk_bf16(v1[2], v1[3]);
        *(v4u*)(O + (size_t)row * ldc + col) = w; } };
struct StBf16Scale { bf16* O; int ldc; const float* scale;
    __device__ __forceinline__ void operator()(int row, int col, f32x4 v0, f32x4 v1) const {
        const f32x4 b0 = *(CF4)(scale + col), b1 = *(CF4)(scale + col + 4);
        v0 = v0 * b0; v1 = v1 * b1;
        v4u w; w.x = pg8::cvt_pk_bf16(v0[0], v0[1]); w.y = pg8::cvt_pk_bf16(v0[2], v0[3]); w.z = pg8::cvt_pk_bf16(v1[0], v1[1]); w.w = pg8::cvt_pk_bf16(v1[2], v1[3]);
        *(v4u*)(O + (size_t)row * ldc + col) = w; } };
struct StF32 { float* C; int ldc;
    __device__ __forceinline__ void operator()(int row, int col, f32x4 v) const { *(f32x4*)(C + (size_t)row * ldc + col) = v; } };
struct StNsa { bf16* Q; bf16* T; float* Gt;
    __device__ __forceinline__ void operator()(int row, int col, f32x4 v0, f32x4 v1) const {
        v4u w; w.x = pg8::cvt_pk_bf16(v0[0], v0[1]); w.y = pg8::cvt_pk_bf16(v0[2], v0[3]); w.z = pg8::cvt_pk_bf16(v1[0], v1[1]); w.w = pg8::cvt_pk_bf16(v1[2], v1[3]);
        if (col < 2048) { *(v4u*)(Q + (size_t)row * 2048 + col) = w; }
        else if (col < 5120) { const int c2 = col - 2048, ten = c2 >> 9, g = (c2 >> 7) & 3, d = c2 & 127, b = row >> 12, t = row & 4095;
            *(v4u*)(T + (size_t)ten * NT_STRIDE + ((size_t)((b * 4 + g) * 4096 + t)) * 128 + d) = w; }
        else if (col < 5168) { float* p = Gt + (size_t)row * 48 + (col - 5120); *(f32x4*)p = v0; *(f32x4*)(p + 4) = v1; }
    } };
struct StKv { bf16* KV; bf16* XVT;
    __device__ __forceinline__ void operator()(int row, int col, f32x4 v0, f32x4 v1) const {
        if (col < 512) { v4u w; w.x = pg8::cvt_pk_bf16(v0[0], v0[1]); w.y = pg8::cvt_pk_bf16(v0[2], v0[3]); w.z = pg8::cvt_pk_bf16(v1[0], v1[1]); w.w = pg8::cvt_pk_bf16(v1[2], v1[3]); *(v4u*)(KV + (size_t)row * 1024 + col) = w; }
        else { const int c2 = col - 512, b = row >> 8, m = row & 255; bf16* p = XVT + ((size_t)(b * 4 + (c2 >> 7)) * 128 + (c2 & 127)) * 256 + m;
#pragma unroll
            for (int j = 0; j < 4; ++j) { p[(size_t)j * 256] = (bf16)f2bf(v0[j]); p[(size_t)(4 + j) * 256] = (bf16)f2bf(v1[j]); } }
    } };
struct StHid { bf16* O; const float* pb;
    __device__ __forceinline__ void operator()(int row, int col, f32x4 v0, f32x4 v1) const {
        const int ten = row >> 12; const float* bias = pb + ten * 256 + col;
        const f32x4 b0 = *(const f32x4*)(bias), b1 = *(const f32x4*)(bias + 4);
#pragma unroll
        for (int j = 0; j < 4; ++j) { v0[j] = gelu_tanh(v0[j] + b0[j]); v1[j] = gelu_tanh(v1[j] + b1[j]); }
        v4u w; w.x = pg8::cvt_pk_bf16(v0[0], v0[1]); w.y = pg8::cvt_pk_bf16(v0[2], v0[3]); w.z = pg8::cvt_pk_bf16(v1[0], v1[1]); w.w = pg8::cvt_pk_bf16(v1[2], v1[3]);
        *(v4u*)(O + (size_t)row * 256 + col) = w; } };

struct Ctx { LAS unsigned char* lds; int tid, lane, wave, vcu, G, gw, NGW; };
__device__ __forceinline__ float dpp_shr1(float x) { return __builtin_bit_cast(float, __builtin_amdgcn_update_dpp(0, __builtin_bit_cast(int, x), 0x111, 0xf, 0xf, true)); }
struct EpiFfn {
    static constexpr bool PERM = true;
    bf16* ACT; bf16* HALO; const float* RS; const float* cw; const float* cb;
    __device__ __forceinline__ void operator()(const f32x4 (&acc)[2][2][4][2], const pg8::Unit& u, int wr, int wc, int fr, int fq) const {
        const int ch0 = 128 * u.pn + 32 * wc + 8 * fq, tok0 = 256 * u.pm + 128 * wr + 8 * fr;
        const f32x4 r0 = *(const f32x4*)(RS + tok0), r1 = *(const f32x4*)(RS + tok0 + 4);
        bf16* hb = HALO + ((size_t)((u.pm * 44 + u.pn) * 2 + wr) * 4) * 256 + 32 * wc + 8 * fq;
#pragma unroll
        for (int n = 0; n < 2; ++n) {
            float g[8][4], v[8][4];
#pragma unroll
            for (int e = 0; e < 8; ++e) { const float rs = (e < 4) ? r0[e & 3] : r1[e & 3];
#pragma unroll
                for (int jj = 0; jj < 4; ++jj) { g[e][jj] = acc[e >> 2][0][e & 3][n][jj] * rs; v[e][jj] = acc[e >> 2][1][e & 3][n][jj] * rs; } }
            if (fr == 0) {
#pragma unroll
                for (int q = 0; q < 2; ++q) { v2u a, b; a.x = pk2(g[q][0], g[q][1]); a.y = pk2(g[q][2], g[q][3]); b.x = pk2(v[q][0], v[q][1]); b.y = pk2(v[q][2], v[q][3]);
                    *(v2u*)(hb + (size_t)q * 256 + 4 * n) = a; *(v2u*)(hb + (size_t)q * 256 + 128 + 4 * n) = b; } }
            if (fr == 15) {
#pragma unroll
                for (int q = 0; q < 2; ++q) { v2u a, b; a.x = pk2(g[6 + q][0], g[6 + q][1]); a.y = pk2(g[6 + q][2], g[6 + q][3]); b.x = pk2(v[6 + q][0], v[6 + q][1]); b.y = pk2(v[6 + q][2], v[6 + q][3]);
                    *(v2u*)(hb + (size_t)(2 + q) * 256 + 4 * n) = a; *(v2u*)(hb + (size_t)(2 + q) * 256 + 128 + 4 * n) = b; } }
            const int cc = ch0 + 4 * n;
            const f32x4 wg0 = *(CF4)(cw + cc), wg1 = *(CF4)(cw + FF2 + cc), wg2 = *(CF4)(cw + 2 * FF2 + cc), wv0 = *(CF4)(cw + FFH + cc), wv1 = *(CF4)(cw + FF2 + FFH + cc), wv2 = *(CF4)(cw + 2 * FF2 + FFH + cc);
            const f32x4 bg = *(CF4)(cb + cc), bv = *(CF4)(cb + FFH + cc);
#pragma unroll
            for (int jj = 0; jj < 4; ++jj) {
                float g2 = dpp_shr1(g[6][jj]), g1 = dpp_shr1(g[7][jj]), v2 = dpp_shr1(v[6][jj]), v1 = dpp_shr1(v[7][jj]);
#pragma unroll
                for (int e = 0; e < 8; ++e) { const float g0 = g[e][jj], v0 = v[e][jj];
                    const float cg = bg[jj] + wg0[jj] * g2 + wg1[jj] * g1 + wg2[jj] * g0, cv = bv[jj] + wv0[jj] * v2 + wv1[jj] * v1 + wv2[jj] * v0;
                    g[e][jj] = silu_fast(cg) * cv; g2 = g1; g1 = g0; v2 = v1; v1 = v0; } }
#pragma unroll
            for (int e = 0; e < 8; ++e) { v2u w; w.x = pk2(g[e][0], g[e][1]); w.y = pk2(g[e][2], g[e][3]); *(v2u*)(ACT + (size_t)(tok0 + e) * FFH + cc) = w; }
        }
    }
};
__device__ __forceinline__ void ffn_fixup(const Ctx& c, const bf16* HALO, const float* cw, const float* cb, bf16* ACT) {
    for (int it = c.vcu * 512 + c.tid; it < 64 * 44 * 2 * 16; it += c.G * 512) {
        const int cg8 = it & 15, wr = (it >> 4) & 1, tile = it >> 5, pm = tile / 44, pn = tile % 44, ch0 = 128 * pn + 8 * cg8;
        const bf16* cur = HALO + ((size_t)(tile * 2 + wr) * 4) * 256 + 8 * cg8;
        const bool hasprev = wr == 1 || (pm & 15) != 0; const bf16* prv = wr == 1 ? HALO + ((size_t)(tile * 2) * 4 + 2) * 256 + 8 * cg8 : HALO + ((size_t)((tile - 44) * 2 + 1) * 4 + 2) * 256 + 8 * cg8;
        const v4u z4 = (v4u){0u, 0u, 0u, 0u};
        const v4u cg0 = *(const v4u*)cur, cv0 = *(const v4u*)(cur + 128), cg1 = *(const v4u*)(cur + 256), cv1 = *(const v4u*)(cur + 256 + 128);
        const v4u pg2 = hasprev ? *(const v4u*)prv : z4, pv2 = hasprev ? *(const v4u*)(prv + 128) : z4, pg3 = hasprev ? *(const v4u*)(prv + 256) : z4, pv3 = hasprev ? *(const v4u*)(prv + 256 + 128) : z4;
        float oa[8], ob[8];
#pragma unroll
        for (int j = 0; j < 8; ++j) { const int q = j >> 1; const bool hi = j & 1;
            const float wg0 = cw[ch0 + j], wg1 = cw[FF2 + ch0 + j], wg2 = cw[2 * FF2 + ch0 + j], wv0 = cw[FFH + ch0 + j], wv1 = cw[FF2 + FFH + ch0 + j], wv2 = cw[2 * FF2 + FFH + ch0 + j], bg = cb[ch0 + j], bv = cb[FFH + ch0 + j];
            const float gA2 = hi ? bfhi(pg2[q]) : bflo(pg2[q]), gA1 = hi ? bfhi(pg3[q]) : bflo(pg3[q]), gA0 = hi ? bfhi(cg0[q]) : bflo(cg0[q]), gB0 = hi ? bfhi(cg1[q]) : bflo(cg1[q]);
            const float vA2 = hi ? bfhi(pv2[q]) : bflo(pv2[q]), vA1 = hi ? bfhi(pv3[q]) : bflo(pv3[q]), vA0 = hi ? bfhi(cv0[q]) : bflo(cv0[q]), vB0 = hi ? bfhi(cv1[q]) : bflo(cv1[q]);
            oa[j] = siluf_(bg + wg0 * gA2 + wg1 * gA1 + wg2 * gA0) * (bv + wv0 * vA2 + wv1 * vA1 + wv2 * vA0);
            ob[j] = siluf_(bg + wg0 * gA1 + wg1 * gA0 + wg2 * gB0) * (bv + wv0 * vA1 + wv1 * vA0 + wv2 * vB0); }
        const size_t tok = (size_t)256 * pm + 128 * wr;
        v4u w; w.x = pk2(oa[0], oa[1]); w.y = pk2(oa[2], oa[3]); w.z = pk2(oa[4], oa[5]); w.w = pk2(oa[6], oa[7]); *(v4u*)(ACT + tok * FFH + ch0) = w;
        w.x = pk2(ob[0], ob[1]); w.y = pk2(ob[2], ob[3]); w.z = pk2(ob[4], ob[5]); w.w = pk2(ob[6], ob[7]); *(v4u*)(ACT + (tok + 1) * FFH + ch0) = w;
    }
}


__device__ __forceinline__ void conv_w(const Ctx& c, const float* W, int K, int N, int Npad, bf16* WT, const float* gain = nullptr, bool ffnmap = false, int gw_ = -1, int ngw_ = 0) {
    LAS float* scr = (LAS float*)(c.lds + c.wave * 16640);
    const int nblk = Npad / 64, items = (K / 64) * nblk, lane = c.lane;
#if PROBE == 5
#pragma unroll 1
    for (int rep_ = 0; rep_ < 2; ++rep_)
#endif
    const int gw0 = gw_ >= 0 ? gw_ : c.gw, ngw = gw_ >= 0 ? ngw_ : c.NGW;
    for (int it = gw0; it < items; it += ngw) {
        const int kb = it / nblk, nb = it % nblk, k0 = 64 * kb, n0 = 64 * nb, nq = (lane & 15) * 4, kr = lane >> 4; const bool ok = (n0 + nq) < N;
        f32x4 v[16];
#pragma unroll
        for (int i = 0; i < 16; ++i) v[i] = ok ? __builtin_nontemporal_load((const f32x4*)(W + (size_t)(k0 + 4 * i + kr) * N + n0 + nq)) : (f32x4){0.f, 0.f, 0.f, 0.f};
        if (gain) {
#pragma unroll
            for (int i = 0; i < 16; ++i) v[i] *= gain[k0 + 4 * i + kr]; }
#pragma unroll
        for (int i = 0; i < 16; ++i) { LAS float* d = scr + (4 * i + kr) * 65 + nq; d[0] = v[i].x; d[1] = v[i].y; d[2] = v[i].z; d[3] = v[i].w; }
        LDS_WAIT(); asm volatile("" ::: "memory");
        const int c8 = lane & 7; int d0 = n0;
        if (ffnmap) { const int bj = n0 >= FFH ? 1 : 0, chn = n0 - FFH * bj; d0 = 256 * (chn >> 7) + 128 * bj + (chn & 127); }
#pragma unroll
        for (int j = 0; j < 8; ++j) { const int n = (lane >> 3) + 8 * j; const LAS float* sp = scr + (8 * c8) * 65 + n;
            v4u o; o.x = pk2(sp[0 * 65], sp[1 * 65]); o.y = pk2(sp[2 * 65], sp[3 * 65]); o.z = pk2(sp[4 * 65], sp[5 * 65]); o.w = pk2(sp[6 * 65], sp[7 * 65]);
            *(v4u*)(WT + (size_t)(d0 + n) * K + k0 + 8 * c8) = o; }
        LDS_WAIT(); asm volatile("" ::: "memory");
    }
}

__device__ __forceinline__ void rms_row_bf16(const Ctx& c, const float* xrow, const float* gain, bf16* orow, float* copy) {
    const f32x4* xr = (const f32x4*)xrow + c.lane; f32x4 v[8]; float s = 0.f;
#pragma unroll
    for (int j = 0; j < 8; ++j) { v[j] = xr[64 * j]; s += (v[j].x * v[j].x + v[j].y * v[j].y) + (v[j].z * v[j].z + v[j].w * v[j].w); }
    const float rs = rsqrtf(wave_sum(s) * (1.f / DM) + EPS);
    if (copy) {
#pragma unroll
        for (int j = 0; j < 8; ++j) ((f32x4*)copy + c.lane)[64 * j] = v[j]; }
    const f32x4* gr = (const f32x4*)gain + c.lane; v2u* o8 = (v2u*)orow + c.lane;
#pragma unroll
    for (int j = 0; j < 8; ++j) { const f32x4 g = gr[64 * j]; v2u o; o.x = pk2(v[j].x * rs * g.x, v[j].y * rs * g.y); o.y = pk2(v[j].z * rs * g.z, v[j].w * rs * g.w); o8[64 * j] = o; }
}
__device__ __forceinline__ void postnorm(const Ctx& c, const bf16* MF, bf16* XB, float* RS, const float* gpost, float* OUT) {
    for (int row = c.gw; row < MT; row += c.NGW) {
        const v4u* mr = (const v4u*)(MF + (size_t)row * DM) + c.lane; v4u* xr = (v4u*)(XB + (size_t)row * DM) + c.lane;
        v4u mv[4], xv[4]; float v[4][8]; float s = 0.f;
#pragma unroll
        for (int j = 0; j < 4; ++j) { mv[j] = mr[64 * j]; xv[j] = xr[64 * j]; }
#pragma unroll
        for (int j = 0; j < 4; ++j)
#pragma unroll
            for (int k = 0; k < 4; ++k) { v[j][2 * k] = bflo(mv[j][k]); v[j][2 * k + 1] = bfhi(mv[j][k]); s += v[j][2 * k] * v[j][2 * k] + v[j][2 * k + 1] * v[j][2 * k + 1]; }
        const float rs = rsqrtf(wave_sum(s) * (1.f / DM) + EPS);
        float s2 = 0.f;
#pragma unroll
        for (int j = 0; j < 4; ++j) { const float* gp = gpost + (c.lane + 64 * j) * 8; const f32x4 g0 = *(const f32x4*)gp, g1 = *(const f32x4*)(gp + 4);
#pragma unroll
            for (int k = 0; k < 4; ++k) { const float ga = (k < 2) ? g0[2 * k] : g1[2 * k - 4], gb = (k < 2) ? g0[2 * k + 1] : g1[2 * k - 3];
                v[j][2 * k] = bflo(xv[j][k]) + v[j][2 * k] * rs * ga; v[j][2 * k + 1] = bfhi(xv[j][k]) + v[j][2 * k + 1] * rs * gb;
                s2 += v[j][2 * k] * v[j][2 * k] + v[j][2 * k + 1] * v[j][2 * k + 1]; } }
        if (OUT) {
#pragma unroll
            for (int j = 0; j < 4; ++j) { float* op = OUT + (size_t)row * DM + (c.lane + 64 * j) * 8; *(f32x4*)op = (f32x4){v[j][0], v[j][1], v[j][2], v[j][3]}; *(f32x4*)(op + 4) = (f32x4){v[j][4], v[j][5], v[j][6], v[j][7]}; }
        } else {
#pragma unroll
            for (int j = 0; j < 4; ++j) { v4u o; o.x = pk2(v[j][0], v[j][1]); o.y = pk2(v[j][2], v[j][3]); o.z = pk2(v[j][4], v[j][5]); o.w = pk2(v[j][6], v[j][7]); xr[64 * j] = o; }
            const float rs2 = rsqrtf(wave_sum(s2) * (1.f / DM) + EPS); if (c.lane == 0) RS[row] = rs2;
        }
    }
}
__device__ __forceinline__ void x_to_xb(const Ctx& c, const float* X, bf16* XB, float* RS) {
    for (int row = c.gw; row < MT; row += c.NGW) {
        const f32x4* xr = (const f32x4*)(X + (size_t)row * DM) + c.lane; f32x4 v[8]; float s = 0.f;
#pragma unroll
        for (int j = 0; j < 8; ++j) { v[j] = xr[64 * j]; s += (v[j].x * v[j].x + v[j].y * v[j].y) + (v[j].z * v[j].z + v[j].w * v[j].w); }
        const float rs = rsqrtf(wave_sum(s) * (1.f / DM) + EPS); if (c.lane == 0) RS[row] = rs;
        v2u* o8 = (v2u*)(XB + (size_t)row * DM) + c.lane;
#pragma unroll
        for (int j = 0; j < 8; ++j) { v2u o; o.x = pk2(v[j].x, v[j].y); o.y = pk2(v[j].z, v[j].w); o8[64 * j] = o; }
    }
}

__device__ __forceinline__ void ffn_convact(const Ctx& c, const bf16* U, const float* cw, const float* cb, bf16* ACT) {
    const int NCG = FFH / 8, items = (MT / 8) * NCG;
    for (int it = c.vcu * 512 + c.tid; it < items; it += c.G * 512) {
        const int rb = it / NCG, cg = it % NCG, c0 = cg * 8, row0 = rb * 8, t0 = row0 & (SEQ - 1);
        v4u ga[10], va[10];
#pragma unroll
        for (int i = 0; i < 10; ++i) { const bool ok = (i >= 2) || (t0 != 0); const size_t r = (size_t)(row0 + i - 2);
            ga[i] = ok ? *(const v4u*)(U + r * FF2 + c0) : (v4u){0u, 0u, 0u, 0u}; va[i] = ok ? *(const v4u*)(U + r * FF2 + FFH + c0) : (v4u){0u, 0u, 0u, 0u}; }
        float wg[3][8], wv[3][8], bg[8], bv[8];
#pragma unroll
        for (int k = 0; k < 3; ++k) { const f32x4 a0 = *(const f32x4*)(cw + k * FF2 + c0), a1 = *(const f32x4*)(cw + k * FF2 + c0 + 4), b0 = *(const f32x4*)(cw + k * FF2 + FFH + c0), b1 = *(const f32x4*)(cw + k * FF2 + FFH + c0 + 4);
#pragma unroll
            for (int j = 0; j < 4; ++j) { wg[k][j] = a0[j]; wg[k][4 + j] = a1[j]; wv[k][j] = b0[j]; wv[k][4 + j] = b1[j]; } }
        { const f32x4 a0 = *(const f32x4*)(cb + c0), a1 = *(const f32x4*)(cb + c0 + 4), b0 = *(const f32x4*)(cb + FFH + c0), b1 = *(const f32x4*)(cb + FFH + c0 + 4);
#pragma unroll
          for (int j = 0; j < 4; ++j) { bg[j] = a0[j]; bg[4 + j] = a1[j]; bv[j] = b0[j]; bv[4 + j] = b1[j]; } }
#pragma unroll
        for (int i = 0; i < 8; ++i) {
            float o[8];
#pragma unroll
            for (int j = 0; j < 8; ++j) { const int q = j >> 1;
                const float g2 = (j & 1) ? bfhi(ga[i][q]) : bflo(ga[i][q]), g1 = (j & 1) ? bfhi(ga[i + 1][q]) : bflo(ga[i + 1][q]), g0 = (j & 1) ? bfhi(ga[i + 2][q]) : bflo(ga[i + 2][q]);
                const float v2 = (j & 1) ? bfhi(va[i][q]) : bflo(va[i][q]), v1 = (j & 1) ? bfhi(va[i + 1][q]) : bflo(va[i + 1][q]), v0 = (j & 1) ? bfhi(va[i + 2][q]) : bflo(va[i + 2][q]);
                const float cgv = bg[j] + wg[0][j] * g2 + wg[1][j] * g1 + wg[2][j] * g0, cvv = bv[j] + wv[0][j] * v2 + wv[1][j] * v1 + wv[2][j] * v0;
                o[j] = siluf_(cgv) * cvv; }
            v4u w; w.x = pk2(o[0], o[1]); w.y = pk2(o[2], o[3]); w.z = pk2(o[4], o[5]); w.w = pk2(o[6], o[7]);
            *(v4u*)(ACT + (size_t)(row0 + i) * FFH + c0) = w;
        }
    }
}

__device__ __forceinline__ void ssd_conv(const Ctx& c, const bf16* P, const float* cw, const float* cb, const float* dtb, bf16* X2, float* DT) {
    const int NC = 6144, NCG = NC / 8, items = (MT / 8) * NCG;
    for (int it = c.vcu * 512 + c.tid; it < items; it += c.G * 512) {
        const int rb = it / NCG, cg = it % NCG, c0 = cg * 8, row0 = rb * 8, t0 = row0 & (SEQ - 1);
        v4u xa[11];
#pragma unroll
        for (int i = 0; i < 11; ++i) { const bool ok = (i >= 3) || (t0 != 0); xa[i] = ok ? *(const v4u*)(P + (size_t)(row0 + i - 3) * SSD_NP + 4096 + c0) : (v4u){0u, 0u, 0u, 0u}; }
        float w[4][8], bb[8];
#pragma unroll
        for (int k = 0; k < 4; ++k) { const f32x4 a0 = *(const f32x4*)(cw + k * NC + c0), a1 = *(const f32x4*)(cw + k * NC + c0 + 4);
#pragma unroll
            for (int j = 0; j < 4; ++j) { w[k][j] = a0[j]; w[k][4 + j] = a1[j]; } }
        { const f32x4 a0 = *(const f32x4*)(cb + c0), a1 = *(const f32x4*)(cb + c0 + 4);
#pragma unroll
          for (int j = 0; j < 4; ++j) { bb[j] = a0[j]; bb[4 + j] = a1[j]; } }
#pragma unroll
        for (int i = 0; i < 8; ++i) {
            float o[8];
#pragma unroll
            for (int j = 0; j < 8; ++j) { const int q = j >> 1; float y = bb[j];
#pragma unroll
                for (int k = 0; k < 4; ++k) y += w[k][j] * ((j & 1) ? bfhi(xa[i + k][q]) : bflo(xa[i + k][q]));
                o[j] = silu_fast(y); }
            v4u wv; wv.x = pk2(o[0], o[1]); wv.y = pk2(o[2], o[3]); wv.z = pk2(o[4], o[5]); wv.w = pk2(o[6], o[7]);
            *(v4u*)(X2 + (size_t)(row0 + i) * NC + c0) = wv;
        }
    }
    for (int it = c.vcu * 512 + c.tid; it < MT * 64; it += c.G * 512) {
        const int row = it >> 6, h = it & 63; const float raw = bflo((unsigned)P[(size_t)row * SSD_NP + 10240 + h]) + dtb[h];
        DT[it] = raw > 20.f ? raw : log1pf(expf(raw));
    }
}

__device__ __forceinline__ s16x4 tr16(const LAS unsigned char* p) { return __builtin_amdgcn_ds_read_tr16_b64_v4i16((LAS s16x4*)p); }
__device__ __forceinline__ bf16x8 cat8(s16x4 a, s16x4 b) { bf16x8 r; r[0] = a[0]; r[1] = a[1]; r[2] = a[2]; r[3] = a[3]; r[4] = b[0]; r[5] = b[1]; r[6] = b[2]; r[7] = b[3]; return r; }
__device__ __forceinline__ void ssd_scan_mfma(const Ctx& c, bf16* X2, const float* DT, const float* a_log, const float* dskip, bool do_store) {
    constexpr int SS_B = 0, SS_C = 17408, SS_XR = 34816, SS_XD = 44032, SS_XW = 53248, SS_SB = 62464  , SS_CS = 97280  , SS_DTS = 97792  ;
    LAS unsigned char* L = c.lds;
    const int tid = c.tid, lane = c.lane, l15 = lane & 15, lg = lane >> 4, w = c.wave, lt = w >> 1, ph = w & 1, tq = l15 >> 2, tp = l15 & 3;
    for (int u = c.vcu; u < NB * 64; u += c.G) {
        const int b = u >> 6, h = u & 63, g = h >> 3; const float Ah = -expf(a_log[h]), Dh = dskip[h];
        f32x4 ST[4];
#pragma unroll
        for (int i = 0; i < 4; ++i) ST[i] = (f32x4){0.f, 0.f, 0.f, 0.f};
        __syncthreads();
        for (int i = tid; i < 17408 / 16; i += 512) *(LAS v4u*)(L + SS_SB + i * 16) = (v4u){0u, 0u, 0u, 0u};
        v4u rB[2], rC[2], rXR; float rdt = 0.f;
        const bf16* x2b = X2 + (size_t)b * SEQ * 6144;
#define SSD_LOAD(t0_) do { _Pragma("unroll") for (int e = 0; e < 2; ++e) { const int cc = tid + 512 * e; \
            rB[e] = *(const v4u*)(x2b + (size_t)((t0_) + (cc >> 4)) * 6144 + 4096 + g * 128 + (cc & 15) * 8); rC[e] = *(const v4u*)(x2b + (size_t)((t0_) + (cc >> 4)) * 6144 + 5120 + g * 128 + (cc & 15) * 8); } \
            rXR = *(const v4u*)(x2b + (size_t)((t0_) + (tid >> 3)) * 6144 + h * 64 + (tid & 7) * 8); } while (0)
#define SSD_CS(buf_) do { if (w == 0) { float a = rdt * Ah; \
            _Pragma("unroll") for (int o = 1; o < 64; o <<= 1) { const float v = __shfl_up(a, o); if (lane >= o) a += v; } \
            ((LAS float*)(L + SS_CS))[(buf_) * 64 + lane] = a; ((LAS float*)(L + SS_DTS))[(buf_) * 64 + lane] = rdt; } } while (0)
#define SSD_LDT(t0_) do { if (w == 0) rdt = DT[((size_t)b * SEQ + (t0_) + lane) * 64 + h]; } while (0)
        SSD_LOAD(0); SSD_LDT(0); SSD_CS(0); SSD_LDT(64);
        for (int ch = 0; ch < SEQ / 64; ++ch) {
            const int t0 = ch * 64, cb = ch & 1; LAS float* CS = (LAS float*)(L + SS_CS) + cb * 64; LAS float* DTS = (LAS float*)(L + SS_DTS) + cb * 64;
            LAS unsigned char* SBr = L + SS_SB + cb * 17408; LAS unsigned char* SBw = L + SS_SB + (cb ^ 1) * 17408;
            __syncthreads();
#pragma unroll
            for (int e = 0; e < 2; ++e) { const int cc = tid + 512 * e;
                *(LAS v4u*)(L + SS_B + (cc >> 4) * 272 + (cc & 15) * 16) = rB[e]; *(LAS v4u*)(L + SS_C + (cc >> 4) * 272 + (cc & 15) * 16) = rC[e]; }
            *(LAS v4u*)(L + SS_XR + (tid >> 3) * 144 + (tid & 7) * 16) = rXR;
            { const int sr = tid >> 3, p8 = tid & 7; const float fd = DTS[sr], fw = fd * __expf(CS[63] - CS[sr]);
              float xv[8];
#pragma unroll
              for (int j = 0; j < 4; ++j) { xv[2 * j] = bflo(rXR[j]); xv[2 * j + 1] = bfhi(rXR[j]); }
              v4u o1, o2; o1.x = pk2(xv[0] * fd, xv[1] * fd); o1.y = pk2(xv[2] * fd, xv[3] * fd); o1.z = pk2(xv[4] * fd, xv[5] * fd); o1.w = pk2(xv[6] * fd, xv[7] * fd);
              o2.x = pk2(xv[0] * fw, xv[1] * fw); o2.y = pk2(xv[2] * fw, xv[3] * fw); o2.z = pk2(xv[4] * fw, xv[5] * fw); o2.w = pk2(xv[6] * fw, xv[7] * fw);
              *(LAS v4u*)(L + SS_XD + sr * 144 + p8 * 16) = o1; *(LAS v4u*)(L + SS_XW + sr * 144 + p8 * 16) = o2; }
            if (ch + 1 < SEQ / 64) { SSD_LOAD(t0 + 64); SSD_CS(cb ^ 1); if (ch + 2 < SEQ / 64) SSD_LDT(t0 + 128); }
            __syncthreads();
            {
                const float csl = CS[16 * lt + l15];
                bf16x8 Cf[4];
#pragma unroll
                for (int ks = 0; ks < 4; ++ks) Cf[ks] = *(const LAS bf16x8*)(L + SS_C + (16 * lt + l15) * 272 + (32 * ks + 8 * lg) * 2);
                f32x4 GT[4];
#pragma unroll
                for (int st = 0; st < 4; ++st) { GT[st] = (f32x4){0.f, 0.f, 0.f, 0.f};
                    if (st <= lt) {
#pragma unroll
                        for (int ks = 0; ks < 4; ++ks) { const bf16x8 bf = *(const LAS bf16x8*)(L + SS_B + (16 * st + l15) * 272 + (32 * ks + 8 * lg) * 2); GT[st] = __builtin_amdgcn_mfma_f32_16x16x32_bf16(bf, Cf[ks], GT[st], 0, 0, 0); }
                        const f32x4 css = *(const LAS f32x4*)(CS + 16 * st + 4 * lg);
#pragma unroll
                        for (int r = 0; r < 4; ++r) { const bool ok = (16 * st + 4 * lg + r) <= (16 * lt + l15); GT[st][r] = ok ? GT[st][r] * __expf(csl - css[r]) : 0.f; }
                    } }
                bf16x8 Lf[2];
#pragma unroll
                for (int k2 = 0; k2 < 2; ++k2) { v4u q; q.x = pg8::cvt_pk_bf16(GT[2 * k2][0], GT[2 * k2][1]); q.y = pg8::cvt_pk_bf16(GT[2 * k2][2], GT[2 * k2][3]); q.z = pg8::cvt_pk_bf16(GT[2 * k2 + 1][0], GT[2 * k2 + 1][1]); q.w = pg8::cvt_pk_bf16(GT[2 * k2 + 1][2], GT[2 * k2 + 1][3]);
                    Lf[k2] = __builtin_bit_cast(bf16x8, q); }
                const float el = __expf(csl);
                const LAS unsigned char* xdb = L + SS_XD + (4 * lg + tq) * 144 + tp * 8;
#pragma unroll
                for (int pp = 0; pp < 2; ++pp) { const int pt = 2 * ph + pp; f32x4 Y = (f32x4){0.f, 0.f, 0.f, 0.f}, Yo = (f32x4){0.f, 0.f, 0.f, 0.f};
#pragma unroll
                    for (int k2 = 0; k2 < 2; ++k2) if (2 * k2 <= lt) { const LAS unsigned char* xp = xdb + k2 * 32 * 144 + pt * 32;
                        Y = __builtin_amdgcn_mfma_f32_16x16x32_bf16(cat8(tr16(xp), tr16(xp + 16 * 144)), Lf[k2], Y, 0, 0, 0); }
#pragma unroll
                    for (int ks = 0; ks < 4; ++ks) { const bf16x8 sb = *(const LAS bf16x8*)(SBr + (16 * pt + l15) * 272 + (32 * ks + 8 * lg) * 2); Yo = __builtin_amdgcn_mfma_f32_16x16x32_bf16(sb, Cf[ks], Yo, 0, 0, 0); }
                    const v2u xr = *(const LAS v2u*)(L + SS_XR + (16 * lt + l15) * 144 + (16 * pt + 4 * lg) * 2);
                    const float y0 = Y[0] + el * Yo[0] + Dh * bflo(xr.x), y1 = Y[1] + el * Yo[1] + Dh * bfhi(xr.x), y2 = Y[2] + el * Yo[2] + Dh * bflo(xr.y), y3 = Y[3] + el * Yo[3] + Dh * bfhi(xr.y);
                    v2u o; o.x = pk2(y0, y1); o.y = pk2(y2, y3);
                    if (do_store) *(v2u*)(X2 + ((size_t)b * SEQ + t0 + 16 * lt + l15) * 6144 + h * 64 + 16 * pt + 4 * lg) = o; }
                const float e63 = __expf(CS[63]); const int pts = w >> 1;
                const LAS unsigned char* bb = L + SS_B + (8 * lg + tq) * 272 + tp * 8; const LAS unsigned char* xwb = L + SS_XW + (8 * lg + tq) * 144 + tp * 8 + pts * 32;
                bf16x8 Xf[2];
#pragma unroll
                for (int ks = 0; ks < 2; ++ks) Xf[ks] = cat8(tr16(xwb + ks * 32 * 144), tr16(xwb + ks * 32 * 144 + 4 * 144));
#pragma unroll
                for (int i = 0; i < 4; ++i) { const int nt = 4 * (w & 1) + i; ST[i] *= e63;
#pragma unroll
                    for (int ks = 0; ks < 2; ++ks) { const LAS unsigned char* bp = bb + ks * 32 * 272 + nt * 32;
                        ST[i] = __builtin_amdgcn_mfma_f32_16x16x32_bf16(cat8(tr16(bp), tr16(bp + 4 * 272)), Xf[ks], ST[i], 0, 0, 0); }
                    v2u q; q.x = pk2(ST[i][0], ST[i][1]); q.y = pk2(ST[i][2], ST[i][3]);
                    *(LAS v2u*)(SBw + (16 * pts + l15) * 272 + (16 * nt + 4 * lg) * 2) = q; }
            }
        }
#undef SSD_LOAD
#undef SSD_CS
#undef SSD_LDT
    }
    __syncthreads();
}

__device__ __forceinline__ void ssd_gnorm(const Ctx& c, bf16* X2, const bf16* P, const float* g) {
    for (int row = c.gw; row < MT; row += c.NGW) {
        v4u* yr = (v4u*)(X2 + (size_t)row * 6144) + c.lane; const v4u* zr = (const v4u*)(P + (size_t)row * SSD_NP) + c.lane;
        float v[8][8]; float s = 0.f;
#pragma unroll
        for (int j = 0; j < 8; ++j) { const v4u y = yr[64 * j], z = zr[64 * j];
#pragma unroll
            for (int k = 0; k < 4; ++k) { const float a = bflo(y[k]) * siluf_(bflo(z[k])), b = bfhi(y[k]) * siluf_(bfhi(z[k])); v[j][2 * k] = a; v[j][2 * k + 1] = b; s += a * a + b * b; } }
        const float rs = rsqrtf(wave_sum(s) * (1.f / 4096.f) + EPS);
#pragma unroll
        for (int j = 0; j < 8; ++j) { const float* gg = g + (c.lane + 64 * j) * 8; const f32x4 g0 = *(const f32x4*)gg, g1 = *(const f32x4*)(gg + 4);
            v4u w; w.x = pk2(v[j][0] * rs * g0.x, v[j][1] * rs * g0.y); w.y = pk2(v[j][2] * rs * g0.z, v[j][3] * rs * g0.w); w.z = pk2(v[j][4] * rs * g1.x, v[j][5] * rs * g1.y); w.w = pk2(v[j][6] * rs * g1.z, v[j][7] * rs * g1.w);
            yr[64 * j] = w; }
    }
}

__device__ __forceinline__ void sgu_ln(const Ctx& c, bf16* P, const float* g) {
    for (int row = c.gw; row < MT; row += c.NGW) {
        v4u* vr = (v4u*)(P + (size_t)row * 8192 + 4096) + c.lane;
        float v[8][8]; float s = 0.f;
#pragma unroll
        for (int j = 0; j < 8; ++j) { const v4u y = vr[64 * j];
#pragma unroll
            for (int k = 0; k < 4; ++k) { v[j][2 * k] = bflo(y[k]); v[j][2 * k + 1] = bfhi(y[k]); s += v[j][2 * k] + v[j][2 * k + 1]; } }
        const float mu = wave_sum(s) * (1.f / 4096.f); float q = 0.f;
#pragma unroll
        for (int j = 0; j < 8; ++j)
#pragma unroll
            for (int k = 0; k < 8; ++k) { v[j][k] -= mu; q += v[j][k] * v[j][k]; }
        const float rs = rsqrtf(wave_sum(q) * (1.f / 4096.f) + EPS);
#pragma unroll
        for (int j = 0; j < 8; ++j) { const float* gg = g + (c.lane + 64 * j) * 8; const f32x4 g0 = *(const f32x4*)gg, g1 = *(const f32x4*)(gg + 4);
            v4u w; w.x = pk2(v[j][0] * rs * g0.x, v[j][1] * rs * g0.y); w.y = pk2(v[j][2] * rs * g0.z, v[j][3] * rs * g0.w); w.z = pk2(v[j][4] * rs * g1.x, v[j][5] * rs * g1.y); w.w = pk2(v[j][6] * rs * g1.z, v[j][7] * rs * g1.w);
            vr[64 * j] = w; }
    }
}
__device__ __forceinline__ void sgu_spatial(const Ctx& c, const bf16* P, const float* Wsp, const float* bsp, bf16* ACT) {
    LAS unsigned char* Vs = c.lds;
    for (int u = c.vcu; u < NB * 32 * 8; u += c.G) {
        const int g = u & 7, bc = u >> 3; const size_t row0 = (size_t)bc * 128;
        __syncthreads();
        for (int i = c.tid; i < 128 * 64; i += 512) { const int s = i >> 6, d8 = i & 63; *(LAS v4u*)(Vs + s * 1024 + d8 * 16) = *(const v4u*)(P + (row0 + s) * 8192 + 4096 + g * 512 + d8 * 8); }
        __syncthreads();
        const int d8 = c.lane;
        for (int i = 0; i < 16; ++i) {
            const int t = c.wave + 8 * i; const float* wrow = Wsp + ((size_t)g * 128 + t) * 128;
            float acc[8];
#pragma unroll
            for (int j = 0; j < 8; ++j) acc[j] = 0.f;
            for (int s = 0; s <= t; ++s) { const float w = wrow[s]; const v4u v = *(const LAS v4u*)(Vs + s * 1024 + d8 * 16);
#pragma unroll
                for (int j = 0; j < 4; ++j) { acc[2 * j] += w * bflo(v[j]); acc[2 * j + 1] += w * bfhi(v[j]); } }
            const float bb = bsp[g * 128 + t]; const v4u uu = *(const v4u*)(P + (row0 + t) * 8192 + g * 512 + d8 * 8);
            v4u w; w.x = pk2(bflo(uu.x) * (acc[0] + bb), bfhi(uu.x) * (acc[1] + bb)); w.y = pk2(bflo(uu.y) * (acc[2] + bb), bfhi(uu.y) * (acc[3] + bb));
            w.z = pk2(bflo(uu.z) * (acc[4] + bb), bfhi(uu.z) * (acc[5] + bb)); w.w = pk2(bflo(uu.w) * (acc[6] + bb), bfhi(uu.w) * (acc[7] + bb));
            *(v4u*)(ACT + (row0 + t) * 4096 + g * 512 + d8 * 8) = w;
        }
    }
    __syncthreads();
}

__device__ __forceinline__ void sgu_spatial_mfma(const Ctx& c, const bf16* P, const float* Wsp, const float* bsp, bf16* ACT) {
    constexpr int RS = 528, WB = 128 * RS, WRS = 272;
    LAS unsigned char* L = c.lds; const int tid = c.tid, l15 = c.lane & 15, lg = c.lane >> 4, w = c.wave;
    for (int u_ = c.vcu; u_ < (PROBE == 22 ? 2 : 1) * NB * 32 * 8; u_ += c.G) {
        const int u = u_ & (NB * 32 * 8 - 1); const int g = u & 7, bc = u >> 3; const size_t row0 = (size_t)bc * 128;
        __syncthreads();
#pragma unroll
        for (int e = 0; e < 4; ++e) { const int cc = tid + 512 * e, t = cc >> 4, s8 = cc & 15; const float* wp = Wsp + ((size_t)g * 128 + t) * 128 + s8 * 8; f32x4 a = *(const f32x4*)wp, b = *(const f32x4*)(wp + 4);
#pragma unroll
            for (int j = 0; j < 4; ++j) { if (s8 * 8 + j > t) a[j] = 0.f; if (s8 * 8 + 4 + j > t) b[j] = 0.f; }
            v4u q; q.x = pk2(a[0], a[1]); q.y = pk2(a[2], a[3]); q.z = pk2(b[0], b[1]); q.w = pk2(b[2], b[3]); *(LAS v4u*)(L + WB + t * WRS + s8 * 16) = q; }
        for (int half = 0; half < 2; ++half) {
            if (half) __syncthreads();
#pragma unroll
            for (int e = 0; e < 8; ++e) { const int cc = tid + 512 * e, sr = cc >> 5, d8 = cc & 31; *(LAS v4u*)(L + sr * RS + d8 * 16) = *(const v4u*)(P + (row0 + sr) * 8192 + 4096 + g * 512 + 256 * half + d8 * 8); }
            __syncthreads();
            bf16x8 Wf[4];
#pragma unroll
            for (int ks = 0; ks < 4; ++ks) Wf[ks] = *(const LAS bf16x8*)(L + WB + (16 * w + l15) * WRS + (32 * ks + 8 * lg) * 2);
            const int nks = (w >> 1) + 1; const int t = 16 * w + l15; const float bb = bsp[g * 128 + t];
            const LAS unsigned char* vb = L + (8 * lg + (l15 >> 2)) * RS + (l15 & 3) * 8;
            v2u uv[16];
#pragma unroll
            for (int dt = 0; dt < 16; ++dt) uv[dt] = *(const v2u*)(P + (row0 + t) * 8192 + (size_t)g * 512 + 256 * half + 16 * dt + 4 * lg);
#pragma unroll
            for (int dt = 0; dt < 16; ++dt) {
                f32x4 acc = (f32x4){0.f, 0.f, 0.f, 0.f};
#pragma unroll
                for (int ks = 0; ks < 4; ++ks) if (ks < nks) {
                    const s16x4 a0 = __builtin_amdgcn_ds_read_tr16_b64_v4i16((LAS s16x4*)(vb + ks * 32 * RS + dt * 32)), a1 = __builtin_amdgcn_ds_read_tr16_b64_v4i16((LAS s16x4*)(vb + ks * 32 * RS + 4 * RS + dt * 32));
                    bf16x8 af; af[0] = a0[0]; af[1] = a0[1]; af[2] = a0[2]; af[3] = a0[3]; af[4] = a1[0]; af[5] = a1[1]; af[6] = a1[2]; af[7] = a1[3];
                    acc = __builtin_amdgcn_mfma_f32_16x16x32_bf16(af, Wf[ks], acc, 0, 0, 0); }
                const size_t col = (size_t)g * 512 + 256 * half + 16 * dt + 4 * lg;
                const v2u uu = uv[dt];
                v2u o; o.x = pk2(bflo(uu.x) * (acc[0] + bb), bfhi(uu.x) * (acc[1] + bb)); o.y = pk2(bflo(uu.y) * (acc[2] + bb), bfhi(uu.y) * (acc[3] + bb));
                *(v2u*)(ACT + (row0 + t) * 4096 + col) = o;
            }
        }
    }
    __syncthreads();
}

template <int WIN> __device__ __forceinline__ f32x4 pool_sum(const float* zp, int t) {
    f32x4 v[WIN];
#pragma unroll
    for (int j = 1; j < WIN; ++j) v[j] = (j <= t) ? *(const f32x4*)(zp - (size_t)j * DM) : (f32x4){0.f, 0.f, 0.f, 0.f};
    f32x4 s = (f32x4){0.f, 0.f, 0.f, 0.f};
#pragma unroll
    for (int j = 1; j < WIN; ++j) s += v[j];
    return s;
}
__device__ __forceinline__ void pool_pool(const Ctx& c, const float* Z, bf16* O) {
    for (int it = c.vcu * 512 + c.tid; it < MT * 512; it += c.G * 512) {
        const int row = it >> 9, c4 = (it & 511) * 4, gi = __builtin_amdgcn_readfirstlane(c4 >> 9), win = 2 << gi, t = row & (SEQ - 1), cnt = (t + 1 < win) ? t + 1 : win;
        const float* zp = Z + (size_t)row * DM + c4; const f32x4 z0 = *(const f32x4*)zp; f32x4 s;
        if (gi == 0) s = pool_sum<2>(zp, t); else if (gi == 1) s = pool_sum<4>(zp, t); else if (gi == 2) s = pool_sum<8>(zp, t); else s = pool_sum<16>(zp, t);
        s += z0;
        const float ic = 1.f / (float)cnt; v2u o; o.x = pk2(s.x * ic - z0.x, s.y * ic - z0.y); o.y = pk2(s.z * ic - z0.z, s.w * ic - z0.w);
        *(v2u*)(O + (size_t)row * DM + c4) = o;
    }
}

__device__ __forceinline__ void xa_attn(const Ctx& c, const bf16* Q, const bf16* KV, bf16* O) {
    LAS unsigned char* Ks = c.lds; LAS unsigned char* Vs = c.lds + 69632; LAS float* qs = (LAS float*)(c.lds + 135168 + c.wave * 1536); LAS float* ps = qs + 128;
    const int lane = c.lane; const float scale = 0.08838834764831845f;
    for (int u = c.vcu; u < 256; u += c.G) {
        const int bh = u >> 4, chunk = u & 15, b = bh >> 2, hd = bh & 3;
        __syncthreads();
        for (int i = c.tid; i < 256 * 16; i += 512) { const int key = i >> 4, d8 = i & 15; const bf16* src = KV + (size_t)(b * 256 + key) * 1024 + hd * 128 + d8 * 8;
            *(LAS v4u*)(Ks + key * 272 + d8 * 16) = *(const v4u*)src; *(LAS v4u*)(Vs + key * 256 + d8 * 16) = *(const v4u*)(src + 512); }
        __syncthreads();
        for (int i = 0; i < 32; ++i) {
            const size_t row = (size_t)b * SEQ + chunk * 256 + c.wave * 32 + i;
            const unsigned qq = *(const unsigned*)(Q + row * 512 + hd * 128 + 2 * lane);
            qs[2 * lane] = bflo(qq); qs[2 * lane + 1] = bfhi(qq);
            LDS_WAIT();
            float sc[4] = {0.f, 0.f, 0.f, 0.f};
#pragma unroll 2
            for (int d8 = 0; d8 < 16; ++d8) { const f32x4 q0 = *(const LAS f32x4*)(qs + d8 * 8), q1 = *(const LAS f32x4*)(qs + d8 * 8 + 4);
#pragma unroll
                for (int r = 0; r < 4; ++r) { const v4u kv = *(const LAS v4u*)(Ks + (lane + 64 * r) * 272 + d8 * 16);
                    sc[r] += bflo(kv.x) * q0.x + bfhi(kv.x) * q0.y + bflo(kv.y) * q0.z + bfhi(kv.y) * q0.w + bflo(kv.z) * q1.x + bfhi(kv.z) * q1.y + bflo(kv.w) * q1.z + bfhi(kv.w) * q1.w; } }
#pragma unroll
            for (int r = 0; r < 4; ++r) sc[r] *= scale;
            const float m = wave_max(fmaxf(fmaxf(sc[0], sc[1]), fmaxf(sc[2], sc[3])));
            float l = 0.f;
#pragma unroll
            for (int r = 0; r < 4; ++r) { const float p = __expf(sc[r] - m); l += p; ps[lane + 64 * r] = p; }
            l = wave_sum(l);
            LDS_WAIT();
            float o0 = 0.f, o1 = 0.f;
#pragma unroll 8
            for (int key = 0; key < 256; ++key) { const float p = ps[key]; const unsigned vv = *(const LAS unsigned*)(Vs + key * 256 + lane * 4); o0 += p * bflo(vv); o1 += p * bfhi(vv); }
            const float il = 1.f / l;
            *(unsigned*)(O + row * 512 + hd * 128 + 2 * lane) = pk2(o0 * il, o1 * il);
            LDS_WAIT();
        }
    }
    __syncthreads();
}

__device__ __forceinline__ void nsa_posbias(const Ctx& c, const float* pos, const float* w1, float* PBP) {
    for (int o = ((c.gw & 3) == 3) ? (c.gw >> 2) : 512; o < 512; o += (c.NGW >> 2)) { const int ten = o >> 8, nb = (o >> 6) & 3, ks = o & 63, n = nb * 64 + c.lane; float a = 0.f;
#pragma unroll 16
        for (int k = 0; k < 64; ++k) a += pos[ten * 4096 + ks * 64 + k] * w1[((size_t)ten * 4096 + ks * 64 + k) * 256 + n];
        PBP[(ten * 64 + ks) * 256 + n] = a; }
}
__device__ __forceinline__ void nsa_posbias_reduce(const Ctx& c, const float* PBP, float* PB) {
    if (c.vcu == 0) { const int ten = c.tid >> 8, n = c.tid & 255; float a = 0.f;
#pragma unroll 16
        for (int ks = 0; ks < 64; ++ks) a += PBP[(ten * 64 + ks) * 256 + n];
        PB[c.tid] = a; }
}
__device__ __forceinline__ void nsa_w2(const Ctx& c, const bf16* HID, const float* w2, float* KC) {
    for (int it = c.vcu * 512 + c.tid; it < 8192 * 128; it += c.G * 512) {
        const int r = it >> 7, d = it & 127, ten = r >> 12; const bf16* hrow = HID + (size_t)r * 256; const float* w = w2 + (size_t)ten * 256 * 128 + d; float a = 0.f;
#pragma unroll 8
        for (int h = 0; h < 256; ++h) a += bflo((unsigned)hrow[h]) * w[h * 128];
        KC[it] = a;
    }
}
__device__ __forceinline__ void nsa_block(const bf16* Kb, const bf16* Vb, bool valid, const LAS float* qs, LAS float* ps, int lane, float (&m)[4], float (&l)[4], float (&o)[4][2]) {
    const float scale = 0.08838834764831845f;
    float sc[4] = {0.f, 0.f, 0.f, 0.f};
    const v4u* kr = (const v4u*)(Kb + (size_t)lane * 128);
#pragma unroll 4
    for (int d8 = 0; d8 < 16; ++d8) { const v4u kv = kr[d8]; float k[8];
#pragma unroll
        for (int j = 0; j < 4; ++j) { k[2 * j] = bflo(kv[j]); k[2 * j + 1] = bfhi(kv[j]); }
#pragma unroll
        for (int h = 0; h < 4; ++h) { const f32x4 q0 = *(const LAS f32x4*)(qs + h * 128 + d8 * 8), q1 = *(const LAS f32x4*)(qs + h * 128 + d8 * 8 + 4);
            sc[h] += k[0] * q0.x + k[1] * q0.y + k[2] * q0.z + k[3] * q0.w + k[4] * q1.x + k[5] * q1.y + k[6] * q1.z + k[7] * q1.w; } }
    float alpha[4];
#pragma unroll
    for (int h = 0; h < 4; ++h) { const float s = valid ? sc[h] * scale : -1e30f; const float mn = fmaxf(m[h], wave_max(s)); const float p = valid ? __expf(s - mn) : 0.f;
        alpha[h] = __expf(m[h] - mn); m[h] = mn; l[h] = l[h] * alpha[h] + wave_sum(p); ps[h * 64 + lane] = p; o[h][0] *= alpha[h]; o[h][1] *= alpha[h]; }
    LDS_WAIT();
#pragma unroll 4
    for (int s = 0; s < 64; ++s) { const unsigned vv = *(const unsigned*)(Vb + (size_t)s * 128 + 2 * lane); const float v0 = bflo(vv), v1 = bfhi(vv);
#pragma unroll
        for (int h = 0; h < 4; ++h) { const float p = ps[h * 64 + s]; o[h][0] += p * v0; o[h][1] += p * v1; } }
    LDS_WAIT();
}
__device__ __forceinline__ void nsa_attn(const Ctx& c, const bf16* Q, const bf16* T, const float* KC, const float* Gt, bf16* OUT) {
    LAS float* qs = (LAS float*)(c.lds + c.wave * 8192);
    LAS float* ps = qs + 512;
    LAS float* psum = ps + 1024;
    const int lane = c.lane; const float scale = 0.08838834764831845f;
    for (int task = c.gw; task < MT * 4; task += c.NGW) {
        const int g = task & 3, row = task >> 2, b = row >> 12, t = row & 4095, bg = b * 4 + g;
        { const v4u qv = *(const v4u*)(Q + (size_t)row * 2048 + g * 512 + lane * 8); LAS float* qd = qs + lane * 8;
#pragma unroll
          for (int j = 0; j < 4; ++j) { qd[2 * j] = bflo(qv[j]); qd[2 * j + 1] = bfhi(qv[j]); } }
        LDS_WAIT();
        const int nv = (t >= 31) ? ((t - 31) >> 4) + 1 : 0;
        float oc[4][2] = {{0.f, 0.f}, {0.f, 0.f}, {0.f, 0.f}, {0.f, 0.f}};
        const float* kcb = KC + (size_t)bg * 256 * 128; const float* vcb = KC + (size_t)(16 + bg) * 256 * 128;
        psum[lane] = 0.f; psum[lane + 64] = 0.f; psum[lane + 128] = 0.f; psum[lane + 192] = 0.f;
        if (nv > 0) {
            float sc[4][4];
#pragma unroll
            for (int r = 0; r < 4; ++r) { const int i = lane + 64 * r;
#pragma unroll
                for (int h = 0; h < 4; ++h) sc[h][r] = 0.f;
                if (i < nv) { const f32x4* kr = (const f32x4*)(kcb + (size_t)i * 128);
#pragma unroll 4
                    for (int d4 = 0; d4 < 32; ++d4) { const f32x4 kv = kr[d4];
#pragma unroll
                        for (int h = 0; h < 4; ++h) { const f32x4 q0 = *(const LAS f32x4*)(qs + h * 128 + d4 * 4); sc[h][r] += kv.x * q0.x + kv.y * q0.y + kv.z * q0.z + kv.w * q0.w; } } } }
            float ps_r[4] = {0.f, 0.f, 0.f, 0.f};
#pragma unroll
            for (int h = 0; h < 4; ++h) { float mx = -1e30f;
#pragma unroll
                for (int r = 0; r < 4; ++r) { const bool ok = (lane + 64 * r) < nv; sc[h][r] = ok ? sc[h][r] * scale : -1e30f; mx = fmaxf(mx, sc[h][r]); }
                mx = wave_max(mx); float sm = 0.f;
#pragma unroll
                for (int r = 0; r < 4; ++r) { const bool ok = (lane + 64 * r) < nv; sc[h][r] = ok ? __expf(sc[h][r] - mx) : 0.f; sm += sc[h][r]; }
                sm = wave_sum(sm); const float inv = 1.f / sm;
#pragma unroll
                for (int r = 0; r < 4; ++r) { const float p = sc[h][r] * inv; ps[h * 256 + lane + 64 * r] = p; ps_r[r] += p; } }
#pragma unroll
            for (int r = 0; r < 4; ++r) psum[lane + 64 * r] = ps_r[r];
            LDS_WAIT();
            for (int i = 0; i < nv; ++i) { const f32x2 vv = *(const f32x2*)(vcb + (size_t)i * 128 + 2 * lane);
#pragma unroll
                for (int h = 0; h < 4; ++h) { const float p = ps[h * 256 + i]; oc[h][0] += p * vv.x; oc[h][1] += p * vv.y; } }
        }
        LDS_WAIT();
        const int cur = t >> 6;
        float imp = 0.f;
        { const int i0 = (4 * lane - 1) < 0 ? 0 : 4 * lane - 1, i1 = (4 * lane + 3) > 254 ? 254 : 4 * lane + 3;
          for (int i = i0; i <= i1; ++i) imp += psum[i]; }
        const bool forced = (lane == 0) || (lane <= cur && lane > cur - 3), future = lane > cur;
        const float score = forced ? 1e30f : (future ? -1e30f : imp);
        int rank = 0;
        for (int k = 0; k < 64; ++k) { const float sk = __shfl(score, k); rank += (sk > score || (sk == score && k < lane)) ? 1 : 0; }
        const unsigned long long selmask = __ballot(rank < 16);
        LDS_WAIT();
        float m1[4] = {-1e30f, -1e30f, -1e30f, -1e30f}, l1[4] = {0.f, 0.f, 0.f, 0.f}, o1[4][2] = {{0.f, 0.f}, {0.f, 0.f}, {0.f, 0.f}, {0.f, 0.f}};
        const bf16* ksb = T + 2 * NT_STRIDE + (size_t)bg * 4096 * 128; const bf16* vsb = T + 3 * NT_STRIDE + (size_t)bg * 4096 * 128;
        for (int k = 0; k <= cur; ++k) { if (!((selmask >> k) & 1ull)) continue;
            nsa_block(ksb + (size_t)k * 64 * 128, vsb + (size_t)k * 64 * 128, (k * 64 + lane) <= t, qs, ps, lane, m1, l1, o1); }
        float m2[4] = {-1e30f, -1e30f, -1e30f, -1e30f}, l2[4] = {0.f, 0.f, 0.f, 0.f}, o2[4][2] = {{0.f, 0.f}, {0.f, 0.f}, {0.f, 0.f}, {0.f, 0.f}};
        const bf16* kwb = T + 4 * NT_STRIDE + (size_t)bg * 4096 * 128; const bf16* vwb = T + 5 * NT_STRIDE + (size_t)bg * 4096 * 128;
        const int lo = (t - 511) < 0 ? 0 : (t - 511);
        for (int k = lo >> 6; k <= cur; ++k) { const int pos = k * 64 + lane;
            nsa_block(kwb + (size_t)k * 64 * 128, vwb + (size_t)k * 64 * 128, pos <= t && pos >= lo, qs, ps, lane, m2, l2, o2); }
#pragma unroll
        for (int h = 0; h < 4; ++h) { const float* gl = Gt + (size_t)row * 48 + (g * 4 + h) * 3; const float g0 = sigmoidf_(gl[0]), g1 = sigmoidf_(gl[1]), g2 = sigmoidf_(gl[2]);
            const float i1 = 1.f / l1[h], i2 = 1.f / l2[h];
            const float a = g0 * oc[h][0] + g1 * o1[h][0] * i1 + g2 * o2[h][0] * i2, bq = g0 * oc[h][1] + g1 * o1[h][1] * i1 + g2 * o2[h][1] * i2;
            *(unsigned*)(OUT + (size_t)row * 2048 + (g * 4 + h) * 128 + 2 * lane) = pk2(a, bq); }
        LDS_WAIT();
    }
}


namespace fa {
constexpr int KS_STRIDE = 272, VT_STRIDE = 144, KS_BYTES = 64 * KS_STRIDE, VT_BYTES = 128 * VT_STRIDE, BUF_BYTES = KS_BYTES + VT_BYTES;
constexpr int PS_OFF = 2 * BUF_BYTES, PS_STRIDE = 260, SM_OFF = PS_OFF + 64 * PS_STRIDE * 4;
constexpr float C2 = 0.08838834764831845f * 1.4426950408889634f;
struct Src { const bf16* K; size_t kstride; const bf16* Vt; size_t vstride; };
struct Stage { v4u k[2], v[2]; };
template <bool WITH_V> __device__ __forceinline__ void load_tile(const Src& s, int key0, int tid, Stage& st) {
#pragma unroll
    for (int e = 0; e < 2; ++e) { const int cc = tid + 512 * e;
        st.k[e] = *(const v4u*)(s.K + (size_t)(key0 + (cc >> 4)) * s.kstride + (cc & 15) * 8);
        if constexpr (WITH_V) st.v[e] = *(const v4u*)(s.Vt + (size_t)(cc >> 3) * s.vstride + key0 + (cc & 7) * 8); }
}
template <bool WITH_V> __device__ __forceinline__ void store_tile(LAS unsigned char* buf, int tid, const Stage& st) {
#pragma unroll
    for (int e = 0; e < 2; ++e) { const int cc = tid + 512 * e;
        *(LAS v4u*)(buf + (cc >> 4) * KS_STRIDE + (cc & 15) * 16) = st.k[e];
        if constexpr (WITH_V) *(LAS v4u*)(buf + KS_BYTES + (cc >> 3) * VT_STRIDE + (cc & 7) * 16) = st.v[e]; }
}
struct NoMask { __device__ __forceinline__ bool valid(int, int, int) const { return true; } __device__ __forceinline__ bool need(int) const { return false; } };
struct CmpMask { int nvq[2]; __device__ __forceinline__ bool valid(int kb, int ko, int mi) const { return kb * 64 + ko < nvq[mi]; } __device__ __forceinline__ bool need(int kb) const { return !__all(kb * 64 + 64 <= nvq[0] && kb * 64 + 64 <= nvq[1]); } };
struct SelMask { int tq[2]; unsigned long long sm[2]; int qb; __device__ __forceinline__ bool valid(int kb, int ko, int mi) const { return ((sm[mi] >> kb) & 1ull) && (kb * 64 + ko <= tq[mi]); }
    __device__ __forceinline__ bool need(int kb) const { return kb == qb || !__all((int)((sm[0] >> kb) & (sm[1] >> kb) & 1ull)); } };
struct WinMask { int tq[2]; int qb; __device__ __forceinline__ bool valid(int kb, int ko, int mi) const { const int kp = kb * 64 + ko; return kp <= tq[mi] && kp + 511 >= tq[mi]; } __device__ __forceinline__ bool need(int kb) const { return kb == qb || kb + 8 <= qb; } };

template <int MODE, class MaskF>
__device__ __forceinline__ void tile_qk(const LAS unsigned char* buf, const bf16x8 (&Qf)[2][4], f32x4 (&O)[8][2], float (&m)[2], float (&l)[2], const float (&invl)[2],
                                        int kb, const MaskF& mf, LAS float* PS, int wave, int l15, int lg, bf16x8 (&Pf)[2][2], f32x4 (&OL)[2]) {
    f32x4 S[4][2];
#pragma unroll
    for (int nt = 0; nt < 4; ++nt)
#pragma unroll
        for (int mi = 0; mi < 2; ++mi) S[nt][mi] = (f32x4){0.f, 0.f, 0.f, 0.f};
    const LAS unsigned char* kbase = buf + l15 * KS_STRIDE + lg * 16;
    bf16x8 kf[2][2];
#pragma unroll
    for (int q = 0; q < 2; ++q) kf[0][q] = *(const LAS bf16x8*)(kbase + q * 16 * KS_STRIDE);
#pragma unroll
    for (int h = 0; h < 8; ++h) { const int ks = h >> 1, n0 = (h & 1) * 2;
        if (h < 7) { const int ks1 = (h + 1) >> 1, n1 = ((h + 1) & 1) * 2;
#pragma unroll
            for (int q = 0; q < 2; ++q) kf[(h + 1) & 1][q] = *(const LAS bf16x8*)(kbase + (n1 + q) * 16 * KS_STRIDE + ks1 * 64); }
        __builtin_amdgcn_sched_barrier(0);
        __builtin_amdgcn_s_setprio(1);
#pragma unroll
        for (int q = 0; q < 2; ++q)
#pragma unroll
            for (int mi = 0; mi < 2; ++mi) S[n0 + q][mi] = __builtin_amdgcn_mfma_f32_16x16x32_bf16(kf[h & 1][q], Qf[mi][ks], S[n0 + q][mi], 0, 0, 0);
        __builtin_amdgcn_s_setprio(0);
        __builtin_amdgcn_sched_barrier(0);
    }
    const float NEG = -__builtin_inff();
    float mx[2] = {NEG, NEG};
    if (mf.need(kb)) {
#pragma unroll
        for (int nt = 0; nt < 4; ++nt)
#pragma unroll
            for (int mi = 0; mi < 2; ++mi)
#pragma unroll
                for (int r = 0; r < 4; ++r) { const float sv = mf.valid(kb, 16 * nt + 4 * lg + r, mi) ? S[nt][mi][r] : NEG; S[nt][mi][r] = sv; mx[mi] = fmaxf(mx[mi], sv); }
    } else {
#pragma unroll
        for (int nt = 0; nt < 4; ++nt)
#pragma unroll
            for (int mi = 0; mi < 2; ++mi)
#pragma unroll
                for (int r = 0; r < 4; ++r) mx[mi] = fmaxf(mx[mi], S[nt][mi][r]);
    }
#pragma unroll
    for (int mi = 0; mi < 2; ++mi) {
        float ref;
        if constexpr (MODE == 2) { ref = m[mi]; }
        else { float t = fmaxf(mx[mi], __shfl_xor(mx[mi], 16)); t = fmaxf(t, __shfl_xor(t, 32)); t *= C2;
            if (__all(t <= m[mi] + 6.0f)) { ref = m[mi]; }
            else { const float mn = fmaxf(m[mi], t); const float alpha = __builtin_amdgcn_exp2f(m[mi] - mn); m[mi] = mn; ref = mn;
                if constexpr (MODE == 0) { OL[mi] *= alpha;
#pragma unroll
                    for (int dt = 0; dt < 8; ++dt) O[dt][mi] *= alpha; }
                else l[mi] *= alpha; } }
        float ps = 0.f;
#pragma unroll
        for (int nt = 0; nt < 4; ++nt)
#pragma unroll
            for (int r = 0; r < 4; ++r) { float p = __builtin_amdgcn_exp2f(__builtin_fmaf(S[nt][mi][r], C2, -ref)); if constexpr (MODE == 2) p *= invl[mi]; S[nt][mi][r] = p; if constexpr (MODE == 1) ps += p; }
        if constexpr (MODE == 1) l[mi] += ps;
    }
    if constexpr (MODE == 2) {
#pragma unroll
        for (int nt = 0; nt < 4; ++nt)
#pragma unroll
            for (int mi = 0; mi < 2; ++mi) { f32x4 v = S[nt][mi];
#pragma unroll
                for (int r = 0; r < 4; ++r) { v[r] += __shfl_xor(v[r], 1); v[r] += __shfl_xor(v[r], 2); }
                if ((l15 & 3) == 0) *(LAS f32x4*)(PS + ((32 * wave + 16 * mi + l15) >> 2) * PS_STRIDE + 64 * kb + 16 * nt + 4 * lg) = v; }
    }
    if constexpr (MODE != 1) {
#pragma unroll
        for (int mi = 0; mi < 2; ++mi)
#pragma unroll
            for (int k2 = 0; k2 < 2; ++k2) { v4u w; w.x = pg8::cvt_pk_bf16(S[2 * k2][mi][0], S[2 * k2][mi][1]); w.y = pg8::cvt_pk_bf16(S[2 * k2][mi][2], S[2 * k2][mi][3]);
                w.z = pg8::cvt_pk_bf16(S[2 * k2 + 1][mi][0], S[2 * k2 + 1][mi][1]); w.w = pg8::cvt_pk_bf16(S[2 * k2 + 1][mi][2], S[2 * k2 + 1][mi][3]); Pf[mi][k2] = __builtin_bit_cast(bf16x8, w); }
    }
}
__device__ __forceinline__ void tile_pv(const LAS unsigned char* buf, const bf16x8 (&Pf)[2][2], f32x4 (&O)[8][2], int l15, int lg, f32x4 (&OL)[2], bool with_l) {
    if (with_l) { v4u ow; ow.x = ow.y = ow.z = ow.w = 0x3F803F80u; const bf16x8 ones = __builtin_bit_cast(bf16x8, ow);
#pragma unroll
        for (int k2 = 0; k2 < 2; ++k2)
#pragma unroll
            for (int mi = 0; mi < 2; ++mi) OL[mi] = __builtin_amdgcn_mfma_f32_16x16x32_bf16(ones, Pf[mi][k2], OL[mi], 0, 0, 0); }
    const LAS unsigned char* vbase = buf + KS_BYTES + l15 * VT_STRIDE + lg * 8;
    v2u va[2][2][2];
#define FA_LDV(slot_, g_) do { _Pragma("unroll") for (int q = 0; q < 2; ++q) { const int dt_ = ((g_) & 3) * 2 + q, k2_ = (g_) >> 2; \
        va[slot_][q][0] = *(const LAS v2u*)(vbase + dt_ * 16 * VT_STRIDE + k2_ * 64); va[slot_][q][1] = *(const LAS v2u*)(vbase + dt_ * 16 * VT_STRIDE + k2_ * 64 + 32); } } while (0)
    FA_LDV(0, 0);
#pragma unroll
    for (int g = 0; g < 8; ++g) {
        if (g < 7) FA_LDV((g + 1) & 1, g + 1);
        __builtin_amdgcn_sched_barrier(0);
        __builtin_amdgcn_s_setprio(1);
#pragma unroll
        for (int q = 0; q < 2; ++q) { const int dt = (g & 3) * 2 + q, k2 = g >> 2; v4u w; w.x = va[g & 1][q][0].x; w.y = va[g & 1][q][0].y; w.z = va[g & 1][q][1].x; w.w = va[g & 1][q][1].y; const bf16x8 vf = __builtin_bit_cast(bf16x8, w);
#pragma unroll
            for (int mi = 0; mi < 2; ++mi) O[dt][mi] = __builtin_amdgcn_mfma_f32_16x16x32_bf16(vf, Pf[mi][k2], O[dt][mi], 0, 0, 0); }
        __builtin_amdgcn_s_setprio(0);
        __builtin_amdgcn_sched_barrier(0);
    }
#undef FA_LDV
}
template <int MODE, class MaskF>
__device__ __forceinline__ void run(LAS unsigned char* lds, const Src& src, unsigned long long tiles, const bf16x8 (&Qf)[2][4], f32x4 (&O)[8][2], float (&m)[2], float (&l)[2], const float (&invl)[2],
                                    const MaskF& mf, int tid, int wave, int l15, int lg) {
    if (tiles == 0ull) return;
    int kb = __builtin_ctzll(tiles); tiles &= tiles - 1ull; int cur = 0;
    f32x4 OL[2]; OL[0] = (f32x4){0.f, 0.f, 0.f, 0.f}; OL[1] = (f32x4){0.f, 0.f, 0.f, 0.f};
    { Stage st; load_tile<MODE != 1>(src, kb * 64, tid, st); store_tile<MODE != 1>(lds, tid, st); }
    __syncthreads();
    for (;;) {
        const bool more = tiles != 0ull; int nkb = 0;
        if (more) { nkb = __builtin_ctzll(tiles); tiles &= tiles - 1ull; }
        bf16x8 Pf[2][2];
        tile_qk<MODE>(lds + cur * BUF_BYTES, Qf, O, m, l, invl, kb, mf, (LAS float*)(lds + PS_OFF), wave, l15, lg, Pf, OL);
        __builtin_amdgcn_sched_barrier(0);
        Stage st;
        if (more) load_tile<MODE != 1>(src, nkb * 64, tid, st);
        if constexpr (MODE != 1) tile_pv(lds + cur * BUF_BYTES, Pf, O, l15, lg, OL, MODE == 0);
        if (more) store_tile<MODE != 1>(lds + (cur ^ 1) * BUF_BYTES, tid, st);
        __syncthreads();
        if (!more) break;
        kb = nkb; cur ^= 1;
    }
    if constexpr (MODE == 0) { l[0] = OL[0][0] * 0.25f; l[1] = OL[1][0] * 0.25f; }
}
}

__device__ __forceinline__ void xa_attn_fa(const Ctx& c, const bf16* Q, const bf16* KV, const bf16* XVT, bf16* Oo) {
    const int l15 = c.lane & 15, lg = c.lane >> 4;
    for (int u_ = c.vcu; u_ < (PROBE == 12 ? 512 : 256); u_ += c.G) {
        const int u = u_ & 255; const int bh = u >> 4, chunk = u & 15, b = bh >> 2, hd = bh & 3;
        bf16x8 Qf[2][4]; size_t grow[2];
#pragma unroll
        for (int mi = 0; mi < 2; ++mi) { grow[mi] = (size_t)b * SEQ + chunk * 256 + 32 * c.wave + 16 * mi + l15;
#pragma unroll
            for (int ks = 0; ks < 4; ++ks) Qf[mi][ks] = *(const bf16x8*)(Q + grow[mi] * 512 + hd * 128 + 32 * ks + 8 * lg); }
        f32x4 O[8][2]; float m[2] = {-1e30f, -1e30f}, l[2] = {0.f, 0.f}; const float invl[2] = {0.f, 0.f};
#pragma unroll
        for (int dt = 0; dt < 8; ++dt) { O[dt][0] = (f32x4){0.f, 0.f, 0.f, 0.f}; O[dt][1] = (f32x4){0.f, 0.f, 0.f, 0.f}; }
        fa::Src src{KV + (size_t)b * 256 * 1024 + hd * 128, 1024, XVT + (size_t)bh * 128 * 256, 256};
        fa::run<0>(c.lds, src, 0xFull, Qf, O, m, l, invl, fa::NoMask{}, c.tid, c.wave, l15, lg);
#pragma unroll
        for (int mi = 0; mi < 2; ++mi) { float lt = l[mi]; lt += __shfl_xor(lt, 16); lt += __shfl_xor(lt, 32); const float il = 1.f / lt;
#pragma unroll
            for (int dt = 0; dt < 8; ++dt) { const f32x4 o = O[dt][mi] * il; v2u w; w.x = pk2(o[0], o[1]); w.y = pk2(o[2], o[3]);
                *(v2u*)(Oo + grow[mi] * 512 + hd * 128 + 16 * dt + 4 * lg) = w; } }
    }
}
__device__ __forceinline__ void xa_vt(const Ctx& c, const bf16* KV, bf16* XVT) {
    for (int it = c.vcu * 512 + c.tid; it < 16 * 128 * 32; it += c.G * 512) {
        const int m8 = it & 31, d = (it >> 5) & 127, bh = it >> 12, b = bh >> 2, hd = bh & 3; unsigned short v[8];
#pragma unroll
        for (int j = 0; j < 8; ++j) v[j] = KV[(size_t)(b * 256 + m8 * 8 + j) * 1024 + 512 + hd * 128 + d];
        v4u w; w.x = v[0] | ((unsigned)v[1] << 16); w.y = v[2] | ((unsigned)v[3] << 16); w.z = v[4] | ((unsigned)v[5] << 16); w.w = v[6] | ((unsigned)v[7] << 16);
        *(v4u*)(XVT + ((size_t)bh * 128 + d) * 256 + m8 * 8) = w;
    }
}
__device__ __forceinline__ void nsa_vt(const Ctx& c, const bf16* T, bf16* VT) {
    LAS unsigned short* Tt = (LAS unsigned short*)c.lds;
    for (int it = c.vcu; it < 2 * 16 * 64; it += c.G) {
        const int tb = it & 63, bg = (it >> 6) & 15, which = it >> 10; const bf16* src = T + (size_t)(3 + 2 * which) * NT_STRIDE + ((size_t)bg * 4096 + tb * 64) * 128;
        __syncthreads();
#pragma unroll
        for (int e = 0; e < 2; ++e) { const int cc = c.tid + 512 * e, key = cc >> 4, d8 = cc & 15; const v4u v = *(const v4u*)(src + (size_t)key * 128 + d8 * 8);
#pragma unroll
            for (int j = 0; j < 4; ++j) { Tt[(d8 * 8 + 2 * j) * 72 + key] = (unsigned short)(v[j] & 0xffffu); Tt[(d8 * 8 + 2 * j + 1) * 72 + key] = (unsigned short)(v[j] >> 16); } }
        __syncthreads();
#pragma unroll
        for (int e = 0; e < 2; ++e) { const int cc = c.tid + 512 * e, d = cc >> 3, k8 = cc & 7;
            *(v4u*)(VT + ((size_t)(which * 16 + bg) * 128 + d) * 4096 + tb * 64 + k8 * 8) = *(const LAS v4u*)((const LAS unsigned char*)Tt + d * 144 + k8 * 16); }
    }
    __syncthreads();
}
__device__ __forceinline__ void nsa_hidreduce(const Ctx& c, const float* HIDP, const float* pb, bf16* HID) {
    for (int it = c.vcu * 512 + c.tid; it < 8192 * 32; it += c.G * 512) {
        const int r = it >> 5, h0 = (it & 31) * 8, ten = r >> 12; const float* hrow = HIDP + (size_t)r * 2048 + h0;
        f32x4 a0 = *(const f32x4*)(pb + ten * 256 + h0), a1 = *(const f32x4*)(pb + ten * 256 + h0 + 4);
#pragma unroll
        for (int sp = 0; sp < 8; ++sp) { a0 += *(const f32x4*)(hrow + sp * 256); a1 += *(const f32x4*)(hrow + sp * 256 + 4); }
        v4u o; o.x = pk2(gelu_tanh(a0.x), gelu_tanh(a0.y)); o.y = pk2(gelu_tanh(a0.z), gelu_tanh(a0.w)); o.z = pk2(gelu_tanh(a1.x), gelu_tanh(a1.y)); o.w = pk2(gelu_tanh(a1.z), gelu_tanh(a1.w));
        *(v4u*)(HID + (size_t)r * 256 + h0) = o;
    }
}
__device__ __forceinline__ void nsa_w2b(const Ctx& c, const bf16* HID, const float* w2, bf16* KCb, bf16* VCT) {
    for (int it = c.vcu * 512 + c.tid; it < 8192 * 16; it += c.G * 512) {
        const int r = it >> 4, d0 = (it & 15) * 8, ten = r >> 12, bg = (r >> 8) & 15, i = r & 255; const bf16* hrow = HID + (size_t)r * 256; const float* w = w2 + (size_t)ten * 256 * 128 + d0;
        float a[8];
#pragma unroll
        for (int j = 0; j < 8; ++j) a[j] = 0.f;
#pragma unroll 4
        for (int h8 = 0; h8 < 32; ++h8) { const v4u hv = *(const v4u*)(hrow + h8 * 8);
#pragma unroll
            for (int q = 0; q < 8; ++q) { const float hf = (q & 1) ? bfhi(hv[q >> 1]) : bflo(hv[q >> 1]); const f32x4 w0 = *(const f32x4*)(w + (size_t)(h8 * 8 + q) * 128), w1 = *(const f32x4*)(w + (size_t)(h8 * 8 + q) * 128 + 4);
                a[0] += hf * w0.x; a[1] += hf * w0.y; a[2] += hf * w0.z; a[3] += hf * w0.w; a[4] += hf * w1.x; a[5] += hf * w1.y; a[6] += hf * w1.z; a[7] += hf * w1.w; } }
        if (ten == 0) { v4u o; o.x = pk2(a[0], a[1]); o.y = pk2(a[2], a[3]); o.z = pk2(a[4], a[5]); o.w = pk2(a[6], a[7]); *(v4u*)(KCb + ((size_t)bg * 256 + i) * 128 + d0) = o; }
        else {
#pragma unroll
            for (int j = 0; j < 8; ++j) VCT[((size_t)bg * 128 + d0 + j) * 256 + i] = (bf16)f2bf(a[j]); }
    }
}
#define NSA_UNIT_PROLOGUE \
        const int ui = uu >> 8, slot = uu & 255; \
        const int bg = 2 * (slot >> 5) + (slot & 1), x = (slot & 31) >> 1, qb = (ui == 0) ? x : (ui == 1) ? 31 - x : (ui == 2) ? 32 + x : 63 - x;   \
        const int b = bg >> 2, g = bg & 3, t0 = qb * 64; \
        bf16x8 Qf[2][4]; int grow[2]; int tq[2], hcol[2]; \
        _Pragma("unroll") for (int mi = 0; mi < 2; ++mi) { const int qrow = 32 * c.wave + 16 * mi + l15, tl = qrow >> 2, j = qrow & 3; tq[mi] = t0 + tl; grow[mi] = b * SEQ + tq[mi]; hcol[mi] = (g * 4 + j) * 128; \
            _Pragma("unroll") for (int ks = 0; ks < 4; ++ks) Qf[mi][ks] = *(const bf16x8*)(Q + (size_t)grow[mi] * 2048 + hcol[mi] + 32 * ks + 8 * lg); }
__device__ __forceinline__ void nsa_attn_cmp(const Ctx& c, const bf16* Q, const bf16* KCb, const bf16* VCT, const float* Gt, float* NACC, unsigned long long* SMg) {
    const int l15 = c.lane & 15, lg = c.lane >> 4, lane = c.lane;
    LAS float* PS = (LAS float*)(c.lds + fa::PS_OFF);
#if PROBE == 9
#pragma unroll 1
    for (int rep_ = 0; rep_ < 2; ++rep_)
#endif
    for (int uu = c.vcu; uu < 1024; uu += c.G) {
        NSA_UNIT_PROLOGUE
        f32x4 O[8][2]; float m[2], l[2], invl[2] = {0.f, 0.f};
        const int tmax = t0 + 63, nvmax = tmax >= 31 ? ((tmax - 31) >> 4) + 1 : 0, ntile = (nvmax + 63) >> 6;
        { const unsigned long long tiles = (1ull << ntile) - 1ull;
          fa::CmpMask mk; mk.nvq[0] = tq[0] >= 31 ? ((tq[0] - 31) >> 4) + 1 : 0; mk.nvq[1] = tq[1] >= 31 ? ((tq[1] - 31) >> 4) + 1 : 0;
          fa::Src src{KCb + (size_t)bg * 256 * 128, 128, VCT + (size_t)bg * 128 * 256, 256};
          m[0] = m[1] = -1e30f; l[0] = l[1] = 0.f;
          fa::run<1>(c.lds, src, tiles, Qf, O, m, l, invl, mk, c.tid, c.wave, l15, lg);
#pragma unroll
          for (int mi = 0; mi < 2; ++mi) { float lt = l[mi]; lt += __shfl_xor(lt, 16); lt += __shfl_xor(lt, 32); invl[mi] = lt > 0.f ? 1.f / lt : 0.f; }
#pragma unroll
          for (int dt = 0; dt < 8; ++dt) { O[dt][0] = (f32x4){0.f, 0.f, 0.f, 0.f}; O[dt][1] = (f32x4){0.f, 0.f, 0.f, 0.f}; }
          fa::run<2>(c.lds, src, tiles, Qf, O, m, l, invl, mk, c.tid, c.wave, l15, lg);
#pragma unroll
          for (int mi = 0; mi < 2; ++mi) { const float g0 = sigmoidf_(Gt[(size_t)grow[mi] * 48 + (hcol[mi] >> 7) * 3 + 0]);
#pragma unroll
              for (int dt = 0; dt < 8; ++dt) *(f32x4*)(NACC + (size_t)grow[mi] * 2048 + hcol[mi] + 16 * dt + 4 * lg) = O[dt][mi] * g0; }
        }
        __syncthreads();
        for (int i = 0; i < 8; ++i) { const int tl = 8 * c.wave + i; const LAS float* pr = PS + tl * fa::PS_STRIDE; float imp = 0.f;
            { const int i0 = (4 * lane - 1) < 0 ? 0 : 4 * lane - 1; int i1 = (4 * lane + 3) > 254 ? 254 : 4 * lane + 3; if (i1 > 64 * ntile - 1) i1 = 64 * ntile - 1; for (int q = i0; q <= i1; ++q) imp += pr[q]; }
            const bool forced = (lane == 0) || (lane <= qb && lane > qb - 3), future = lane > qb;
            const float score = forced ? 1e30f : (future ? -1e30f : imp); int rank = 0;
            for (int k = 0; k < 64; ++k) { const float sk = __shfl(score, k); rank += (sk > score || (sk == score && k < lane)) ? 1 : 0; }
            const unsigned long long sel = __ballot(rank < 16); if (lane == 0) SMg[(size_t)bg * SEQ + t0 + tl] = sel; }
        __syncthreads();
    }
}
__device__ __forceinline__ void nsa_attn_sw(const Ctx& c, const bf16* Q, const bf16* T, const bf16* VT, const float* Gt, const float* NACC, float* NACC2, const unsigned long long* SMg, bf16* OUT) {
    const int l15 = c.lane & 15, lg = c.lane >> 4, lane = c.lane;
    for (int uu_ = c.vcu; uu_ < (PROBE == 21 ? 2048 : 1024); uu_ += c.G) { const int uu = uu_ & 1023;
        NSA_UNIT_PROLOGUE
        unsigned long long um = SMg[(size_t)bg * SEQ + t0 + lane];
#pragma unroll
        for (int o = 1; o < 64; o <<= 1) { const unsigned lo_ = __shfl_xor((unsigned)um, o), hi_ = __shfl_xor((unsigned)(um >> 32), o); um |= ((unsigned long long)hi_ << 32) | lo_; }
        const unsigned long long umu = ((unsigned long long)__builtin_amdgcn_readfirstlane((unsigned)(um >> 32)) << 32) | (unsigned)__builtin_amdgcn_readfirstlane((unsigned)um);
        f32x4 O[8][2]; float m[2], l[2]; const float invl[2] = {0.f, 0.f};
        { fa::SelMask mk; mk.qb = qb; mk.tq[0] = tq[0]; mk.tq[1] = tq[1]; mk.sm[0] = SMg[(size_t)bg * SEQ + tq[0]]; mk.sm[1] = SMg[(size_t)bg * SEQ + tq[1]];
          const unsigned long long tiles = umu & ((2ull << qb) - 1ull);
          fa::Src src{T + 2 * NT_STRIDE + (size_t)bg * 4096 * 128, 128, VT + (size_t)bg * 128 * 4096, 4096};
          m[0] = m[1] = -1e30f; l[0] = l[1] = 0.f;
#pragma unroll
          for (int dt = 0; dt < 8; ++dt) { O[dt][0] = (f32x4){0.f, 0.f, 0.f, 0.f}; O[dt][1] = (f32x4){0.f, 0.f, 0.f, 0.f}; }
          fa::run<0>(c.lds, src, tiles, Qf, O, m, l, invl, mk, c.tid, c.wave, l15, lg);
#pragma unroll
          for (int mi = 0; mi < 2; ++mi) { float lt = l[mi]; lt += __shfl_xor(lt, 16); lt += __shfl_xor(lt, 32); const float sc = sigmoidf_(Gt[(size_t)grow[mi] * 48 + (hcol[mi] >> 7) * 3 + 1]) / lt;
#pragma unroll
              for (int dt = 0; dt < 8; ++dt) { const size_t off = (size_t)grow[mi] * 2048 + hcol[mi] + 16 * dt + 4 * lg; *(f32x4*)(NACC2 + off) = *(const f32x4*)(NACC + off) + O[dt][mi] * sc; } }
        }
        { fa::WinMask mk; mk.qb = qb; mk.tq[0] = tq[0]; mk.tq[1] = tq[1];
          const int kb0 = qb - 8 < 0 ? 0 : qb - 8; const unsigned long long tiles = ((2ull << qb) - 1ull) & ~((1ull << kb0) - 1ull);
          fa::Src src{T + 4 * NT_STRIDE + (size_t)bg * 4096 * 128, 128, VT + (size_t)(16 + bg) * 128 * 4096, 4096};
          m[0] = m[1] = -1e30f; l[0] = l[1] = 0.f;
#pragma unroll
          for (int dt = 0; dt < 8; ++dt) { O[dt][0] = (f32x4){0.f, 0.f, 0.f, 0.f}; O[dt][1] = (f32x4){0.f, 0.f, 0.f, 0.f}; }
          fa::run<0>(c.lds, src, tiles, Qf, O, m, l, invl, mk, c.tid, c.wave, l15, lg);
#pragma unroll
          for (int mi = 0; mi < 2; ++mi) { float lt = l[mi]; lt += __shfl_xor(lt, 16); lt += __shfl_xor(lt, 32); const float sc = sigmoidf_(Gt[(size_t)grow[mi] * 48 + (hcol[mi] >> 7) * 3 + 2]) / lt;
#pragma unroll
              for (int dt = 0; dt < 8; ++dt) { const f32x4 a = *(const f32x4*)(NACC2 + (size_t)grow[mi] * 2048 + hcol[mi] + 16 * dt + 4 * lg) + O[dt][mi] * sc; v2u w_; w_.x = pk2(a[0], a[1]); w_.y = pk2(a[2], a[3]);
                  *(v2u*)(OUT + (size_t)grow[mi] * 2048 + hcol[mi] + 16 * dt + 4 * lg) = w_; } }
        }
    }
}

struct Args { const float* in[35]; float* out; unsigned char* ws; int ph_lo, ph_hi; };
constexpr int NPH = 16, N_PHASES = 4 * NPH;


#define IN(k) (lo <= (k) && (k) < hi)
#if MK_MULTI
#define SEAM(k) do { } while (0)
#else
#if PROBE == 4
#define SEAM(k) do { if (IN(k) && IN((k) + 1)) { xcd_barrier(bar); xcd_barrier(bar); } } while (0)
#else
#define SEAM(k) do { if (IN(k) && IN((k) + 1)) xcd_barrier(bar); } while (0)
#endif
#endif
template <int L>
__device__ __forceinline__ void layer_body(const Ctx& c, const Args& args, const XcdBarrier& bar, int lo, int hi) {
    constexpr int P0 = L * NPH;
    unsigned char* ws = args.ws;
    const float* x_in = args.in[0]; const float* mem = args.in[1]; const float* norm_pre = args.in[2]; const float* norm_post = args.in[3]; const float* norm_mem = args.in[4];
    float* X = args.out;
    bf16* XB = (bf16*)(ws + WS_H); float* RS = (float*)(ws + WS_PB + 256 * 1024); bf16* POOLED = (bf16*)(ws + WS_ACT + 64 * MiB); (void)POOLED; bf16* PROJ = (bf16*)(ws + WS_PROJ); float* MF = (float*)(ws + WS_PROJ); bf16* MFb = (bf16*)(ws + WS_PROJ); bf16* ACT = (bf16*)(ws + WS_ACT);
    bf16* XQ = (bf16*)(ws + WS_Q); bf16* XO = (bf16*)(ws + WS_O); bf16* KV = (bf16*)(ws + WS_KV); bf16* MEMN = (bf16*)(ws + WS_MEMN); float* DT = (float*)(ws + WS_DT); float* PB = (float*)(ws + WS_PB); float* PBP = (float*)(ws + WS_PB + 4096); (void)PBP;
    bf16* NQ = (bf16*)(ws + WS_NQ); bf16* NT = (bf16*)(ws + WS_NT); bf16* NHID = (bf16*)(ws + WS_NHID); float* NKC = (float*)(ws + WS_NKC); float* NG = (float*)(ws + WS_NG);
    bf16* Wmi = (bf16*)(ws + W_MIX_IN); bf16* Wmo = (bf16*)(ws + W_MIX_OUT); bf16* Wmx = (bf16*)(ws + W_MIX_X);
    bf16* Wxq = (bf16*)(ws + W_XQ); bf16* Wxkv = (bf16*)(ws + W_XKV); bf16* Wxo = (bf16*)(ws + W_XO); bf16* Wup = (bf16*)(ws + W_UP); bf16* Wdn = (bf16*)(ws + W_DOWN);
    const int cid = (int)blockIdx.x;
    bf16* NVT = (bf16*)(ws + WS_NVT); bf16* XVT = (bf16*)(ws + WS_XVT); bf16* KCb = (bf16*)(ws + WS_NKC); bf16* VCT = (bf16*)(ws + WS_NKC + 1 * MiB); unsigned long long* SMg = (unsigned long long*)(ws + WS_NKC + 2 * MiB);
    (void)x_in; (void)DT; (void)PB; (void)NQ; (void)NT; (void)NHID; (void)NKC; (void)NG; (void)Wmx; (void)NVT; (void)KCb; (void)VCT; (void)SMg;

        if (IN(P0 + 0))
#if PROBE == 11
#pragma unroll 1
        for (int rep_ = 0; rep_ < 2; ++rep_)
#endif
        {
            if constexpr (L == 0) { conv_w(c, args.in[5], 2048, SSD_IN, SSD_NP, Wmi, norm_pre + (L * 3) * DM); conv_w(c, args.in[12], 4096, 2048, 2048, Wmo); }
            if constexpr (L == 1) nsa_posbias(c, args.in[14], args.in[15], PBP);
            conv_w(c, args.in[28] + (size_t)L * 2048 * 512, 2048, 512, 512, Wxq, norm_pre + (L * 3 + 1) * DM, false, c.gw, c.NGW);
            conv_w(c, args.in[29] + (size_t)L * 2048 * 1024, 2048, 1024, 1024, Wxkv, nullptr, false, (c.gw + c.NGW - 256) % c.NGW, c.NGW);
            conv_w(c, args.in[30] + (size_t)L * 512 * 2048, 512, 2048, 2048, Wxo, nullptr, false, (c.gw + c.NGW - 768) % c.NGW, c.NGW);
            for (int r = (c.gw + c.NGW - 1024) % c.NGW; r < 1024; r += c.NGW) rms_row_bf16(c, mem + (size_t)r * DM, norm_mem + L * DM, MEMN + (size_t)r * DM, nullptr);
            if constexpr (L == 0) x_to_xb(c, x_in, XB, RS);
        }
        SEAM(P0 + 0);
        if (IN(P0 + 1)) {
            constexpr int NA = (L == 0) ? 11 : (L == 1) ? 6 : (L == 2) ? 8 : 2, NBU = (L == 0) ? 10 : (L == 1) ? 5 : (L == 2) ? 8 : 2;
            if ((cid >> 3) & 1) { const int ga = ((cid & 7) | ((cid >> 4) << 3)) * 8 + c.wave;
                conv_w(c, args.in[31] + (size_t)L * 2048 * FF2, 2048, FF2, FF2, Wup, norm_pre + (L * 3 + 2) * DM, true, ga, 1024);
                conv_w(c, args.in[34] + (size_t)L * FFH * 2048, FFH, 2048, 2048, Wdn, nullptr, false, ga, 1024); __syncthreads(); }
            if constexpr (L == 0) { pg8::ProbSplit S; S.init(XB, Wmi, 2048, 2048, 2048, 64, SSD_NP / 256, c.G, cid); S.nA = NA; S.nB = NBU; pg8::EpiP<StBf16> E{{PROJ, SSD_NP}, RS}; pg8::gemm_phase(c.lds, S, E); }
            else if constexpr (L == 1) { nsa_posbias_reduce(c, PBP, PB); pg8::ProbSplit S; S.init(XB, Wmi, 2048, 2048, 2048, 64, NSA_NP / 256, c.G, cid); S.nA = NA; S.nB = NBU; pg8::EpiP<StNsa> E{{NQ, NT, NG}, RS}; pg8::gemm_phase(c.lds, S, E); }
            else if constexpr (L == 2) { pg8::ProbSplit S; S.init(XB, Wmi, 2048, 2048, 2048, 64, 32, c.G, cid); S.nA = NA; S.nB = NBU; pg8::EpiP<StBf16BiasGelu> E{{PROJ, 8192, args.in[19]}, RS}; pg8::gemm_phase(c.lds, S, E); }
            else { pg8::ProbSplit S; S.init(XB, Wmi, 2048, 2048, 2048, 64, 8, c.G, cid); S.nA = NA; S.nB = NBU; pg8::EpiN<StF32> E{{MF, 2048}, RS}; pg8::gemm_phase(c.lds, S, E); }
        }
        SEAM(P0 + 1);
        if (IN(P0 + 2)) {
            if constexpr (L == 0) { ssd_conv(c, PROJ, args.in[6], args.in[7], args.in[8], ACT, DT);
#if PROBE == 11
                ssd_conv(c, PROJ, args.in[6], args.in[7], args.in[8], ACT, DT);
#endif
            }
            else if constexpr (L == 1) { pg8::ProbC S; S.init(NT, Wmx, 2048, 4096, 512, 32, 8, c.G, cid); S.a_tile_stride = (size_t)4096 * 128;
                pg8::EpiN<StF32> E{{(float*)(ws + WS_ACT), 2048}, nullptr}; pg8::gemm_phase(c.lds, S, E); nsa_vt(c, NT, NVT);
#if PROBE == 11
                nsa_vt(c, NT, NVT);
#endif
            }
            else if constexpr (L == 2) sgu_ln(c, PROJ, args.in[20]);
            else { pool_pool(c, MF, POOLED);
#if PROBE == 11
                pool_pool(c, MF, POOLED);
#endif
            }
        }
        SEAM(P0 + 2);
        if (IN(P0 + 3)) {
            if constexpr (L == 0) {
#if PROBE == 10
                ssd_scan_mfma(c, ACT, DT, args.in[9], args.in[10], lo < 0);
#endif
                ssd_scan_mfma(c, ACT, DT, args.in[9], args.in[10], true); }
            else if constexpr (L == 1) { nsa_hidreduce(c, (const float*)(ws + WS_ACT), PB, NHID); if (IN(P0 + 3) && IN(P0 + 4)) xcd_barrier(bar); nsa_w2b(c, NHID, args.in[16], KCb, VCT);
#if PROBE == 11
                nsa_hidreduce(c, (const float*)(ws + WS_ACT), PB, NHID); if (IN(P0 + 3) && IN(P0 + 4)) xcd_barrier(bar); nsa_w2b(c, NHID, args.in[16], KCb, VCT);
#endif
            }
            else if constexpr (L == 2) sgu_spatial_mfma(c, PROJ, args.in[21], args.in[22], ACT);
            else { pg8::Prob S; S.init(POOLED, Wmx, 2048, 512, 512, 64, 8, c.G, cid); S.a_group_shift = 1; S.a_group_cols = 512; pg8::EpiP<StBf16Scale> E{{ACT, 2048, args.in[26]}, nullptr}; pg8::gemm_phase(c.lds, S, E); }
        }
        SEAM(P0 + 3);
        if (IN(P0 + 4)) {
            if constexpr (L == 0) ssd_gnorm(c, ACT, PROJ, args.in[11]);
            else if constexpr (L == 1) nsa_attn_cmp(c, NQ, KCb, VCT, NG, MF, SMg);
        }
        if constexpr (L <= 1) SEAM(P0 + 4);
        if (IN(P0 + 5)) {
            if constexpr (L == 1) { nsa_attn_sw(c, NQ, NT, NVT, NG, MF, (float*)(ws + WS_ACT + 64 * MiB), SMg, ACT);
#if PROBE == 1
                nsa_attn_sw(c, NQ, NT, NVT, NG, MF, (float*)(ws + WS_ACT + 64 * MiB), SMg, ACT);
#endif
            }
        }
        if constexpr (L == 1) SEAM(P0 + 5);
        if (IN(P0 + 6)) {
            if constexpr (L == 0) { pg8::Prob S; S.init(ACT, Wmo, 6144, 4096, 4096, 64, 8, c.G, cid); pg8::EpiP<StBf16> E{{MFb, 2048}, nullptr}; pg8::gemm_phase(c.lds, S, E); }
            else if constexpr (L == 2) { pg8::Prob S; S.init(ACT, Wmo, 4096, 4096, 4096, 64, 8, c.G, cid); pg8::EpiP<StBf16> E{{MFb, 2048}, nullptr}; pg8::gemm_phase(c.lds, S, E); }
            else { pg8::Prob S; S.init(ACT, Wmo, 2048, 2048, 2048, 64, 8, c.G, cid); pg8::EpiP<StBf16> E{{MFb, 2048}, nullptr}; pg8::gemm_phase(c.lds, S, E); }
        }
        SEAM(P0 + 6);
        if (IN(P0 + 7)) postnorm(c, MFb, XB, RS, norm_post + (L * 3 + 0) * DM, nullptr);
        SEAM(P0 + 7);
        if (IN(P0 + 8)) {
            { pg8::Prob S; S.init(XB, Wxq, 2048, 2048, 2048, 64, 2, c.G, cid); pg8::EpiP<StBf16> E{{XQ, 512}, RS}; pg8::gemm_phase(c.lds, S, E); }
            { pg8::Prob S; S.init(MEMN, Wxkv, 2048, 2048, 2048, 4, 4, c.G, (cid + c.G - 128) % c.G); pg8::EpiP<StKv> E{{KV, XVT}, nullptr}; pg8::gemm_phase(c.lds, S, E); }
            if (cid >= 144 && c.G == 256) { const int ga = (cid - 144) * 8 + c.wave; constexpr int NG_ = 112 * 8;
                if constexpr (L == 0) { conv_w(c, args.in[13], 2048, NSA_IN, NSA_NP, Wmi, norm_pre + ((L + 1) * 3) * DM, false, ga, NG_); conv_w(c, args.in[17], 2048, 2048, 2048, Wmo, nullptr, false, ga, NG_);
                    conv_w(c, args.in[15], 4096, 256, 256, Wmx, nullptr, false, ga, NG_); conv_w(c, args.in[15] + (size_t)4096 * 256, 4096, 256, 256, Wmx + (size_t)256 * 4096, nullptr, false, ga, NG_); }
                else if constexpr (L == 1) { conv_w(c, args.in[18], 2048, 8192, 8192, Wmi, norm_pre + ((L + 1) * 3) * DM, false, ga, NG_); conv_w(c, args.in[23], 4096, 2048, 2048, Wmo, nullptr, false, ga, NG_); }
                else if constexpr (L == 2) { conv_w(c, args.in[24], 2048, 2048, 2048, Wmi, norm_pre + ((L + 1) * 3) * DM, false, ga, NG_); conv_w(c, args.in[27], 2048, 2048, 2048, Wmo, nullptr, false, ga, NG_);
#pragma unroll 1
                    for (int g = 0; g < 4; ++g) conv_w(c, args.in[25] + (size_t)g * 512 * 512, 512, 512, 512, Wmx + (size_t)g * 512 * 512, nullptr, false, ga, NG_); }
            }
        }
        SEAM(P0 + 8);
        if (IN(P0 + 9)) xa_attn_fa(c, XQ, KV, XVT, XO);
        SEAM(P0 + 9);
        if (IN(P0 + 10)) { pg8::Prob S; S.init(XO, Wxo, 512, 512, 512, 64, 8, c.G, cid); pg8::EpiP<StBf16> E{{MFb, 2048}, nullptr}; pg8::gemm_phase(c.lds, S, E); }
        SEAM(P0 + 10);
        if (IN(P0 + 11)) postnorm(c, MFb, XB, RS, norm_post + (L * 3 + 1) * DM, nullptr);
        SEAM(P0 + 11);
        if (IN(P0 + 12)) { pg8::ProbR S; S.init(XB, Wup, 2048, 2048, 2048, 64, 44, c.G, cid); EpiFfn E{ACT, (bf16*)(ws + WS_SXT), RS, args.in[32] + (size_t)L * 3 * FF2, args.in[33] + (size_t)L * FF2}; pg8::gemm_phase(c.lds, S, E); }
        SEAM(P0 + 12);
        if (IN(P0 + 13)) ffn_fixup(c, (const bf16*)(ws + WS_SXT), args.in[32] + (size_t)L * 3 * FF2, args.in[33] + (size_t)L * FF2, ACT);
        SEAM(P0 + 13);
        if (IN(P0 + 14)) { pg8::Prob S; S.init(ACT, Wdn, FFH, FFH, FFH, 64, 8, c.G, cid); pg8::EpiP<StBf16> E{{MFb, 2048}, nullptr}; pg8::gemm_phase(c.lds, S, E); }
        SEAM(P0 + 14);
        if (IN(P0 + 15)) postnorm(c, MFb, XB, RS, norm_post + (L * 3 + 2) * DM, (L == 3) ? X : nullptr);
    }
#undef IN
#undef SEAM

__global__ void __launch_bounds__(512, 2) mega_fwd(Args args) {
    extern __shared__ __attribute__((aligned(16))) unsigned char lds_raw[];
    Ctx c; c.lds = (LAS unsigned char*)lds_raw; c.tid = threadIdx.x; c.lane = c.tid & 63; c.wave = __builtin_amdgcn_readfirstlane(c.tid >> 6);
    c.G = gridDim.x; { const int bx = blockIdx.x; c.vcu = (c.G % 8 == 0) ? (bx % 8) * (c.G / 8) + bx / 8 : bx; }
    c.gw = c.vcu * 8 + c.wave; c.NGW = c.G * 8;
    volatile LAS unsigned* MISC = (volatile LAS unsigned*)(c.lds + MISC_OFF);
    if (c.tid < 64) MISC[c.tid] = 0u;
    __syncthreads();
    unsigned char* ws = args.ws;
    unsigned* ctl = (unsigned*)(ws + WS_CTL);
    XcdBarrier bar; bar.bar = ctl + CW_BAR; bar.x = 0; bar.st = nullptr;
#if !MK_MULTI
    bar = xcd_barrier_post(ctl + CW_BAR, MISC + 8);
#endif
    const int lo = args.ph_lo, hi = args.ph_hi;
    layer_body<0>(c, args, bar, lo, hi);
    layer_body<1>(c, args, bar, lo, hi);
    layer_body<2>(c, args, bar, lo, hi);
    layer_body<3>(c, args, bar, lo, hi);
}

extern "C" void kernel_launch(void* const* d_in, const int* in_sizes, int n_in, void* d_out, int out_size, void* d_ws, size_t ws_size, hipStream_t stream) {
    static int grid = 0;
    if (grid == 0) {
        if (n_in != 35 || out_size != MT * DM || ws_size < WS_END) { fprintf(stderr, "kernel_launch: unexpected shapes: n_in %d out %d ws %zu (need %zu)\n", n_in, out_size, ws_size, (size_t)WS_END); grid = -1; return; }
        int dev = 0, cus = 0, per_cu = 0;
        if (hipGetDevice(&dev) != hipSuccess || hipDeviceGetAttribute(&cus, hipDeviceAttributeMultiprocessorCount, dev) != hipSuccess) { grid = -1; return; }
        if (hipFuncSetAttribute((const void*)mega_fwd, hipFuncAttributeMaxDynamicSharedMemorySize, LDS_BYTES) != hipSuccess) { fprintf(stderr, "kernel_launch: hipFuncSetAttribute failed\n"); grid = -1; return; }
        if (hipOccupancyMaxActiveBlocksPerMultiprocessor(&per_cu, (const void*)mega_fwd, 512, LDS_BYTES) != hipSuccess || per_cu < 1) { fprintf(stderr, "kernel_launch: occupancy query says %d\n", per_cu); grid = -1; return; }
        (void)hipGetLastError();
        if (cus < 256) { fprintf(stderr, "kernel_launch: needs >= 256 CUs (got %d)\n", cus); grid = -1; return; }
        grid = 256;
    }
    if (grid < 0) return;
    (void)hipMemsetAsync((char*)d_ws + WS_CTL, 0, CTL_ZERO_BYTES, stream);
    Args a{};
    for (int i = 0; i < 35; ++i) a.in[i] = (const float*)d_in[i];
    a.out = (float*)d_out; a.ws = (unsigned char*)d_ws;
#if MK_MULTI
    for (int p = 0; p < N_PHASES; ++p) { a.ph_lo = p; a.ph_hi = p + 1; hipLaunchKernelGGL(mega_fwd, dim3(grid), dim3(512), LDS_BYTES, stream, a); }
#else
    a.ph_lo = 0; a.ph_hi = N_PHASES;
    hipLaunchKernelGGL(mega_fwd, dim3(grid), dim3(512), LDS_BYTES, stream, a);
#endif
}
```

```cpp
#include <hip/hip_runtime.h>
#include <cstdio>
#include <cstdint>

#ifndef MK_MULTI
#define MK_MULTI 0
#endif
#ifndef PROBE
#define PROBE 0
#endif

#define GAS __attribute__((address_space(1)))
#define LAS __attribute__((address_space(3)))
typedef unsigned short bf16;
typedef unsigned v4u __attribute__((ext_vector_type(4)));
typedef unsigned v2u __attribute__((ext_vector_type(2)));
typedef float f32x4 __attribute__((ext_vector_type(4)));
typedef float f32x2 __attribute__((ext_vector_type(2)));
typedef short bf16x8 __attribute__((ext_vector_type(8)));
typedef short s16x4 __attribute__((ext_vector_type(4)));
#define LDS_WAIT() asm volatile("s_waitcnt lgkmcnt(0)" ::: "memory")

constexpr int DM = 2048, NB = 4, SEQ = 4096, MT = NB * SEQ;
constexpr int SSD_NP = 10496, SSD_IN = 10304;
constexpr int NSA_NP = 5376, NSA_IN = 5168;
constexpr int FFH = 5632, FF2 = 11264;
constexpr float EPS = 1e-6f;

constexpr size_t MiB = 1u << 20;
constexpr size_t WS_CTL = 0, CTL_ZERO_BYTES = 64 * 1024;
constexpr size_t WS_W = 1 * MiB;
constexpr size_t W_MIX_IN = WS_W + 0, W_MIX_OUT = WS_W + 44 * MiB, W_MIX_X = WS_W + 62 * MiB;
constexpr size_t W_XQ = WS_W + 68 * MiB, W_XKV = WS_W + 71 * MiB, W_XO = WS_W + 76 * MiB, W_UP = WS_W + 79 * MiB, W_DOWN = WS_W + 123 * MiB;
constexpr size_t WS_H = 148 * MiB;
constexpr size_t WS_PROJ = 212 * MiB;
constexpr size_t WS_ACT = 564 * MiB;
constexpr size_t WS_Q = 756 * MiB, WS_O = 772 * MiB, WS_KV = 788 * MiB, WS_MEMN = 790 * MiB, WS_DT = 794 * MiB, WS_PB = 798 * MiB;
constexpr size_t WS_SXT = 800 * MiB;
constexpr size_t WS_SBT = 928 * MiB;
constexpr size_t WS_END = 960 * MiB;
constexpr size_t WS_NQ = WS_PROJ + 128 * MiB;
constexpr size_t WS_NT = WS_NQ + 64 * MiB;
constexpr size_t NT_STRIDE = (size_t)16 * 4096 * 128;
constexpr size_t WS_NHID = WS_NT + 97 * MiB;
constexpr size_t WS_NKC = WS_NHID + 4 * MiB;
constexpr size_t WS_NG = WS_NKC + 4 * MiB;
constexpr size_t WS_NVT = WS_NG + 3 * MiB;
static_assert(WS_NVT + 32 * MiB <= WS_ACT, "nsa map");
constexpr size_t WS_XVT = 799 * MiB;
constexpr int CW_BAR = 4096;

constexpr int LDS_BYTES = 159744;
constexpr int MISC_OFF = LDS_BYTES - 256;

__device__ __forceinline__ unsigned f2bf(float f) { unsigned u = __builtin_bit_cast(unsigned, f); return (u + 0x7fffu + ((u >> 16) & 1u)) >> 16; }
__device__ __forceinline__ unsigned pk2(float lo, float hi) { return f2bf(lo) | (f2bf(hi) << 16); }
__device__ __forceinline__ float bflo(unsigned u) { return __builtin_bit_cast(float, u << 16); }
__device__ __forceinline__ float bfhi(unsigned u) { return __builtin_bit_cast(float, u & 0xffff0000u); }
__device__ __forceinline__ float wave_sum(float v) {
#pragma unroll
    for (int o = 1; o < 64; o <<= 1) v += __shfl_xor(v, o);
    return v;
}
__device__ __forceinline__ float wave_max(float v) {
#pragma unroll
    for (int o = 1; o < 64; o <<= 1) v = fmaxf(v, __shfl_xor(v, o));
    return v;
}
__device__ __forceinline__ float sigmoidf_(float x) { return 1.f / (1.f + __expf(-x)); }
__device__ __forceinline__ float silu_fast(float x) { return x * __builtin_amdgcn_rcpf(1.f + __builtin_amdgcn_exp2f(-1.4426950408889634f * x)); }
__device__ __forceinline__ float siluf_(float x) { return x * sigmoidf_(x); }
__device__ __forceinline__ float gelu_tanh(float x) { return x * __builtin_amdgcn_rcpf(1.f + __builtin_amdgcn_exp2f(x * __builtin_fmaf(-1.029432396e-01f, x * x, -2.302208198e+00f))); }

#define XB_TMO      128
#define XB_XCNT(j)  (256  + 64 * (j))
#define XB_XSUB(j)  (1280 + 64 * (j))
#define XB_XGEN(j)  (2304 + 64 * (j))
#define XB_TOP      3328
#define XB_TOPGEN   3392
#define XCD_BAR_WORDS 3456
#define XB_SPIN_CAP (1u << 22)

__device__ __forceinline__ unsigned xb_ld(unsigned* p)              { return __hip_atomic_load(p, __ATOMIC_RELAXED, __HIP_MEMORY_SCOPE_AGENT); }
__device__ __forceinline__ unsigned xb_add(unsigned* p, unsigned v) { return __hip_atomic_fetch_add(p, v, __ATOMIC_RELAXED, __HIP_MEMORY_SCOPE_AGENT); }
__device__ __forceinline__ unsigned xb_xcc_id() { return (unsigned)__builtin_amdgcn_s_getreg((3 << 11) | 20) & 0xFu; }
#define XB_SPIN(cond, bar) do { unsigned _sp = 0; while (cond) { __builtin_amdgcn_s_sleep(1); \
    if ((++_sp & 255u) == 0u) { if (xb_ld(&(bar)[XB_TMO])) break; if (_sp > XB_SPIN_CAP) { atomicAdd(&(bar)[XB_TMO], 1u); break; } } } } while (0)

struct XcdBarrier { unsigned* bar; unsigned x; volatile LAS unsigned* st; };

__device__ __forceinline__ XcdBarrier xcd_barrier_post(unsigned* bar, volatile LAS unsigned* st) {
    XcdBarrier b; b.bar = bar; b.x = xb_xcc_id(); b.st = st;
    if (threadIdx.x == 0) (void)xb_add(&bar[XB_XCNT(b.x)], 1u);
    return b;
}
__device__ __forceinline__ void xcd_barrier_complete(unsigned* bar, unsigned x, unsigned& nloc, unsigned& nx) {
    const unsigned G = gridDim.x * gridDim.y * gridDim.z;
    unsigned sum, cnt, mine, sp = 0u;
    for (;;) {
        sum = 0u; cnt = 0u; mine = 0u;
#pragma unroll
        for (unsigned j = 0; j < 16; ++j) { const unsigned c = xb_ld(&bar[XB_XCNT(j)]); sum += c; cnt += (c > 0u) ? 1u : 0u; mine = (j == x) ? c : mine; }
        if (sum == G) break;
        __builtin_amdgcn_s_sleep(1);
        if ((++sp & 255u) == 0u) { if (xb_ld(&bar[XB_TMO])) break; if (sp > XB_SPIN_CAP) { atomicAdd(&bar[XB_TMO], 1u); break; } }
    }
    nloc = mine > 0u ? mine : 1u; nx = cnt > 0u ? cnt : 1u;
}
__device__ __forceinline__ void xcd_barrier(const XcdBarrier& b) {
    asm volatile("s_waitcnt vmcnt(0)" ::: "memory");
    __syncthreads();
    if (threadIdx.x == 0) {
        unsigned* bar = b.bar;
        __builtin_amdgcn_s_waitcnt(0);
        unsigned nloc = b.st[0], nx = b.st[1];
        if (nloc == 0u) { xcd_barrier_complete(bar, b.x, nloc, nx); b.st[0] = nloc; b.st[1] = nx; }
        const unsigned old = xb_add(&bar[XB_XSUB(b.x)], 1u);
        const unsigned gen = old / nloc;
        if (old + 1u == (gen + 1u) * nloc) {
            __builtin_amdgcn_fence(__ATOMIC_RELEASE, "agent");
            asm volatile("s_waitcnt vmcnt(0)" ::: "memory");
            const unsigned og = xb_add(&bar[XB_TOP], 1u);
            const unsigned tg = og / nx;
            if (og + 1u == (tg + 1u) * nx) xb_add(&bar[XB_TOPGEN], 1u);
            else XB_SPIN(xb_ld(&bar[XB_TOPGEN]) == tg, bar);
            __builtin_amdgcn_fence(__ATOMIC_ACQUIRE, "agent");
            xb_add(&bar[XB_XGEN(b.x)], 1u);
            asm volatile("s_waitcnt vmcnt(0)" ::: "memory");
        } else {
            XB_SPIN(xb_ld(&bar[XB_XGEN(b.x)]) == gen, bar);
            __builtin_amdgcn_fence(__ATOMIC_ACQUIRE, "agent");
            asm volatile("s_waitcnt vmcnt(0)" ::: "memory");
        }
    }
    __syncthreads();
}

namespace pg8 {
constexpr int BM = 256, BK = 64, HALF = 128, HTB = HALF * BK * 2, STAGE_BYTES = 8 * HTB, NXCD = 8, WGM = 8;
__device__ __forceinline__ int lds_byte(int r, int c) { const int st = (r >> 4) * 2 + (c >> 5), rr = r & 15, cc = c & 31, ob = rr * 64 + cc * 2; return st * 1024 + (ob ^ (((ob >> 9) & 1) << 5)); }
__device__ __forceinline__ void stage_rc(int b, int& R, int& C) { const int st = b / 1024, sb = b % 1024, swz = sb ^ (((sb >> 9) & 1) << 5); R = (st >> 1) * 16 + swz / 64; C = (st & 1) * 32 + (swz % 64) / 2; }
__device__ __forceinline__ int perm32(int rho) { const int n = rho >> 4, i = rho & 15; return 8 * (i >> 2) + 4 * n + (i & 3); }
struct Unit { int pm, pn; };
struct Prob {
    static constexpr bool ROWPERM = false;
    const bf16* A; const bf16* Bt; int lda, ldb, K, nM, nN, G, c; int a_group_shift, a_group_cols;
    size_t a_tile_stride, b_tile_stride;
    __device__ __forceinline__ void init(const bf16* A_, const bf16* Bt_, int lda_, int ldb_, int K_, int nM_, int nN_, int G_, int c_) {
        A = A_; Bt = Bt_; lda = lda_; ldb = ldb_; K = K_; nM = nM_; nN = nN_; G = G_; c = c_; a_group_shift = 0; a_group_cols = 0; a_tile_stride = (size_t)256 * lda_; b_tile_stride = (size_t)256 * ldb_; }
    __device__ __forceinline__ bool next(int i, Unit& u) const {
        const int nwg = nM * nN; const long L = (long)i * G + c; if (L >= nwg) return false;
        int wgid = (int)L; { const int q = nwg / NXCD, r = nwg % NXCD, xcd = wgid % NXCD, off = wgid / NXCD; wgid = (xcd < r ? xcd * (q + 1) : r * (q + 1) + (xcd - r) * q) + off; }
        const int nig = WGM * nN, gid = wgid / nig, fm = gid * WGM, gsz = (nM - fm) < WGM ? (nM - fm) : WGM;
        u.pm = fm + ((wgid % nig) % gsz); u.pn = (wgid % nig) / gsz; return true;
    }
    __device__ __forceinline__ const char* pa(const Unit& u) const { return (const char*)(A + (size_t)u.pm * a_tile_stride + (size_t)((u.pn >> a_group_shift) * a_group_cols)); }
    __device__ __forceinline__ const char* pb(const Unit& u) const { return (const char*)(Bt + (size_t)u.pn * b_tile_stride); }
};
struct ProbR : Prob { static constexpr bool ROWPERM = true; };
struct ProbSplit : Prob { int nA, nB;
    __device__ __forceinline__ bool next(int i, Unit& u) const {
        const int nwg = nM * nN, a = (c & 7) | ((c >> 4) << 3), grp = (c >> 3) & 1;
        if (i >= (grp ? nB : nA)) return false;
        const int L = (grp ? 128 * nA : 0) + i * 128 + a; if (L >= nwg) return false;
        int wgid = L; { const int q = nwg / NXCD, r = nwg % NXCD, xcd = wgid % NXCD, off = wgid / NXCD; wgid = (xcd < r ? xcd * (q + 1) : r * (q + 1) + (xcd - r) * q) + off; }
        const int nig = WGM * nN, gid = wgid / nig, fm = gid * WGM, gsz = (nM - fm) < WGM ? (nM - fm) : WGM;
        u.pm = fm + ((wgid % nig) % gsz); u.pn = (wgid % nig) / gsz; return true;
    } };
struct ProbC : Prob {
    __device__ __forceinline__ const char* pa(const Unit& u) const { return (const char*)(A + (size_t)u.pm * a_tile_stride + (size_t)u.pn * 512); }
    __device__ __forceinline__ const char* pb(const Unit& u) const { return (const char*)(Bt + (size_t)(u.pm >> 4) * 256 * 4096 + (size_t)u.pn * 512); } };
__device__ __forceinline__ unsigned cvt_pk_bf16(float lo, float hi) { unsigned r; asm volatile("v_cvt_pk_bf16_f32 %0, %1, %2" : "=v"(r) : "v"(lo), "v"(hi)); return r; }

template <class F> struct EpiP {
    static constexpr bool PERM = true; F f; const float* rowscale;
    __device__ __forceinline__ void operator()(const f32x4 (&acc)[2][2][4][2], const Unit& u, int wr, int wc, int fr, int fq) const {
        const int row0 = u.pm * BM + wr * 64 + fr, col0 = u.pn * BM + wc * 32 + 8 * fq;
#pragma unroll
        for (int ai = 0; ai < 2; ++ai)
#pragma unroll
            for (int m = 0; m < 4; ++m) { const int row = row0 + ai * HALF + m * 16; const float rs = rowscale ? rowscale[row] : 1.f;
#pragma unroll
                for (int bj = 0; bj < 2; ++bj) f(row, col0 + bj * HALF, acc[ai][bj][m][0] * rs, acc[ai][bj][m][1] * rs); }
    }
};
template <class F> struct EpiN {
    static constexpr bool PERM = false; F f; const float* rowscale;
    __device__ __forceinline__ void operator()(const f32x4 (&acc)[2][2][4][2], const Unit& u, int wr, int wc, int fr, int fq) const {
        const int row0 = u.pm * BM + wr * 64 + fr, col0 = u.pn * BM + wc * 32 + 4 * fq;
#pragma unroll
        for (int ai = 0; ai < 2; ++ai)
#pragma unroll
            for (int m = 0; m < 4; ++m) { const int row = row0 + ai * HALF + m * 16; const float rs = rowscale ? rowscale[row] : 1.f;
#pragma unroll
                for (int bj = 0; bj < 2; ++bj)
#pragma unroll
                    for (int n = 0; n < 2; ++n) f(row, col0 + bj * HALF + n * 16, acc[ai][bj][m][n] * rs); }
    }
};

#ifndef GEMM_REP
#define GEMM_REP 1
#endif
template <class PT, class Epi> __device__ __forceinline__ void gemm_phase_once(LAS unsigned char* lds, const PT& S, const Epi& E, bool epi_on);
template <class PT, class Epi>
__device__ __forceinline__ void gemm_phase(LAS unsigned char* lds, const PT& S, const Epi& E) {
    gemm_phase_once(lds, S, E, true);
}
template <class PT, class Epi>
__device__ __forceinline__ void gemm_phase_once(LAS unsigned char* lds, const PT& S, const Epi& E, bool epi_on) {
    const int tid = threadIdx.x, wid = __builtin_amdgcn_readfirstlane(tid >> 6), lane = tid & 63, wr = wid >> 2, wc = wid & 3, fr = lane & 15, fq = lane >> 4;
    const int K = S.K, nt = K / BK, lda = S.lda, ldb = S.ldb;
    unsigned voffA[2], voffB[2];
#pragma unroll
    for (int i = 0; i < 2; ++i) { int R, C; stage_rc(tid * 16 + i * 8192, R, C); const int Rb = Epi::PERM ? ((R & ~31) + perm32(R & 31)) : R;
        const int Ra = PT::ROWPERM ? (128 * (R >> 6) + 8 * (R & 15) + ((R >> 4) & 3)) : R;
        voffA[i] = (unsigned)(Ra * lda + C) * 2u; voffB[i] = (unsigned)(Rb * ldb + C) * 2u; }
    const size_t kstep = (size_t)(BK * 2);
    const size_t hstepA = (size_t)(PT::ROWPERM ? 4 : HALF) * lda * 2, hstepB = (size_t)HALF * ldb * 2;
    const unsigned ldsw = (unsigned)wid * 1024u;
    const int aoff = lds_byte(wr * 64 + fr, fq * 8), boff = lds_byte(wc * 32 + fr, fq * 8);
#define PG8_SA(b, h) (((b) * 2 + (h)) * HTB)
#define PG8_SB(b, h) ((4 + (b) * 2 + (h)) * HTB)
#define PG8_STAGE(bufoff, gbase, voff) do { _Pragma("unroll") for (int _i = 0; _i < 2; ++_i) \
        __builtin_amdgcn_global_load_lds((const unsigned*)((const char*)(gbase) + (voff)[_i]), (LAS unsigned*)(lds + (bufoff) + ldsw + _i * 8192), 16, 0, 0); } while (0)
#define PG8_LDA(dst, b, h) do { _Pragma("unroll") for (int m = 0; m < 4; ++m) _Pragma("unroll") for (int k = 0; k < 2; ++k) dst[m][k] = *(const LAS bf16x8*)(lds + PG8_SA(b, h) + aoff + m * 2048 + k * 1024); } while (0)
#define PG8_LDB(dst, b, h) do { _Pragma("unroll") for (int n = 0; n < 2; ++n) _Pragma("unroll") for (int k = 0; k < 2; ++k) dst[n][k] = *(const LAS bf16x8*)(lds + PG8_SB(b, h) + boff + n * 2048 + k * 1024); } while (0)
#define PG8_MMA(ai, bj, At, Bt) do { __builtin_amdgcn_s_setprio(1); _Pragma("unroll") for (int m = 0; m < 4; ++m) _Pragma("unroll") for (int n = 0; n < 2; ++n) _Pragma("unroll") for (int k = 0; k < 2; ++k) \
        acc[ai][bj][m][n] = __builtin_amdgcn_mfma_f32_16x16x32_bf16(Bt[n][k], At[m][k], acc[ai][bj][m][n], 0, 0, 0); __builtin_amdgcn_s_setprio(0); } while (0)
#define PG8_WAIT_V(n) asm volatile("s_waitcnt vmcnt(" #n ")" ::: "memory")
#define PG8_WAIT_L(n) asm volatile("s_waitcnt lgkmcnt(" #n ")" ::: "memory")
#define PG8_BAR __builtin_amdgcn_s_barrier()
#define PG8_SCHED __builtin_amdgcn_sched_barrier(0)
    Unit cur, nxt; int ui = 0;
    if (!S.next(0, cur)) return;
    f32x4 acc[2][2][4][2];
#pragma unroll
    for (int a = 0; a < 2; ++a)
#pragma unroll
        for (int b = 0; b < 2; ++b)
#pragma unroll
            for (int m = 0; m < 4; ++m)
#pragma unroll
                for (int n = 0; n < 2; ++n) acc[a][b][m][n] = (f32x4){0.f, 0.f, 0.f, 0.f};
    bf16x8 At[4][2], B0[2][2], B1[2][2];
    const char* cA = S.pa(cur); const char* cB = S.pb(cur);
    PG8_STAGE(PG8_SB(0, 0), cB, voffB); PG8_STAGE(PG8_SA(0, 0), cA, voffA); PG8_STAGE(PG8_SB(0, 1), cB + hstepB, voffB); PG8_STAGE(PG8_SA(0, 1), cA + hstepA, voffA);
    if (wr == 1) PG8_BAR;
    PG8_WAIT_V(4); PG8_BAR;
    PG8_STAGE(PG8_SB(1, 0), cB + kstep, voffB); PG8_STAGE(PG8_SA(1, 0), cA + kstep, voffA); PG8_STAGE(PG8_SB(1, 1), cB + hstepB + kstep, voffB);
    PG8_WAIT_V(6); PG8_BAR;
    for (;;) {
        const bool has_next = S.next(ui + 1, nxt);
        const char* nA = has_next ? S.pa(nxt) : cA; const char* nB = has_next ? S.pb(nxt) : cB;
        for (int t = 0; t < nt; t += 2) {
            const bool last = (t == nt - 2);
            const char* a1 = cA + (size_t)(t + 1) * kstep;
            const char* a2 = last ? nA : cA + (size_t)(t + 2) * kstep; const char* b2 = last ? nB : cB + (size_t)(t + 2) * kstep;
            const char* a3 = a2 + kstep; const char* b3 = b2 + kstep;
            PG8_LDB(B0, 0, 0); PG8_SCHED; PG8_LDA(At, 0, 0); PG8_STAGE(PG8_SA(1, 1), a1 + hstepA, voffA);
            PG8_WAIT_L(8); PG8_BAR; PG8_WAIT_L(0); PG8_MMA(0, 0, At, B0); PG8_BAR; PG8_SCHED;
            PG8_LDB(B1, 0, 1); PG8_STAGE(PG8_SB(0, 0), b2, voffB);
            PG8_BAR; PG8_WAIT_L(0); PG8_MMA(0, 1, At, B1); PG8_BAR;
            PG8_LDA(At, 0, 1); PG8_STAGE(PG8_SA(0, 0), a2, voffA);
            PG8_BAR; PG8_WAIT_L(0); PG8_MMA(1, 0, At, B0); PG8_BAR; PG8_SCHED;
            PG8_STAGE(PG8_SB(0, 1), b2 + hstepB, voffB);
            PG8_WAIT_V(6); PG8_BAR; PG8_MMA(1, 1, At, B1); PG8_BAR;
            PG8_LDB(B0, 1, 0); PG8_SCHED; PG8_LDA(At, 1, 0); PG8_STAGE(PG8_SA(0, 1), a2 + hstepA, voffA);
            PG8_WAIT_L(8); PG8_BAR; PG8_WAIT_L(0); PG8_MMA(0, 0, At, B0); PG8_BAR; PG8_SCHED;
            PG8_LDB(B1, 1, 1); PG8_STAGE(PG8_SB(1, 0), b3, voffB);
            PG8_BAR; PG8_WAIT_L(0); PG8_MMA(0, 1, At, B1); PG8_BAR;
            PG8_LDA(At, 1, 1); PG8_STAGE(PG8_SA(1, 0), a3, voffA);
            PG8_BAR; PG8_WAIT_L(0); PG8_MMA(1, 0, At, B0); PG8_BAR; PG8_SCHED;
            PG8_STAGE(PG8_SB(1, 1), b3 + hstepB, voffB);
            PG8_WAIT_V(6); PG8_BAR; PG8_MMA(1, 1, At, B1); PG8_BAR;
        }
        if (epi_on) E(acc, cur, wr, wc, fr, fq);
        if (!has_next) break;
#pragma unroll
        for (int a = 0; a < 2; ++a)
#pragma unroll
            for (int b = 0; b < 2; ++b)
#pragma unroll
                for (int m = 0; m < 4; ++m)
#pragma unroll
                    for (int n = 0; n < 2; ++n) acc[a][b][m][n] = (f32x4){0.f, 0.f, 0.f, 0.f};
        cur = nxt; cA = nA; cB = nB; ++ui;
    }
    PG8_WAIT_V(0);
    if (wr == 0) PG8_BAR;
    PG8_BAR;
#undef PG8_SA
#undef PG8_SB
#undef PG8_STAGE
#undef PG8_LDA
#undef PG8_LDB
#undef PG8_MMA
#undef PG8_WAIT_V
#undef PG8_WAIT_L
#undef PG8_BAR
#undef PG8_SCHED
}
}

typedef const f32x4 __attribute__((address_space(4)))* CF4;
struct StBf16 { bf16* O; int ldc;
    __device__ __forceinline__ void operator()(int row, int col, f32x4 v0, f32x4 v1) const {
        v4u w; w.x = pg8::cvt_pk_bf16(v0[0], v0[1]); w.y = pg8::cvt_pk_bf16(v0[2], v0[3]); w.z = pg8::cvt_pk_bf16(v1[0], v1[1]); w.w = pg8::cvt_pk_bf16(v1[2], v1[3]);
        *(v4u*)(O + (size_t)row * ldc + col) = w; } };
struct StBf16BiasGelu { bf16* O; int ldc; const float* bias;
    __device__ __forceinline__ void operator()(int row, int col, f32x4 v0, f32x4 v1) const {
        const f32x4 b0 = *(CF4)(bias + col), b1 = *(CF4)(bias + col + 4);
#pragma unroll
        for (int j = 0; j < 4; ++j) { v0[j] = gelu_tanh(v0[j] + b0[j]); v1[j] = gelu_tanh(v1[j] + b1[j]); }
        v4u w; w.x = pg8::cvt_pk_bf16(v0[0], v0[1]); w.y = pg8::cvt_pk_bf16(v0[2], v0[3]); w.z = pg8::cvt_pk_bf16(v1[0], v1[1]); w.w = pg8::cvt_pk_bf16(v1[2], v1[3]);
        *(v4u*)(O + (size_t)row * ldc + col) = w; } };
struct StBf16Scale { bf16* O; int ldc; const float* scale;
    __device__ __forceinline__ void operator()(int row, int col, f32x4 v0, f32x4 v1) const {
        const f32x4 b0 = *(CF4)(scale + col), b1 = *(CF4)(scale + col + 4);
        v0 = v0 * b0; v1 = v1 * b1;
        v4u w; w.x = pg8::cvt_pk_bf16(v0[0], v0[1]); w.y = pg8::cvt_pk_bf16(v0[2], v0[3]); w.z = pg8::cvt_pk_bf16(v1[0], v1[1]); w.w = pg8::cvt_pk_bf16(v1[2], v1[3]);
        *(v4u*)(O + (size_t)row * ldc + col) = w; } };
struct StF32 { float* C; int ldc;
    __device__ __forceinline__ void operator()(int row, int col, f32x4 v) const { *(f32x4*)(C + (size_t)row * ldc + col) = v; } };
struct StNsa { bf16* Q; bf16* T; float* Gt;
    __device__ __forceinline__ void operator()(int row, int col, f32x4 v0, f32x4 v1) const {
        v4u w; w.x = pg8::cvt_pk_bf16(v0[0], v0[1]); w.y = pg8::cvt_pk_bf16(v0[2], v0[3]); w.z = pg8::cvt_pk_bf16(v1[0], v1[1]); w.w = pg8::cvt_pk_bf16(v1[2], v1[3]);
        if (col < 2048) { *(v4u*)(Q + (size_t)row * 2048 + col) = w; }
        else if (col < 5120) { const int c2 = col - 2048, ten = c2 >> 9, g = (c2 >> 7) & 3, d = c2 & 127, b = row >> 12, t = row & 4095;
            *(v4u*)(T + (size_t)ten * NT_STRIDE + ((size_t)((b * 4 + g) * 4096 + t)) * 128 + d) = w; }
        else if (col < 5168) { float* p = Gt + (size_t)row * 48 + (col - 5120); *(f32x4*)p = v0; *(f32x4*)(p + 4) = v1; }
    } };
struct StKv { bf16* KV; bf16* XVT;
    __device__ __forceinline__ void operator()(int row, int col, f32x4 v0, f32x4 v1) const {
        if (col < 512) { v4u w; w.x = pg8::cvt_pk_bf16(v0[0], v0[1]); w.y = pg8::cvt_pk_bf16(v0[2], v0[3]); w.z = pg8::cvt_pk_bf16(v1[0], v1[1]); w.w = pg8::cvt_pk_bf16(v1[2], v1[3]); *(v4u*)(KV + (size_t)row * 1024 + col) = w; }
        else { const int c2 = col - 512, b = row >> 8, m = row & 255; bf16* p = XVT + ((size_t)(b * 4 + (c2 >> 7)) * 128 + (c2 & 127)) * 256 + m;
#pragma unroll
            for (int j = 0; j < 4; ++j) { p[(size_t)j * 256] = (bf16)f2bf(v0[j]); p[(size_t)(4 + j) * 256] = (bf16)f2bf(v1[j]); } }
    } };
struct StHid { bf16* O; const float* pb;
    __device__ __forceinline__ void operator()(int row, int col, f32x4 v0, f32x4 v1) const {
        const int ten = row >> 12; const float* bias = pb + ten * 256 + col;
        const f32x4 b0 = *(const f32x4*)(bias), b1 = *(const f32x4*)(bias + 4);
#pragma unroll
        for (int j = 0; j < 4; ++j) { v0[j] = gelu_tanh(v0[j] + b0[j]); v1[j] = gelu_tanh(v1[j] + b1[j]); }
        v4u w; w.x = pg8::cvt_pk_bf16(v0[0], v0[1]); w.y = pg8::cvt_pk_bf16(v0[2], v0[3]); w.z = pg8::cvt_pk_bf16(v1[0], v1[1]); w.w = pg8::cvt_pk_bf16(v1[2], v1[3]);
        *(v4u*)(O + (size_t)row * 256 + col) = w; } };

struct Ctx { LAS unsigned char* lds; int tid, lane, wave, vcu, G, gw, NGW; };
__device__ __forceinline__ float dpp_shr1(float x) { return __builtin_bit_cast(float, __builtin_amdgcn_update_dpp(0, __builtin_bit_cast(int, x), 0x111, 0xf, 0xf, true)); }
struct EpiFfn {
    static constexpr bool PERM = true;
    bf16* ACT; bf16* HALO; const float* RS; const float* cw; const float* cb;
    __device__ __forceinline__ void operator()(const f32x4 (&acc)[2][2][4][2], const pg8::Unit& u, int wr, int wc, int fr, int fq) const {
        const int ch0 = 128 * u.pn + 32 * wc + 8 * fq, tok0 = 256 * u.pm + 128 * wr + 8 * fr;
        const f32x4 r0 = *(const f32x4*)(RS + tok0), r1 = *(const f32x4*)(RS + tok0 + 4);
        bf16* hb = HALO + ((size_t)((u.pm * 44 + u.pn) * 2 + wr) * 4) * 256 + 32 * wc + 8 * fq;
#pragma unroll
        for (int n = 0; n < 2; ++n) {
            float g[8][4], v[8][4];
#pragma unroll
            for (int e = 0; e < 8; ++e) { const float rs = (e < 4) ? r0[e & 3] : r1[e & 3];
#pragma unroll
                for (int jj = 0; jj < 4; ++jj) { g[e][jj] = acc[e >> 2][0][e & 3][n][jj] * rs; v[e][jj] = acc[e >> 2][1][e & 3][n][jj] * rs; } }
            if (fr == 0) {
#pragma unroll
                for (int q = 0; q < 2; ++q) { v2u a, b; a.x = pk2(g[q][0], g[q][1]); a.y = pk2(g[q][2], g[q][3]); b.x = pk2(v[q][0], v[q][1]); b.y = pk2(v[q][2], v[q][3]);
                    *(v2u*)(hb + (size_t)q * 256 + 4 * n) = a; *(v2u*)(hb + (size_t)q * 256 + 128 + 4 * n) = b; } }
            if (fr == 15) {
#pragma unroll
                for (int q = 0; q < 2; ++q) { v2u a, b; a.x = pk2(g[6 + q][0], g[6 + q][1]); a.y = pk2(g[6 + q][2], g[6 + q][3]); b.x = pk2(v[6 + q][0], v[6 + q][1]); b.y = pk2(v[6 + q][2], v[6 + q][3]);
                    *(v2u*)(hb + (size_t)(2 + q) * 256 + 4 * n) = a; *(v2u*)(hb + (size_t)(2 + q) * 256 + 128 + 4 * n) = b; } }
            const int cc = ch0 + 4 * n;
            const f32x4 wg0 = *(CF4)(cw + cc), wg1 = *(CF4)(cw + FF2 + cc), wg2 = *(CF4)(cw + 2 * FF2 + cc), wv0 = *(CF4)(cw + FFH + cc), wv1 = *(CF4)(cw + FF2 + FFH + cc), wv2 = *(CF4)(cw + 2 * FF2 + FFH + cc);
            const f32x4 bg = *(CF4)(cb + cc), bv = *(CF4)(cb + FFH + cc);
#pragma unroll
            for (int jj = 0; jj < 4; ++jj) {
                float g2 = dpp_shr1(g[6][jj]), g1 = dpp_shr1(g[7][jj]), v2 = dpp_shr1(v[6][jj]), v1 = dpp_shr1(v[7][jj]);
#pragma unroll
                for (int e = 0; e < 8; ++e) { const float g0 = g[e][jj], v0 = v[e][jj];
                    const float cg = bg[jj] + wg0[jj] * g2 + wg1[jj] * g1 + wg2[jj] * g0, cv = bv[jj] + wv0[jj] * v2 + wv1[jj] * v1 + wv2[jj] * v0;
                    g[e][jj] = silu_fast(cg) * cv; g2 = g1; g1 = g0; v2 = v1; v1 = v0; } }
#pragma unroll
            for (int e = 0; e < 8; ++e) { v2u w; w.x = pk2(g[e][0], g[e][1]); w.y = pk2(g[e][2], g[e][3]); *(v2u*)(ACT + (size_t)(tok0 + e) * FFH + cc) = w; }
        }
    }
};
__device__ __forceinline__ void ffn_fixup(const Ctx& c, const bf16* HALO, const float* cw, const float* cb, bf16* ACT) {
    for (int it = c.vcu * 512 + c.tid; it < 64 * 44 * 2 * 16; it += c.G * 512) {
        const int cg8 = it & 15, wr = (it >> 4) & 1, tile = it >> 5, pm = tile / 44, pn = tile % 44, ch0 = 128 * pn + 8 * cg8;
        const bf16* cur = HALO + ((size_t)(tile * 2 + wr) * 4) * 256 + 8 * cg8;
        const bool hasprev = wr == 1 || (pm & 15) != 0; const bf16* prv = wr == 1 ? HALO + ((size_t)(tile * 2) * 4 + 2) * 256 + 8 * cg8 : HALO + ((size_t)((tile - 44) * 2 + 1) * 4 + 2) * 256 + 8 * cg8;
        const v4u z4 = (v4u){0u, 0u, 0u, 0u};
        const v4u cg0 = *(const v4u*)cur, cv0 = *(const v4u*)(cur + 128), cg1 = *(const v4u*)(cur + 256), cv1 = *(const v4u*)(cur + 256 + 128);
        const v4u pg2 = hasprev ? *(const v4u*)prv : z4, pv2 = hasprev ? *(const v4u*)(prv + 128) : z4, pg3 = hasprev ? *(const v4u*)(prv + 256) : z4, pv3 = hasprev ? *(const v4u*)(prv + 256 + 128) : z4;
        float oa[8], ob[8];
#pragma unroll
        for (int j = 0; j < 8; ++j) { const int q = j >> 1; const bool hi = j & 1;
            const float wg0 = cw[ch0 + j], wg1 = cw[FF2 + ch0 + j], wg2 = cw[2 * FF2 + ch0 + j], wv0 = cw[FFH + ch0 + j], wv1 = cw[FF2 + FFH + ch0 + j], wv2 = cw[2 * FF2 + FFH + ch0 + j], bg = cb[ch0 + j], bv = cb[FFH + ch0 + j];
            const float gA2 = hi ? bfhi(pg2[q]) : bflo(pg2[q]), gA1 = hi ? bfhi(pg3[q]) : bflo(pg3[q]), gA0 = hi ? bfhi(cg0[q]) : bflo(cg0[q]), gB0 = hi ? bfhi(cg1[q]) : bflo(cg1[q]);
            const float vA2 = hi ? bfhi(pv2[q]) : bflo(pv2[q]), vA1 = hi ? bfhi(pv3[q]) : bflo(pv3[q]), vA0 = hi ? bfhi(cv0[q]) : bflo(cv0[q]), vB0 = hi ? bfhi(cv1[q]) : bflo(cv1[q]);
            oa[j] = siluf_(bg + wg0 * gA2 + wg1 * gA1 + wg2 * gA0) * (bv + wv0 * vA2 + wv1 * vA1 + wv2 * vA0);
            ob[j] = siluf_(bg + wg0 * gA1 + wg1 * gA0 + wg2 * gB0) * (bv + wv0 * vA1 + wv1 * vA0 + wv2 * vB0); }
        const size_t tok = (size_t)256 * pm + 128 * wr;
        v4u w; w.x = pk2(oa[0], oa[1]); w.y = pk2(oa[2], oa[3]); w.z = pk2(oa[4], oa[5]); w.w = pk2(oa[6], oa[7]); *(v4u*)(ACT + tok * FFH + ch0) = w;
        w.x = pk2(ob[0], ob[1]); w.y = pk2(ob[2], ob[3]); w.z = pk2(ob[4], ob[5]); w.w = pk2(ob[6], ob[7]); *(v4u*)(ACT + (tok + 1) * FFH + ch0) = w;
    }
}


__device__ __forceinline__ void conv_w(const Ctx& c, const float* W, int K, int N, int Npad, bf16* WT, const float* gain = nullptr, bool ffnmap = false, int gw_ = -1, int ngw_ = 0) {
    LAS float* scr = (LAS float*)(c.lds + c.wave * 16640);
    const int nblk = Npad / 64, items = (K / 64) * nblk, lane = c.lane;
#if PROBE == 5
#pragma unroll 1
    for (int rep_ = 0; rep_ < 2; ++rep_)
#endif
    const int gw0 = gw_ >= 0 ? gw_ : c.gw, ngw = gw_ >= 0 ? ngw_ : c.NGW;
    for (int it = gw0; it < items; it += ngw) {
        const int kb = it / nblk, nb = it % nblk, k0 = 64 * kb, n0 = 64 * nb, nq = (lane & 15) * 4, kr = lane >> 4; const bool ok = (n0 + nq) < N;
        f32x4 v[16];
#pragma unroll
        for (int i = 0; i < 16; ++i) v[i] = ok ? __builtin_nontemporal_load((const f32x4*)(W + (size_t)(k0 + 4 * i + kr) * N + n0 + nq)) : (f32x4){0.f, 0.f, 0.f, 0.f};
        if (gain) {
#pragma unroll
            for (int i = 0; i < 16; ++i) v[i] *= gain[k0 + 4 * i + kr]; }
#pragma unroll
        for (int i = 0; i < 16; ++i) { LAS float* d = scr + (4 * i + kr) * 65 + nq; d[0] = v[i].x; d[1] = v[i].y; d[2] = v[i].z; d[3] = v[i].w; }
        LDS_WAIT(); asm volatile("" ::: "memory");
        const int c8 = lane & 7; int d0 = n0;
        if (ffnmap) { const int bj = n0 >= FFH ? 1 : 0, chn = n0 - FFH * bj; d0 = 256 * (chn >> 7) + 128 * bj + (chn & 127); }
#pragma unroll
        for (int j = 0; j < 8; ++j) { const int n = (lane >> 3) + 8 * j; const LAS float* sp = scr + (8 * c8) * 65 + n;
            v4u o; o.x = pk2(sp[0 * 65], sp[1 * 65]); o.y = pk2(sp[2 * 65], sp[3 * 65]); o.z = pk2(sp[4 * 65], sp[5 * 65]); o.w = pk2(sp[6 * 65], sp[7 * 65]);
            *(v4u*)(WT + (size_t)(d0 + n) * K + k0 + 8 * c8) = o; }
        LDS_WAIT(); asm volatile("" ::: "memory");
    }
}

__device__ __forceinline__ void rms_row_bf16(const Ctx& c, const float* xrow, const float* gain, bf16* orow, float* copy) {
    const f32x4* xr = (const f32x4*)xrow + c.lane; f32x4 v[8]; float s = 0.f;
#pragma unroll
    for (int j = 0; j < 8; ++j) { v[j] = xr[64 * j]; s += (v[j].x * v[j].x + v[j].y * v[j].y) + (v[j].z * v[j].z + v[j].w * v[j].w); }
    const float rs = rsqrtf(wave_sum(s) * (1.f / DM) + EPS);
    if (copy) {
#pragma unroll
        for (int j = 0; j < 8; ++j) ((f32x4*)copy + c.lane)[64 * j] = v[j]; }
    const f32x4* gr = (const f32x4*)gain + c.lane; v2u* o8 = (v2u*)orow + c.lane;
#pragma unroll
    for (int j = 0; j < 8; ++j) { const f32x4 g = gr[64 * j]; v2u o; o.x = pk2(v[j].x * rs * g.x, v[j].y * rs * g.y); o.y = pk2(v[j].z * rs * g.z, v[j].w * rs * g.w); o8[64 * j] = o; }
}
__device__ __forceinline__ void postnorm(const Ctx& c, const bf16* MF, bf16* XB, float* RS, const float* gpost, float* OUT) {
    for (int row = c.gw; row < MT; row += c.NGW) {
        const v4u* mr = (const v4u*)(MF + (size_t)row * DM) + c.lane; v4u* xr = (v4u*)(XB + (size_t)row * DM) + c.lane;
        v4u mv[4], xv[4]; float v[4][8]; float s = 0.f;
#pragma unroll
        for (int j = 0; j < 4; ++j) { mv[j] = mr[64 * j]; xv[j] = xr[64 * j]; }
#pragma unroll
        for (int j = 0; j < 4; ++j)
#pragma unroll
            for (int k = 0; k < 4; ++k) { v[j][2 * k] = bflo(mv[j][k]); v[j][2 * k + 1] = bfhi(mv[j][k]); s += v[j][2 * k] * v[j][2 * k] + v[j][2 * k + 1] * v[j][2 * k + 1]; }
        const float rs = rsqrtf(wave_sum(s) * (1.f / DM) + EPS);
        float s2 = 0.f;
#pragma unroll
        for (int j = 0; j < 4; ++j) { const float* gp = gpost + (c.lane + 64 * j) * 8; const f32x4 g0 = *(CF4)gp, g1 = *(CF4)(gp + 4);
#pragma unroll
            for (int k = 0; k < 4; ++k) { const float ga = (k < 2) ? g0[2 * k] : g1[2 * k - 4], gb = (k < 2) ? g0[2 * k + 1] : g1[2 * k - 3];
                v[j][2 * k] = bflo(xv[j][k]) + v[j][2 * k] * rs * ga; v[j][2 * k + 1] = bfhi(xv[j][k]) + v[j][2 * k + 1] * rs * gb;
                s2 += v[j][2 * k] * v[j][2 * k] + v[j][2 * k + 1] * v[j][2 * k + 1]; } }
        if (OUT) {
#pragma unroll
            for (int j = 0; j < 4; ++j) { float* op = OUT + (size_t)row * DM + (c.lane + 64 * j) * 8; *(f32x4*)op = (f32x4){v[j][0], v[j][1], v[j][2], v[j][3]}; *(f32x4*)(op + 4) = (f32x4){v[j][4], v[j][5], v[j][6], v[j][7]}; }
        } else {
#pragma unroll
            for (int j = 0; j < 4; ++j) { v4u o; o.x = pk2(v[j][0], v[j][1]); o.y = pk2(v[j][2], v[j][3]); o.z = pk2(v[j][4], v[j][5]); o.w = pk2(v[j][6], v[j][7]); xr[64 * j] = o; }
            const float rs2 = rsqrtf(wave_sum(s2) * (1.f / DM) + EPS); if (c.lane == 0) RS[row] = rs2;
        }
    }
}
__device__ __forceinline__ void x_to_xb(const Ctx& c, const float* X, bf16* XB, float* RS) {
    for (int row = c.gw; row < MT; row += c.NGW) {
        const f32x4* xr = (const f32x4*)(X + (size_t)row * DM) + c.lane; f32x4 v[8]; float s = 0.f;
#pragma unroll
        for (int j = 0; j < 8; ++j) { v[j] = xr[64 * j]; s += (v[j].x * v[j].x + v[j].y * v[j].y) + (v[j].z * v[j].z + v[j].w * v[j].w); }
        const float rs = rsqrtf(wave_sum(s) * (1.f / DM) + EPS); if (c.lane == 0) RS[row] = rs;
        v2u* o8 = (v2u*)(XB + (size_t)row * DM) + c.lane;
#pragma unroll
        for (int j = 0; j < 8; ++j) { v2u o; o.x = pk2(v[j].x, v[j].y); o.y = pk2(v[j].z, v[j].w); o8[64 * j] = o; }
    }
}

__device__ __forceinline__ void ffn_convact(const Ctx& c, const bf16* U, const float* cw, const float* cb, bf16* ACT) {
    const int NCG = FFH / 8, items = (MT / 8) * NCG;
    for (int it = c.vcu * 512 + c.tid; it < items; it += c.G * 512) {
        const int rb = it / NCG, cg = it % NCG, c0 = cg * 8, row0 = rb * 8, t0 = row0 & (SEQ - 1);
        v4u ga[10], va[10];
#pragma unroll
        for (int i = 0; i < 10; ++i) { const bool ok = (i >= 2) || (t0 != 0); const size_t r = (size_t)(row0 + i - 2);
            ga[i] = ok ? *(const v4u*)(U + r * FF2 + c0) : (v4u){0u, 0u, 0u, 0u}; va[i] = ok ? *(const v4u*)(U + r * FF2 + FFH + c0) : (v4u){0u, 0u, 0u, 0u}; }
        float wg[3][8], wv[3][8], bg[8], bv[8];
#pragma unroll
        for (int k = 0; k < 3; ++k) { const f32x4 a0 = *(const f32x4*)(cw + k * FF2 + c0), a1 = *(const f32x4*)(cw + k * FF2 + c0 + 4), b0 = *(const f32x4*)(cw + k * FF2 + FFH + c0), b1 = *(const f32x4*)(cw + k * FF2 + FFH + c0 + 4);
#pragma unroll
            for (int j = 0; j < 4; ++j) { wg[k][j] = a0[j]; wg[k][4 + j] = a1[j]; wv[k][j] = b0[j]; wv[k][4 + j] = b1[j]; } }
        { const f32x4 a0 = *(const f32x4*)(cb + c0), a1 = *(const f32x4*)(cb + c0 + 4), b0 = *(const f32x4*)(cb + FFH + c0), b1 = *(const f32x4*)(cb + FFH + c0 + 4);
#pragma unroll
          for (int j = 0; j < 4; ++j) { bg[j] = a0[j]; bg[4 + j] = a1[j]; bv[j] = b0[j]; bv[4 + j] = b1[j]; } }
#pragma unroll
        for (int i = 0; i < 8; ++i) {
            float o[8];
#pragma unroll
            for (int j = 0; j < 8; ++j) { const int q = j >> 1;
                const float g2 = (j & 1) ? bfhi(ga[i][q]) : bflo(ga[i][q]), g1 = (j & 1) ? bfhi(ga[i + 1][q]) : bflo(ga[i + 1][q]), g0 = (j & 1) ? bfhi(ga[i + 2][q]) : bflo(ga[i + 2][q]);
                const float v2 = (j & 1) ? bfhi(va[i][q]) : bflo(va[i][q]), v1 = (j & 1) ? bfhi(va[i + 1][q]) : bflo(va[i + 1][q]), v0 = (j & 1) ? bfhi(va[i + 2][q]) : bflo(va[i + 2][q]);
                const float cgv = bg[j] + wg[0][j] * g2 + wg[1][j] * g1 + wg[2][j] * g0, cvv = bv[j] + wv[0][j] * v2 + wv[1][j] * v1 + wv[2][j] * v0;
                o[j] = siluf_(cgv) * cvv; }
            v4u w; w.x = pk2(o[0], o[1]); w.y = pk2(o[2], o[3]); w.z = pk2(o[4], o[5]); w.w = pk2(o[6], o[7]);
            *(v4u*)(ACT + (size_t)(row0 + i) * FFH + c0) = w;
        }
    }
}

__device__ __forceinline__ void ssd_conv(const Ctx& c, const bf16* P, const float* cw, const float* cb, const float* dtb, bf16* X2, float* DT) {
    const int NC = 6144, NCG = NC / 8, items = (MT / 8) * NCG;
    for (int it = c.vcu * 512 + c.tid; it < items; it += c.G * 512) {
        const int rb = it / NCG, cg = it % NCG, c0 = cg * 8, row0 = rb * 8, t0 = row0 & (SEQ - 1);
        v4u xa[11];
#pragma unroll
        for (int i = 0; i < 11; ++i) { const bool ok = (i >= 3) || (t0 != 0); xa[i] = ok ? *(const v4u*)(P + (size_t)(row0 + i - 3) * SSD_NP + 4096 + c0) : (v4u){0u, 0u, 0u, 0u}; }
        float w[4][8], bb[8];
#pragma unroll
        for (int k = 0; k < 4; ++k) { const f32x4 a0 = *(const f32x4*)(cw + k * NC + c0), a1 = *(const f32x4*)(cw + k * NC + c0 + 4);
#pragma unroll
            for (int j = 0; j < 4; ++j) { w[k][j] = a0[j]; w[k][4 + j] = a1[j]; } }
        { const f32x4 a0 = *(const f32x4*)(cb + c0), a1 = *(const f32x4*)(cb + c0 + 4);
#pragma unroll
          for (int j = 0; j < 4; ++j) { bb[j] = a0[j]; bb[4 + j] = a1[j]; } }
#pragma unroll
        for (int i = 0; i < 8; ++i) {
            float o[8];
#pragma unroll
            for (int j = 0; j < 8; ++j) { const int q = j >> 1; float y = bb[j];
#pragma unroll
                for (int k = 0; k < 4; ++k) y += w[k][j] * ((j & 1) ? bfhi(xa[i + k][q]) : bflo(xa[i + k][q]));
                o[j] = silu_fast(y); }
            v4u wv; wv.x = pk2(o[0], o[1]); wv.y = pk2(o[2], o[3]); wv.z = pk2(o[4], o[5]); wv.w = pk2(o[6], o[7]);
            *(v4u*)(X2 + (size_t)(row0 + i) * NC + c0) = wv;
        }
    }
    for (int it = c.vcu * 512 + c.tid; it < MT * 64; it += c.G * 512) {
        const int row = it >> 6, h = it & 63; const float raw = bflo((unsigned)P[(size_t)row * SSD_NP + 10240 + h]) + dtb[h];
        DT[it] = raw > 20.f ? raw : log1pf(expf(raw));
    }
}

__device__ __forceinline__ s16x4 tr16(const LAS unsigned char* p) { return __builtin_amdgcn_ds_read_tr16_b64_v4i16((LAS s16x4*)p); }
__device__ __forceinline__ bf16x8 cat8(s16x4 a, s16x4 b) { bf16x8 r; r[0] = a[0]; r[1] = a[1]; r[2] = a[2]; r[3] = a[3]; r[4] = b[0]; r[5] = b[1]; r[6] = b[2]; r[7] = b[3]; return r; }
__device__ __forceinline__ void ssd_scan_mfma(const Ctx& c, bf16* X2, const float* DT, const float* a_log, const float* dskip, bool do_store) {
    constexpr int SS_B = 0, SS_C = 17408, SS_XR = 34816, SS_XD = 44032, SS_XW = 53248, SS_SB = 62464  , SS_CS = 97280  , SS_DTS = 97792  ;
    LAS unsigned char* L = c.lds;
    const int tid = c.tid, lane = c.lane, l15 = lane & 15, lg = lane >> 4, w = c.wave, lt = w >> 1, ph = w & 1, tq = l15 >> 2, tp = l15 & 3;
    for (int u = c.vcu; u < NB * 64; u += c.G) {
        const int b = u >> 6, h = u & 63, g = h >> 3; const float Ah = -expf(a_log[h]), Dh = dskip[h];
        f32x4 ST[4];
#pragma unroll
        for (int i = 0; i < 4; ++i) ST[i] = (f32x4){0.f, 0.f, 0.f, 0.f};
        __syncthreads();
        for (int i = tid; i < 17408 / 16; i += 512) *(LAS v4u*)(L + SS_SB + i * 16) = (v4u){0u, 0u, 0u, 0u};
        v4u rB[2], rC[2], rXR; float rdt = 0.f;
        const bf16* x2b = X2 + (size_t)b * SEQ * 6144;
#define SSD_LOAD(t0_) do { _Pragma("unroll") for (int e = 0; e < 2; ++e) { const int cc = tid + 512 * e; \
            rB[e] = *(const v4u*)(x2b + (size_t)((t0_) + (cc >> 4)) * 6144 + 4096 + g * 128 + (cc & 15) * 8); rC[e] = *(const v4u*)(x2b + (size_t)((t0_) + (cc >> 4)) * 6144 + 5120 + g * 128 + (cc & 15) * 8); } \
            rXR = *(const v4u*)(x2b + (size_t)((t0_) + (tid >> 3)) * 6144 + h * 64 + (tid & 7) * 8); } while (0)
#define SSD_CS(buf_) do { if (w == 0) { float a = rdt * Ah; \
            _Pragma("unroll") for (int o = 1; o < 64; o <<= 1) { const float v = __shfl_up(a, o); if (lane >= o) a += v; } \
            ((LAS float*)(L + SS_CS))[(buf_) * 64 + lane] = a; ((LAS float*)(L + SS_DTS))[(buf_) * 64 + lane] = rdt; } } while (0)
#define SSD_LDT(t0_) do { if (w == 0) rdt = DT[((size_t)b * SEQ + (t0_) + lane) * 64 + h]; } while (0)
        SSD_LOAD(0); SSD_LDT(0); SSD_CS(0); SSD_LDT(64);
        for (int ch = 0; ch < SEQ / 64; ++ch) {
            const int t0 = ch * 64, cb = ch & 1; LAS float* CS = (LAS float*)(L + SS_CS) + cb * 64; LAS float* DTS = (LAS float*)(L + SS_DTS) + cb * 64;
            LAS unsigned char* SBr = L + SS_SB + cb * 17408; LAS unsigned char* SBw = L + SS_SB + (cb ^ 1) * 17408;
            __syncthreads();
#pragma unroll
            for (int e = 0; e < 2; ++e) { const int cc = tid + 512 * e;
                *(LAS v4u*)(L + SS_B + (cc >> 4) * 272 + (cc & 15) * 16) = rB[e]; *(LAS v4u*)(L + SS_C + (cc >> 4) * 272 + (cc & 15) * 16) = rC[e]; }
            *(LAS v4u*)(L + SS_XR + (tid >> 3) * 144 + (tid & 7) * 16) = rXR;
            { const int sr = tid >> 3, p8 = tid & 7; const float fd = DTS[sr], fw = fd * __expf(CS[63] - CS[sr]);
              float xv[8];
#pragma unroll
              for (int j = 0; j < 4; ++j) { xv[2 * j] = bflo(rXR[j]); xv[2 * j + 1] = bfhi(rXR[j]); }
              v4u o1, o2; o1.x = pk2(xv[0] * fd, xv[1] * fd); o1.y = pk2(xv[2] * fd, xv[3] * fd); o1.z = pk2(xv[4] * fd, xv[5] * fd); o1.w = pk2(xv[6] * fd, xv[7] * fd);
              o2.x = pk2(xv[0] * fw, xv[1] * fw); o2.y = pk2(xv[2] * fw, xv[3] * fw); o2.z = pk2(xv[4] * fw, xv[5] * fw); o2.w = pk2(xv[6] * fw, xv[7] * fw);
              *(LAS v4u*)(L + SS_XD + sr * 144 + p8 * 16) = o1; *(LAS v4u*)(L + SS_XW + sr * 144 + p8 * 16) = o2; }
            if (ch + 1 < SEQ / 64) { SSD_LOAD(t0 + 64); SSD_CS(cb ^ 1); if (ch + 2 < SEQ / 64) SSD_LDT(t0 + 128); }
            __syncthreads();
            {
                const float csl = CS[16 * lt + l15];
                bf16x8 Cf[4];
#pragma unroll
                for (int ks = 0; ks < 4; ++ks) Cf[ks] = *(const LAS bf16x8*)(L + SS_C + (16 * lt + l15) * 272 + (32 * ks + 8 * lg) * 2);
                f32x4 GT[4];
#pragma unroll
                for (int st = 0; st < 4; ++st) { GT[st] = (f32x4){0.f, 0.f, 0.f, 0.f};
                    if (st <= lt) {
#pragma unroll
                        for (int ks = 0; ks < 4; ++ks) { const bf16x8 bf = *(const LAS bf16x8*)(L + SS_B + (16 * st + l15) * 272 + (32 * ks + 8 * lg) * 2); GT[st] = __builtin_amdgcn_mfma_f32_16x16x32_bf16(bf, Cf[ks], GT[st], 0, 0, 0); }
                        const f32x4 css = *(const LAS f32x4*)(CS + 16 * st + 4 * lg);
#pragma unroll
                        for (int r = 0; r < 4; ++r) { const bool ok = (16 * st + 4 * lg + r) <= (16 * lt + l15); GT[st][r] = ok ? GT[st][r] * __expf(csl - css[r]) : 0.f; }
                    } }
                bf16x8 Lf[2];
#pragma unroll
                for (int k2 = 0; k2 < 2; ++k2) { v4u q; q.x = pg8::cvt_pk_bf16(GT[2 * k2][0], GT[2 * k2][1]); q.y = pg8::cvt_pk_bf16(GT[2 * k2][2], GT[2 * k2][3]); q.z = pg8::cvt_pk_bf16(GT[2 * k2 + 1][0], GT[2 * k2 + 1][1]); q.w = pg8::cvt_pk_bf16(GT[2 * k2 + 1][2], GT[2 * k2 + 1][3]);
                    Lf[k2] = __builtin_bit_cast(bf16x8, q); }
                const float el = __expf(csl);
                const LAS unsigned char* xdb = L + SS_XD + (4 * lg + tq) * 144 + tp * 8;
#pragma unroll
                for (int pp = 0; pp < 2; ++pp) { const int pt = 2 * ph + pp; f32x4 Y = (f32x4){0.f, 0.f, 0.f, 0.f}, Yo = (f32x4){0.f, 0.f, 0.f, 0.f};
#pragma unroll
                    for (int k2 = 0; k2 < 2; ++k2) if (2 * k2 <= lt) { const LAS unsigned char* xp = xdb + k2 * 32 * 144 + pt * 32;
                        Y = __builtin_amdgcn_mfma_f32_16x16x32_bf16(cat8(tr16(xp), tr16(xp + 16 * 144)), Lf[k2], Y, 0, 0, 0); }
#pragma unroll
                    for (int ks = 0; ks < 4; ++ks) { const bf16x8 sb = *(const LAS bf16x8*)(SBr + (16 * pt + l15) * 272 + (32 * ks + 8 * lg) * 2); Yo = __builtin_amdgcn_mfma_f32_16x16x32_bf16(sb, Cf[ks], Yo, 0, 0, 0); }
                    const v2u xr = *(const LAS v2u*)(L + SS_XR + (16 * lt + l15) * 144 + (16 * pt + 4 * lg) * 2);
                    const float y0 = Y[0] + el * Yo[0] + Dh * bflo(xr.x), y1 = Y[1] + el * Yo[1] + Dh * bfhi(xr.x), y2 = Y[2] + el * Yo[2] + Dh * bflo(xr.y), y3 = Y[3] + el * Yo[3] + Dh * bfhi(xr.y);
                    v2u o; o.x = pk2(y0, y1); o.y = pk2(y2, y3);
                    if (do_store) *(v2u*)(X2 + ((size_t)b * SEQ + t0 + 16 * lt + l15) * 6144 + h * 64 + 16 * pt + 4 * lg) = o; }
                const float e63 = __expf(CS[63]); const int pts = w >> 1;
                const LAS unsigned char* bb = L + SS_B + (8 * lg + tq) * 272 + tp * 8; const LAS unsigned char* xwb = L + SS_XW + (8 * lg + tq) * 144 + tp * 8 + pts * 32;
                bf16x8 Xf[2];
#pragma unroll
                for (int ks = 0; ks < 2; ++ks) Xf[ks] = cat8(tr16(xwb + ks * 32 * 144), tr16(xwb + ks * 32 * 144 + 4 * 144));
#pragma unroll
                for (int i = 0; i < 4; ++i) { const int nt = 4 * (w & 1) + i; ST[i] *= e63;
#pragma unroll
                    for (int ks = 0; ks < 2; ++ks) { const LAS unsigned char* bp = bb + ks * 32 * 272 + nt * 32;
                        ST[i] = __builtin_amdgcn_mfma_f32_16x16x32_bf16(cat8(tr16(bp), tr16(bp + 4 * 272)), Xf[ks], ST[i], 0, 0, 0); }
                    v2u q; q.x = pk2(ST[i][0], ST[i][1]); q.y = pk2(ST[i][2], ST[i][3]);
                    *(LAS v2u*)(SBw + (16 * pts + l15) * 272 + (16 * nt + 4 * lg) * 2) = q; }
            }
        }
#undef SSD_LOAD
#undef SSD_CS
#undef SSD_LDT
    }
    __syncthreads();
}

__device__ __forceinline__ void ssd_gnorm(const Ctx& c, bf16* X2, const bf16* P, const float* g) {
    for (int row = c.gw; row < MT; row += c.NGW) {
        v4u* yr = (v4u*)(X2 + (size_t)row * 6144) + c.lane; const v4u* zr = (const v4u*)(P + (size_t)row * SSD_NP) + c.lane;
        float v[8][8]; float s = 0.f;
#pragma unroll
        for (int j = 0; j < 8; ++j) { const v4u y = yr[64 * j], z = zr[64 * j];
#pragma unroll
            for (int k = 0; k < 4; ++k) { const float a = bflo(y[k]) * siluf_(bflo(z[k])), b = bfhi(y[k]) * siluf_(bfhi(z[k])); v[j][2 * k] = a; v[j][2 * k + 1] = b; s += a * a + b * b; } }
        const float rs = rsqrtf(wave_sum(s) * (1.f / 4096.f) + EPS);
#pragma unroll
        for (int j = 0; j < 8; ++j) { const float* gg = g + (c.lane + 64 * j) * 8; const f32x4 g0 = *(const f32x4*)gg, g1 = *(const f32x4*)(gg + 4);
            v4u w; w.x = pk2(v[j][0] * rs * g0.x, v[j][1] * rs * g0.y); w.y = pk2(v[j][2] * rs * g0.z, v[j][3] * rs * g0.w); w.z = pk2(v[j][4] * rs * g1.x, v[j][5] * rs * g1.y); w.w = pk2(v[j][6] * rs * g1.z, v[j][7] * rs * g1.w);
            yr[64 * j] = w; }
    }
}

__device__ __forceinline__ void sgu_ln(const Ctx& c, bf16* P, const float* g) {
    for (int row = c.gw; row < MT; row += c.NGW) {
        v4u* vr = (v4u*)(P + (size_t)row * 8192 + 4096) + c.lane;
        float v[8][8]; float s = 0.f;
#pragma unroll
        for (int j = 0; j < 8; ++j) { const v4u y = vr[64 * j];
#pragma unroll
            for (int k = 0; k < 4; ++k) { v[j][2 * k] = bflo(y[k]); v[j][2 * k + 1] = bfhi(y[k]); s += v[j][2 * k] + v[j][2 * k + 1]; } }
        const float mu = wave_sum(s) * (1.f / 4096.f); float q = 0.f;
#pragma unroll
        for (int j = 0; j < 8; ++j)
#pragma unroll
            for (int k = 0; k < 8; ++k) { v[j][k] -= mu; q += v[j][k] * v[j][k]; }
        const float rs = rsqrtf(wave_sum(q) * (1.f / 4096.f) + EPS);
#pragma unroll
        for (int j = 0; j < 8; ++j) { const float* gg = g + (c.lane + 64 * j) * 8; const f32x4 g0 = *(const f32x4*)gg, g1 = *(const f32x4*)(gg + 4);
            v4u w; w.x = pk2(v[j][0] * rs * g0.x, v[j][1] * rs * g0.y); w.y = pk2(v[j][2] * rs * g0.z, v[j][3] * rs * g0.w); w.z = pk2(v[j][4] * rs * g1.x, v[j][5] * rs * g1.y); w.w = pk2(v[j][6] * rs * g1.z, v[j][7] * rs * g1.w);
            vr[64 * j] = w; }
    }
}
__device__ __forceinline__ void sgu_spatial(const Ctx& c, const bf16* P, const float* Wsp, const float* bsp, bf16* ACT) {
    LAS unsigned char* Vs = c.lds;
    for (int u = c.vcu; u < NB * 32 * 8; u += c.G) {
        const int g = u & 7, bc = u >> 3; const size_t row0 = (size_t)bc * 128;
        __syncthreads();
        for (int i = c.tid; i < 128 * 64; i += 512) { const int s = i >> 6, d8 = i & 63; *(LAS v4u*)(Vs + s * 1024 + d8 * 16) = *(const v4u*)(P + (row0 + s) * 8192 + 4096 + g * 512 + d8 * 8); }
        __syncthreads();
        const int d8 = c.lane;
        for (int i = 0; i < 16; ++i) {
            const int t = c.wave + 8 * i; const float* wrow = Wsp + ((size_t)g * 128 + t) * 128;
            float acc[8];
#pragma unroll
            for (int j = 0; j < 8; ++j) acc[j] = 0.f;
            for (int s = 0; s <= t; ++s) { const float w = wrow[s]; const v4u v = *(const LAS v4u*)(Vs + s * 1024 + d8 * 16);
#pragma unroll
                for (int j = 0; j < 4; ++j) { acc[2 * j] += w * bflo(v[j]); acc[2 * j + 1] += w * bfhi(v[j]); } }
            const float bb = bsp[g * 128 + t]; const v4u uu = *(const v4u*)(P + (row0 + t) * 8192 + g * 512 + d8 * 8);
            v4u w; w.x = pk2(bflo(uu.x) * (acc[0] + bb), bfhi(uu.x) * (acc[1] + bb)); w.y = pk2(bflo(uu.y) * (acc[2] + bb), bfhi(uu.y) * (acc[3] + bb));
            w.z = pk2(bflo(uu.z) * (acc[4] + bb), bfhi(uu.z) * (acc[5] + bb)); w.w = pk2(bflo(uu.w) * (acc[6] + bb), bfhi(uu.w) * (acc[7] + bb));
            *(v4u*)(ACT + (row0 + t) * 4096 + g * 512 + d8 * 8) = w;
        }
    }
    __syncthreads();
}

__device__ __forceinline__ void sgu_spatial_mfma(const Ctx& c, const bf16* P, const float* Wsp, const float* bsp, bf16* ACT) {
    constexpr int RS = 528, WB = 128 * RS, WRS = 272;
    LAS unsigned char* L = c.lds; const int tid = c.tid, l15 = c.lane & 15, lg = c.lane >> 4, w = c.wave;
    for (int u_ = c.vcu; u_ < (PROBE == 22 ? 2 : 1) * NB * 32 * 8; u_ += c.G) {
        const int u = u_ & (NB * 32 * 8 - 1); const int g = u & 7, bc = u >> 3; const size_t row0 = (size_t)bc * 128;
        __syncthreads();
#pragma unroll
        for (int e = 0; e < 4; ++e) { const int cc = tid + 512 * e, t = cc >> 4, s8 = cc & 15; const float* wp = Wsp + ((size_t)g * 128 + t) * 128 + s8 * 8; f32x4 a = *(const f32x4*)wp, b = *(const f32x4*)(wp + 4);
#pragma unroll
            for (int j = 0; j < 4; ++j) { if (s8 * 8 + j > t) a[j] = 0.f; if (s8 * 8 + 4 + j > t) b[j] = 0.f; }
            v4u q; q.x = pk2(a[0], a[1]); q.y = pk2(a[2], a[3]); q.z = pk2(b[0], b[1]); q.w = pk2(b[2], b[3]); *(LAS v4u*)(L + WB + t * WRS + s8 * 16) = q; }
        for (int half = 0; half < 2; ++half) {
            if (half) __syncthreads();
#pragma unroll
            for (int e = 0; e < 8; ++e) { const int cc = tid + 512 * e, sr = cc >> 5, d8 = cc & 31; *(LAS v4u*)(L + sr * RS + d8 * 16) = *(const v4u*)(P + (row0 + sr) * 8192 + 4096 + g * 512 + 256 * half + d8 * 8); }
            __syncthreads();
            bf16x8 Wf[4];
#pragma unroll
            for (int ks = 0; ks < 4; ++ks) Wf[ks] = *(const LAS bf16x8*)(L + WB + (16 * w + l15) * WRS + (32 * ks + 8 * lg) * 2);
            const int nks = (w >> 1) + 1; const int t = 16 * w + l15; const float bb = bsp[g * 128 + t];
            const LAS unsigned char* vb = L + (8 * lg + (l15 >> 2)) * RS + (l15 & 3) * 8;
            v2u uv[16];
#pragma unroll
            for (int dt = 0; dt < 16; ++dt) uv[dt] = *(const v2u*)(P + (row0 + t) * 8192 + (size_t)g * 512 + 256 * half + 16 * dt + 4 * lg);
#pragma unroll
            for (int dt = 0; dt < 16; ++dt) {
                f32x4 acc = (f32x4){0.f, 0.f, 0.f, 0.f};
#pragma unroll
                for (int ks = 0; ks < 4; ++ks) if (ks < nks) {
                    const s16x4 a0 = __builtin_amdgcn_ds_read_tr16_b64_v4i16((LAS s16x4*)(vb + ks * 32 * RS + dt * 32)), a1 = __builtin_amdgcn_ds_read_tr16_b64_v4i16((LAS s16x4*)(vb + ks * 32 * RS + 4 * RS + dt * 32));
                    bf16x8 af; af[0] = a0[0]; af[1] = a0[1]; af[2] = a0[2]; af[3] = a0[3]; af[4] = a1[0]; af[5] = a1[1]; af[6] = a1[2]; af[7] = a1[3];
                    acc = __builtin_amdgcn_mfma_f32_16x16x32_bf16(af, Wf[ks], acc, 0, 0, 0); }
                const size_t col = (size_t)g * 512 + 256 * half + 16 * dt + 4 * lg;
                const v2u uu = uv[dt];
                v2u o; o.x = pk2(bflo(uu.x) * (acc[0] + bb), bfhi(uu.x) * (acc[1] + bb)); o.y = pk2(bflo(uu.y) * (acc[2] + bb), bfhi(uu.y) * (acc[3] + bb));
                *(v2u*)(ACT + (row0 + t) * 4096 + col) = o;
            }
        }
    }
    __syncthreads();
}

template <int WIN> __device__ __forceinline__ f32x4 pool_sum(const float* zp, int t) {
    f32x4 v[WIN];
#pragma unroll
    for (int j = 1; j < WIN; ++j) v[j] = (j <= t) ? *(const f32x4*)(zp - (size_t)j * DM) : (f32x4){0.f, 0.f, 0.f, 0.f};
    f32x4 s = (f32x4){0.f, 0.f, 0.f, 0.f};
#pragma unroll
    for (int j = 1; j < WIN; ++j) s += v[j];
    return s;
}
__device__ __forceinline__ void pool_pool(const Ctx& c, const float* Z, bf16* O) {
    for (int it = c.vcu * 512 + c.tid; it < MT * 512; it += c.G * 512) {
        const int row = it >> 9, c4 = (it & 511) * 4, gi = __builtin_amdgcn_readfirstlane(c4 >> 9), win = 2 << gi, t = row & (SEQ - 1), cnt = (t + 1 < win) ? t + 1 : win;
        const float* zp = Z + (size_t)row * DM + c4; const f32x4 z0 = *(const f32x4*)zp; f32x4 s;
        if (gi == 0) s = pool_sum<2>(zp, t); else if (gi == 1) s = pool_sum<4>(zp, t); else if (gi == 2) s = pool_sum<8>(zp, t); else s = pool_sum<16>(zp, t);
        s += z0;
        const float ic = 1.f / (float)cnt; v2u o; o.x = pk2(s.x * ic - z0.x, s.y * ic - z0.y); o.y = pk2(s.z * ic - z0.z, s.w * ic - z0.w);
        *(v2u*)(O + (size_t)row * DM + c4) = o;
    }
}

__device__ __forceinline__ void xa_attn(const Ctx& c, const bf16* Q, const bf16* KV, bf16* O) {
    LAS unsigned char* Ks = c.lds; LAS unsigned char* Vs = c.lds + 69632; LAS float* qs = (LAS float*)(c.lds + 135168 + c.wave * 1536); LAS float* ps = qs + 128;
    const int lane = c.lane; const float scale = 0.08838834764831845f;
    for (int u = c.vcu; u < 256; u += c.G) {
        const int bh = u >> 4, chunk = u & 15, b = bh >> 2, hd = bh & 3;
        __syncthreads();
        for (int i = c.tid; i < 256 * 16; i += 512) { const int key = i >> 4, d8 = i & 15; const bf16* src = KV + (size_t)(b * 256 + key) * 1024 + hd * 128 + d8 * 8;
            *(LAS v4u*)(Ks + key * 272 + d8 * 16) = *(const v4u*)src; *(LAS v4u*)(Vs + key * 256 + d8 * 16) = *(const v4u*)(src + 512); }
        __syncthreads();
        for (int i = 0; i < 32; ++i) {
            const size_t row = (size_t)b * SEQ + chunk * 256 + c.wave * 32 + i;
            const unsigned qq = *(const unsigned*)(Q + row * 512 + hd * 128 + 2 * lane);
            qs[2 * lane] = bflo(qq); qs[2 * lane + 1] = bfhi(qq);
            LDS_WAIT();
            float sc[4] = {0.f, 0.f, 0.f, 0.f};
#pragma unroll 2
            for (int d8 = 0; d8 < 16; ++d8) { const f32x4 q0 = *(const LAS f32x4*)(qs + d8 * 8), q1 = *(const LAS f32x4*)(qs + d8 * 8 + 4);
#pragma unroll
                for (int r = 0; r < 4; ++r) { const v4u kv = *(const LAS v4u*)(Ks + (lane + 64 * r) * 272 + d8 * 16);
                    sc[r] += bflo(kv.x) * q0.x + bfhi(kv.x) * q0.y + bflo(kv.y) * q0.z + bfhi(kv.y) * q0.w + bflo(kv.z) * q1.x + bfhi(kv.z) * q1.y + bflo(kv.w) * q1.z + bfhi(kv.w) * q1.w; } }
#pragma unroll
            for (int r = 0; r < 4; ++r) sc[r] *= scale;
            const float m = wave_max(fmaxf(fmaxf(sc[0], sc[1]), fmaxf(sc[2], sc[3])));
            float l = 0.f;
#pragma unroll
            for (int r = 0; r < 4; ++r) { const float p = __expf(sc[r] - m); l += p; ps[lane + 64 * r] = p; }
            l = wave_sum(l);
            LDS_WAIT();
            float o0 = 0.f, o1 = 0.f;
#pragma unroll 8
            for (int key = 0; key < 256; ++key) { const float p = ps[key]; const unsigned vv = *(const LAS unsigned*)(Vs + key * 256 + lane * 4); o0 += p * bflo(vv); o1 += p * bfhi(vv); }
            const float il = 1.f / l;
            *(unsigned*)(O + row * 512 + hd * 128 + 2 * lane) = pk2(o0 * il, o1 * il);
            LDS_WAIT();
        }
    }
    __syncthreads();
}

__device__ __forceinline__ void nsa_posbias(const Ctx& c, const float* pos, const float* w1, float* PBP) {
    for (int o = ((c.gw & 3) == 3) ? (c.gw >> 2) : 512; o < 512; o += (c.NGW >> 2)) { const int ten = o >> 8, nb = (o >> 6) & 3, ks = o & 63, n = nb * 64 + c.lane; float a = 0.f;
#pragma unroll 16
        for (int k = 0; k < 64; ++k) a += pos[ten * 4096 + ks * 64 + k] * w1[((size_t)ten * 4096 + ks * 64 + k) * 256 + n];
        PBP[(ten * 64 + ks) * 256 + n] = a; }
}
__device__ __forceinline__ void nsa_posbias_reduce(const Ctx& c, const float* PBP, float* PB) {
    if (c.vcu == 0) { const int ten = c.tid >> 8, n = c.tid & 255; float a = 0.f;
#pragma unroll 16
        for (int ks = 0; ks < 64; ++ks) a += PBP[(ten * 64 + ks) * 256 + n];
        PB[c.tid] = a; }
}
__device__ __forceinline__ void nsa_w2(const Ctx& c, const bf16* HID, const float* w2, float* KC) {
    for (int it = c.vcu * 512 + c.tid; it < 8192 * 128; it += c.G * 512) {
        const int r = it >> 7, d = it & 127, ten = r >> 12; const bf16* hrow = HID + (size_t)r * 256; const float* w = w2 + (size_t)ten * 256 * 128 + d; float a = 0.f;
#pragma unroll 8
        for (int h = 0; h < 256; ++h) a += bflo((unsigned)hrow[h]) * w[h * 128];
        KC[it] = a;
    }
}
__device__ __forceinline__ void nsa_block(const bf16* Kb, const bf16* Vb, bool valid, const LAS float* qs, LAS float* ps, int lane, float (&m)[4], float (&l)[4], float (&o)[4][2]) {
    const float scale = 0.08838834764831845f;
    float sc[4] = {0.f, 0.f, 0.f, 0.f};
    const v4u* kr = (const v4u*)(Kb + (size_t)lane * 128);
#pragma unroll 4
    for (int d8 = 0; d8 < 16; ++d8) { const v4u kv = kr[d8]; float k[8];
#pragma unroll
        for (int j = 0; j < 4; ++j) { k[2 * j] = bflo(kv[j]); k[2 * j + 1] = bfhi(kv[j]); }
#pragma unroll
        for (int h = 0; h < 4; ++h) { const f32x4 q0 = *(const LAS f32x4*)(qs + h * 128 + d8 * 8), q1 = *(const LAS f32x4*)(qs + h * 128 + d8 * 8 + 4);
            sc[h] += k[0] * q0.x + k[1] * q0.y + k[2] * q0.z + k[3] * q0.w + k[4] * q1.x + k[5] * q1.y + k[6] * q1.z + k[7] * q1.w; } }
    float alpha[4];
#pragma unroll
    for (int h = 0; h < 4; ++h) { const float s = valid ? sc[h] * scale : -1e30f; const float mn = fmaxf(m[h], wave_max(s)); const float p = valid ? __expf(s - mn) : 0.f;
        alpha[h] = __expf(m[h] - mn); m[h] = mn; l[h] = l[h] * alpha[h] + wave_sum(p); ps[h * 64 + lane] = p; o[h][0] *= alpha[h]; o[h][1] *= alpha[h]; }
    LDS_WAIT();
#pragma unroll 4
    for (int s = 0; s < 64; ++s) { const unsigned vv = *(const unsigned*)(Vb + (size_t)s * 128 + 2 * lane); const float v0 = bflo(vv), v1 = bfhi(vv);
#pragma unroll
        for (int h = 0; h < 4; ++h) { const float p = ps[h * 64 + s]; o[h][0] += p * v0; o[h][1] += p * v1; } }
    LDS_WAIT();
}
__device__ __forceinline__ void nsa_attn(const Ctx& c, const bf16* Q, const bf16* T, const float* KC, const float* Gt, bf16* OUT) {
    LAS float* qs = (LAS float*)(c.lds + c.wave * 8192);
    LAS float* ps = qs + 512;
    LAS float* psum = ps + 1024;
    const int lane = c.lane; const float scale = 0.08838834764831845f;
    for (int task = c.gw; task < MT * 4; task += c.NGW) {
        const int g = task & 3, row = task >> 2, b = row >> 12, t = row & 4095, bg = b * 4 + g;
        { const v4u qv = *(const v4u*)(Q + (size_t)row * 2048 + g * 512 + lane * 8); LAS float* qd = qs + lane * 8;
#pragma unroll
          for (int j = 0; j < 4; ++j) { qd[2 * j] = bflo(qv[j]); qd[2 * j + 1] = bfhi(qv[j]); } }
        LDS_WAIT();
        const int nv = (t >= 31) ? ((t - 31) >> 4) + 1 : 0;
        float oc[4][2] = {{0.f, 0.f}, {0.f, 0.f}, {0.f, 0.f}, {0.f, 0.f}};
        const float* kcb = KC + (size_t)bg * 256 * 128; const float* vcb = KC + (size_t)(16 + bg) * 256 * 128;
        psum[lane] = 0.f; psum[lane + 64] = 0.f; psum[lane + 128] = 0.f; psum[lane + 192] = 0.f;
        if (nv > 0) {
            float sc[4][4];
#pragma unroll
            for (int r = 0; r < 4; ++r) { const int i = lane + 64 * r;
#pragma unroll
                for (int h = 0; h < 4; ++h) sc[h][r] = 0.f;
                if (i < nv) { const f32x4* kr = (const f32x4*)(kcb + (size_t)i * 128);
#pragma unroll 4
                    for (int d4 = 0; d4 < 32; ++d4) { const f32x4 kv = kr[d4];
#pragma unroll
                        for (int h = 0; h < 4; ++h) { const f32x4 q0 = *(const LAS f32x4*)(qs + h * 128 + d4 * 4); sc[h][r] += kv.x * q0.x + kv.y * q0.y + kv.z * q0.z + kv.w * q0.w; } } } }
            float ps_r[4] = {0.f, 0.f, 0.f, 0.f};
#pragma unroll
            for (int h = 0; h < 4; ++h) { float mx = -1e30f;
#pragma unroll
                for (int r = 0; r < 4; ++r) { const bool ok = (lane + 64 * r) < nv; sc[h][r] = ok ? sc[h][r] * scale : -1e30f; mx = fmaxf(mx, sc[h][r]); }
                mx = wave_max(mx); float sm = 0.f;
#pragma unroll
                for (int r = 0; r < 4; ++r) { const bool ok = (lane + 64 * r) < nv; sc[h][r] = ok ? __expf(sc[h][r] - mx) : 0.f; sm += sc[h][r]; }
                sm = wave_sum(sm); const float inv = 1.f / sm;
#pragma unroll
                for (int r = 0; r < 4; ++r) { const float p = sc[h][r] * inv; ps[h * 256 + lane + 64 * r] = p; ps_r[r] += p; } }
#pragma unroll
            for (int r = 0; r < 4; ++r) psum[lane + 64 * r] = ps_r[r];
            LDS_WAIT();
            for (int i = 0; i < nv; ++i) { const f32x2 vv = *(const f32x2*)(vcb + (size_t)i * 128 + 2 * lane);
#pragma unroll
                for (int h = 0; h < 4; ++h) { const float p = ps[h * 256 + i]; oc[h][0] += p * vv.x; oc[h][1] += p * vv.y; } }
        }
        LDS_WAIT();
        const int cur = t >> 6;
        float imp = 0.f;
        { const int i0 = (4 * lane - 1) < 0 ? 0 : 4 * lane - 1, i1 = (4 * lane + 3) > 254 ? 254 : 4 * lane + 3;
          for (int i = i0; i <= i1; ++i) imp += psum[i]; }
        const bool forced = (lane == 0) || (lane <= cur && lane > cur - 3), future = lane > cur;
        const float score = forced ? 1e30f : (future ? -1e30f : imp);
        int rank = 0;
        for (int k = 0; k < 64; ++k) { const float sk = __shfl(score, k); rank += (sk > score || (sk == score && k < lane)) ? 1 : 0; }
        const unsigned long long selmask = __ballot(rank < 16);
        LDS_WAIT();
        float m1[4] = {-1e30f, -1e30f, -1e30f, -1e30f}, l1[4] = {0.f, 0.f, 0.f, 0.f}, o1[4][2] = {{0.f, 0.f}, {0.f, 0.f}, {0.f, 0.f}, {0.f, 0.f}};
        const bf16* ksb = T + 2 * NT_STRIDE + (size_t)bg * 4096 * 128; const bf16* vsb = T + 3 * NT_STRIDE + (size_t)bg * 4096 * 128;
        for (int k = 0; k <= cur; ++k) { if (!((selmask >> k) & 1ull)) continue;
            nsa_block(ksb + (size_t)k * 64 * 128, vsb + (size_t)k * 64 * 128, (k * 64 + lane) <= t, qs, ps, lane, m1, l1, o1); }
        float m2[4] = {-1e30f, -1e30f, -1e30f, -1e30f}, l2[4] = {0.f, 0.f, 0.f, 0.f}, o2[4][2] = {{0.f, 0.f}, {0.f, 0.f}, {0.f, 0.f}, {0.f, 0.f}};
        const bf16* kwb = T + 4 * NT_STRIDE + (size_t)bg * 4096 * 128; const bf16* vwb = T + 5 * NT_STRIDE + (size_t)bg * 4096 * 128;
        const int lo = (t - 511) < 0 ? 0 : (t - 511);
        for (int k = lo >> 6; k <= cur; ++k) { const int pos = k * 64 + lane;
            nsa_block(kwb + (size_t)k * 64 * 128, vwb + (size_t)k * 64 * 128, pos <= t && pos >= lo, qs, ps, lane, m2, l2, o2); }
#pragma unroll
        for (int h = 0; h < 4; ++h) { const float* gl = Gt + (size_t)row * 48 + (g * 4 + h) * 3; const float g0 = sigmoidf_(gl[0]), g1 = sigmoidf_(gl[1]), g2 = sigmoidf_(gl[2]);
            const float i1 = 1.f / l1[h], i2 = 1.f / l2[h];
            const float a = g0 * oc[h][0] + g1 * o1[h][0] * i1 + g2 * o2[h][0] * i2, bq = g0 * oc[h][1] + g1 * o1[h][1] * i1 + g2 * o2[h][1] * i2;
            *(unsigned*)(OUT + (size_t)row * 2048 + (g * 4 + h) * 128 + 2 * lane) = pk2(a, bq); }
        LDS_WAIT();
    }
}


namespace fa {
constexpr int KS_STRIDE = 272, VT_STRIDE = 144, KS_BYTES = 64 * KS_STRIDE, VT_BYTES = 128 * VT_STRIDE, BUF_BYTES = KS_BYTES + VT_BYTES;
constexpr int PS_OFF = 2 * BUF_BYTES, PS_STRIDE = 260, SM_OFF = PS_OFF + 64 * PS_STRIDE * 4;
constexpr float C2 = 0.08838834764831845f * 1.4426950408889634f;
struct Src { const bf16* K; size_t kstride; const bf16* Vt; size_t vstride; };
struct Stage { v4u k[2], v[2]; };
template <bool WITH_V> __device__ __forceinline__ void load_tile(const Src& s, int key0, int tid, Stage& st) {
#pragma unroll
    for (int e = 0; e < 2; ++e) { const int cc = tid + 512 * e;
        st.k[e] = *(const v4u*)(s.K + (size_t)(key0 + (cc >> 4)) * s.kstride + (cc & 15) * 8);
        if constexpr (WITH_V) st.v[e] = *(const v4u*)(s.Vt + (size_t)(cc >> 3) * s.vstride + key0 + (cc & 7) * 8); }
}
template <bool WITH_V> __device__ __forceinline__ void store_tile(LAS unsigned char* buf, int tid, const Stage& st) {
#pragma unroll
    for (int e = 0; e < 2; ++e) { const int cc = tid + 512 * e;
        *(LAS v4u*)(buf + (cc >> 4) * KS_STRIDE + (cc & 15) * 16) = st.k[e];
        if constexpr (WITH_V) *(LAS v4u*)(buf + KS_BYTES + (cc >> 3) * VT_STRIDE + (cc & 7) * 16) = st.v[e]; }
}
struct NoMask { __device__ __forceinline__ bool valid(int, int, int) const { return true; } __device__ __forceinline__ bool need(int) const { return false; } };
struct CmpMask { int nvq[2]; __device__ __forceinline__ bool valid(int kb, int ko, int mi) const { return kb * 64 + ko < nvq[mi]; } __device__ __forceinline__ bool need(int kb) const { return !__all(kb * 64 + 64 <= nvq[0] && kb * 64 + 64 <= nvq[1]); } };
struct SelMask { int tq[2]; unsigned long long sm[2]; int qb; __device__ __forceinline__ bool valid(int kb, int ko, int mi) const { return ((sm[mi] >> kb) & 1ull) && (kb * 64 + ko <= tq[mi]); }
    __device__ __forceinline__ bool need(int kb) const { return kb == qb || !__all((int)((sm[0] >> kb) & (sm[1] >> kb) & 1ull)); } };
struct WinMask { int tq[2]; int qb; __device__ __forceinline__ bool valid(int kb, int ko, int mi) const { const int kp = kb * 64 + ko; return kp <= tq[mi] && kp + 511 >= tq[mi]; } __device__ __forceinline__ bool need(int kb) const { return kb == qb || kb + 8 <= qb; } };

template <int MODE, class MaskF>
__device__ __forceinline__ void tile_qk(const LAS unsigned char* buf, const bf16x8 (&Qf)[2][4], f32x4 (&O)[8][2], float (&m)[2], float (&l)[2], const float (&invl)[2],
                                        int kb, const MaskF& mf, LAS float* PS, int wave, int l15, int lg, bf16x8 (&Pf)[2][2], f32x4 (&OL)[2]) {
    f32x4 S[4][2];
#pragma unroll
    for (int nt = 0; nt < 4; ++nt)
#pragma unroll
        for (int mi = 0; mi < 2; ++mi) S[nt][mi] = (f32x4){0.f, 0.f, 0.f, 0.f};
    const LAS unsigned char* kbase = buf + l15 * KS_STRIDE + lg * 16;
    bf16x8 kf[2][2];
#pragma unroll
    for (int q = 0; q < 2; ++q) kf[0][q] = *(const LAS bf16x8*)(kbase + q * 16 * KS_STRIDE);
#pragma unroll
    for (int h = 0; h < 8; ++h) { const int ks = h >> 1, n0 = (h & 1) * 2;
        if (h < 7) { const int ks1 = (h + 1) >> 1, n1 = ((h + 1) & 1) * 2;
#pragma unroll
            for (int q = 0; q < 2; ++q) kf[(h + 1) & 1][q] = *(const LAS bf16x8*)(kbase + (n1 + q) * 16 * KS_STRIDE + ks1 * 64); }
        __builtin_amdgcn_sched_barrier(0);
        __builtin_amdgcn_s_setprio(1);
#pragma unroll
        for (int q = 0; q < 2; ++q)
#pragma unroll
            for (int mi = 0; mi < 2; ++mi) S[n0 + q][mi] = __builtin_amdgcn_mfma_f32_16x16x32_bf16(kf[h & 1][q], Qf[mi][ks], S[n0 + q][mi], 0, 0, 0);
        __builtin_amdgcn_s_setprio(0);
        __builtin_amdgcn_sched_barrier(0);
    }
    const float NEG = -__builtin_inff();
    float mx[2] = {NEG, NEG};
    if (mf.need(kb)) {
#pragma unroll
        for (int nt = 0; nt < 4; ++nt)
#pragma unroll
            for (int mi = 0; mi < 2; ++mi)
#pragma unroll
                for (int r = 0; r < 4; ++r) { const float sv = mf.valid(kb, 16 * nt + 4 * lg + r, mi) ? S[nt][mi][r] : NEG; S[nt][mi][r] = sv; mx[mi] = fmaxf(mx[mi], sv); }
    } else {
#pragma unroll
        for (int nt = 0; nt < 4; ++nt)
#pragma unroll
            for (int mi = 0; mi < 2; ++mi)
#pragma unroll
                for (int r = 0; r < 4; ++r) mx[mi] = fmaxf(mx[mi], S[nt][mi][r]);
    }
#pragma unroll
    for (int mi = 0; mi < 2; ++mi) {
        float ref;
        if constexpr (MODE == 2) { ref = m[mi]; }
        else { float t = fmaxf(mx[mi], __shfl_xor(mx[mi], 16)); t = fmaxf(t, __shfl_xor(t, 32)); t *= C2;
            if (__all(t <= m[mi] + 6.0f)) { ref = m[mi]; }
            else { const float mn = fmaxf(m[mi], t); const float alpha = __builtin_amdgcn_exp2f(m[mi] - mn); m[mi] = mn; ref = mn;
                if constexpr (MODE == 0) { OL[mi] *= alpha;
#pragma unroll
                    for (int dt = 0; dt < 8; ++dt) O[dt][mi] *= alpha; }
                else l[mi] *= alpha; } }
        float ps = 0.f;
#pragma unroll
        for (int nt = 0; nt < 4; ++nt)
#pragma unroll
            for (int r = 0; r < 4; ++r) { float p = __builtin_amdgcn_exp2f(__builtin_fmaf(S[nt][mi][r], C2, -ref)); if constexpr (MODE == 2) p *= invl[mi]; S[nt][mi][r] = p; if constexpr (MODE == 1) ps += p; }
        if constexpr (MODE == 1) l[mi] += ps;
    }
    if constexpr (MODE == 2) {
#pragma unroll
        for (int nt = 0; nt < 4; ++nt)
#pragma unroll
            for (int mi = 0; mi < 2; ++mi) { f32x4 v = S[nt][mi];
#pragma unroll
                for (int r = 0; r < 4; ++r) { v[r] += __shfl_xor(v[r], 1); v[r] += __shfl_xor(v[r], 2); }
                if ((l15 & 3) == 0) *(LAS f32x4*)(PS + ((32 * wave + 16 * mi + l15) >> 2) * PS_STRIDE + 64 * kb + 16 * nt + 4 * lg) = v; }
    }
    if constexpr (MODE != 1) {
#pragma unroll
        for (int mi = 0; mi < 2; ++mi)
#pragma unroll
            for (int k2 = 0; k2 < 2; ++k2) { v4u w; w.x = pg8::cvt_pk_bf16(S[2 * k2][mi][0], S[2 * k2][mi][1]); w.y = pg8::cvt_pk_bf16(S[2 * k2][mi][2], S[2 * k2][mi][3]);
                w.z = pg8::cvt_pk_bf16(S[2 * k2 + 1][mi][0], S[2 * k2 + 1][mi][1]); w.w = pg8::cvt_pk_bf16(S[2 * k2 + 1][mi][2], S[2 * k2 + 1][mi][3]); Pf[mi][k2] = __builtin_bit_cast(bf16x8, w); }
    }
}
__device__ __forceinline__ void tile_pv(const LAS unsigned char* buf, const bf16x8 (&Pf)[2][2], f32x4 (&O)[8][2], int l15, int lg, f32x4 (&OL)[2], bool with_l) {
    if (with_l) { v4u ow; ow.x = ow.y = ow.z = ow.w = 0x3F803F80u; const bf16x8 ones = __builtin_bit_cast(bf16x8, ow);
#pragma unroll
        for (int k2 = 0; k2 < 2; ++k2)
#pragma unroll
            for (int mi = 0; mi < 2; ++mi) OL[mi] = __builtin_amdgcn_mfma_f32_16x16x32_bf16(ones, Pf[mi][k2], OL[mi], 0, 0, 0); }
    const LAS unsigned char* vbase = buf + KS_BYTES + l15 * VT_STRIDE + lg * 8;
    v2u va[2][2][2];
#define FA_LDV(slot_, g_) do { _Pragma("unroll") for (int q = 0; q < 2; ++q) { const int dt_ = ((g_) & 3) * 2 + q, k2_ = (g_) >> 2; \
        va[slot_][q][0] = *(const LAS v2u*)(vbase + dt_ * 16 * VT_STRIDE + k2_ * 64); va[slot_][q][1] = *(const LAS v2u*)(vbase + dt_ * 16 * VT_STRIDE + k2_ * 64 + 32); } } while (0)
    FA_LDV(0, 0);
#pragma unroll
    for (int g = 0; g < 8; ++g) {
        if (g < 7) FA_LDV((g + 1) & 1, g + 1);
        __builtin_amdgcn_sched_barrier(0);
        __builtin_amdgcn_s_setprio(1);
#pragma unroll
        for (int q = 0; q < 2; ++q) { const int dt = (g & 3) * 2 + q, k2 = g >> 2; v4u w; w.x = va[g & 1][q][0].x; w.y = va[g & 1][q][0].y; w.z = va[g & 1][q][1].x; w.w = va[g & 1][q][1].y; const bf16x8 vf = __builtin_bit_cast(bf16x8, w);
#pragma unroll
            for (int mi = 0; mi < 2; ++mi) O[dt][mi] = __builtin_amdgcn_mfma_f32_16x16x32_bf16(vf, Pf[mi][k2], O[dt][mi], 0, 0, 0); }
        __builtin_amdgcn_s_setprio(0);
        __builtin_amdgcn_sched_barrier(0);
    }
#undef FA_LDV
}
template <int MODE, class MaskF>
__device__ __forceinline__ void run(LAS unsigned char* lds, const Src& src, unsigned long long tiles, const bf16x8 (&Qf)[2][4], f32x4 (&O)[8][2], float (&m)[2], float (&l)[2], const float (&invl)[2],
                                    const MaskF& mf, int tid, int wave, int l15, int lg) {
    if (tiles == 0ull) return;
    int kb = __builtin_ctzll(tiles); tiles &= tiles - 1ull; int cur = 0;
    f32x4 OL[2]; OL[0] = (f32x4){0.f, 0.f, 0.f, 0.f}; OL[1] = (f32x4){0.f, 0.f, 0.f, 0.f};
    { Stage st; load_tile<MODE != 1>(src, kb * 64, tid, st); store_tile<MODE != 1>(lds, tid, st); }
    __syncthreads();
    for (;;) {
        const bool more = tiles != 0ull; int nkb = 0;
        if (more) { nkb = __builtin_ctzll(tiles); tiles &= tiles - 1ull; }
        bf16x8 Pf[2][2];
        tile_qk<MODE>(lds + cur * BUF_BYTES, Qf, O, m, l, invl, kb, mf, (LAS float*)(lds + PS_OFF), wave, l15, lg, Pf, OL);
        __builtin_amdgcn_sched_barrier(0);
        Stage st;
        if (more) load_tile<MODE != 1>(src, nkb * 64, tid, st);
        if constexpr (MODE != 1) tile_pv(lds + cur * BUF_BYTES, Pf, O, l15, lg, OL, MODE == 0);
        if (more) store_tile<MODE != 1>(lds + (cur ^ 1) * BUF_BYTES, tid, st);
        __syncthreads();
        if (!more) break;
        kb = nkb; cur ^= 1;
    }
    if constexpr (MODE == 0) { l[0] = OL[0][0] * 0.25f; l[1] = OL[1][0] * 0.25f; }
}
}

__device__ __forceinline__ void xa_attn_fa(const Ctx& c, const bf16* Q, const bf16* KV, const bf16* XVT, bf16* Oo) {
    const int l15 = c.lane & 15, lg = c.lane >> 4;
    for (int u_ = c.vcu; u_ < (PROBE == 12 ? 512 : 256); u_ += c.G) {
        const int u = u_ & 255; const int bh = u >> 4, chunk = u & 15, b = bh >> 2, hd = bh & 3;
        bf16x8 Qf[2][4]; size_t grow[2];
#pragma unroll
        for (int mi = 0; mi < 2; ++mi) { grow[mi] = (size_t)b * SEQ + chunk * 256 + 32 * c.wave + 16 * mi + l15;
#pragma unroll
            for (int ks = 0; ks < 4; ++ks) Qf[mi][ks] = *(const bf16x8*)(Q + grow[mi] * 512 + hd * 128 + 32 * ks + 8 * lg); }
        f32x4 O[8][2]; float m[2] = {-1e30f, -1e30f}, l[2] = {0.f, 0.f}; const float invl[2] = {0.f, 0.f};
#pragma unroll
        for (int dt = 0; dt < 8; ++dt) { O[dt][0] = (f32x4){0.f, 0.f, 0.f, 0.f}; O[dt][1] = (f32x4){0.f, 0.f, 0.f, 0.f}; }
        fa::Src src{KV + (size_t)b * 256 * 1024 + hd * 128, 1024, XVT + (size_t)bh * 128 * 256, 256};
        fa::run<0>(c.lds, src, 0xFull, Qf, O, m, l, invl, fa::NoMask{}, c.tid, c.wave, l15, lg);
#pragma unroll
        for (int mi = 0; mi < 2; ++mi) { float lt = l[mi]; lt += __shfl_xor(lt, 16); lt += __shfl_xor(lt, 32); const float il = 1.f / lt;
#pragma unroll
            for (int dt = 0; dt < 8; ++dt) { const f32x4 o = O[dt][mi] * il; v2u w; w.x = pk2(o[0], o[1]); w.y = pk2(o[2], o[3]);
                *(v2u*)(Oo + grow[mi] * 512 + hd * 128 + 16 * dt + 4 * lg) = w; } }
    }
}
__device__ __forceinline__ void xa_vt(const Ctx& c, const bf16* KV, bf16* XVT) {
    for (int it = c.vcu * 512 + c.tid; it < 16 * 128 * 32; it += c.G * 512) {
        const int m8 = it & 31, d = (it >> 5) & 127, bh = it >> 12, b = bh >> 2, hd = bh & 3; unsigned short v[8];
#pragma unroll
        for (int j = 0; j < 8; ++j) v[j] = KV[(size_t)(b * 256 + m8 * 8 + j) * 1024 + 512 + hd * 128 + d];
        v4u w; w.x = v[0] | ((unsigned)v[1] << 16); w.y = v[2] | ((unsigned)v[3] << 16); w.z = v[4] | ((unsigned)v[5] << 16); w.w = v[6] | ((unsigned)v[7] << 16);
        *(v4u*)(XVT + ((size_t)bh * 128 + d) * 256 + m8 * 8) = w;
    }
}
__device__ __forceinline__ void nsa_vt(const Ctx& c, const bf16* T, bf16* VT) {
    LAS unsigned short* Tt = (LAS unsigned short*)c.lds;
    for (int it = c.vcu; it < 2 * 16 * 64; it += c.G) {
        const int tb = it & 63, bg = (it >> 6) & 15, which = it >> 10; const bf16* src = T + (size_t)(3 + 2 * which) * NT_STRIDE + ((size_t)bg * 4096 + tb * 64) * 128;
        __syncthreads();
#pragma unroll
        for (int e = 0; e < 2; ++e) { const int cc = c.tid + 512 * e, key = cc >> 4, d8 = cc & 15; const v4u v = *(const v4u*)(src + (size_t)key * 128 + d8 * 8);
#pragma unroll
            for (int j = 0; j < 4; ++j) { Tt[(d8 * 8 + 2 * j) * 72 + key] = (unsigned short)(v[j] & 0xffffu); Tt[(d8 * 8 + 2 * j + 1) * 72 + key] = (unsigned short)(v[j] >> 16); } }
        __syncthreads();
#pragma unroll
        for (int e = 0; e < 2; ++e) { const int cc = c.tid + 512 * e, d = cc >> 3, k8 = cc & 7;
            *(v4u*)(VT + ((size_t)(which * 16 + bg) * 128 + d) * 4096 + tb * 64 + k8 * 8) = *(const LAS v4u*)((const LAS unsigned char*)Tt + d * 144 + k8 * 16); }
    }
    __syncthreads();
}
__device__ __forceinline__ void nsa_hidreduce(const Ctx& c, const float* HIDP, const float* pb, bf16* HID) {
    for (int it = c.vcu * 512 + c.tid; it < 8192 * 32; it += c.G * 512) {
        const int r = it >> 5, h0 = (it & 31) * 8, ten = r >> 12; const float* hrow = HIDP + (size_t)r * 2048 + h0;
        f32x4 a0 = *(const f32x4*)(pb + ten * 256 + h0), a1 = *(const f32x4*)(pb + ten * 256 + h0 + 4);
#pragma unroll
        for (int sp = 0; sp < 8; ++sp) { a0 += *(const f32x4*)(hrow + sp * 256); a1 += *(const f32x4*)(hrow + sp * 256 + 4); }
        v4u o; o.x = pk2(gelu_tanh(a0.x), gelu_tanh(a0.y)); o.y = pk2(gelu_tanh(a0.z), gelu_tanh(a0.w)); o.z = pk2(gelu_tanh(a1.x), gelu_tanh(a1.y)); o.w = pk2(gelu_tanh(a1.z), gelu_tanh(a1.w));
        *(v4u*)(HID + (size_t)r * 256 + h0) = o;
    }
}
__device__ __forceinline__ void nsa_w2b(const Ctx& c, const bf16* HID, const float* w2, bf16* KCb, bf16* VCT) {
    for (int it = c.vcu * 512 + c.tid; it < 8192 * 16; it += c.G * 512) {
        const int r = it >> 4, d0 = (it & 15) * 8, ten = r >> 12, bg = (r >> 8) & 15, i = r & 255; const bf16* hrow = HID + (size_t)r * 256; const float* w = w2 + (size_t)ten * 256 * 128 + d0;
        float a[8];
#pragma unroll
        for (int j = 0; j < 8; ++j) a[j] = 0.f;
#pragma unroll 4
        for (int h8 = 0; h8 < 32; ++h8) { const v4u hv = *(const v4u*)(hrow + h8 * 8);
#pragma unroll
            for (int q = 0; q < 8; ++q) { const float hf = (q & 1) ? bfhi(hv[q >> 1]) : bflo(hv[q >> 1]); const f32x4 w0 = *(const f32x4*)(w + (size_t)(h8 * 8 + q) * 128), w1 = *(const f32x4*)(w + (size_t)(h8 * 8 + q) * 128 + 4);
                a[0] += hf * w0.x; a[1] += hf * w0.y; a[2] += hf * w0.z; a[3] += hf * w0.w; a[4] += hf * w1.x; a[5] += hf * w1.y; a[6] += hf * w1.z; a[7] += hf * w1.w; } }
        if (ten == 0) { v4u o; o.x = pk2(a[0], a[1]); o.y = pk2(a[2], a[3]); o.z = pk2(a[4], a[5]); o.w = pk2(a[6], a[7]); *(v4u*)(KCb + ((size_t)bg * 256 + i) * 128 + d0) = o; }
        else {
#pragma unroll
            for (int j = 0; j < 8; ++j) VCT[((size_t)bg * 128 + d0 + j) * 256 + i] = (bf16)f2bf(a[j]); }
    }
}
#define NSA_UNIT_PROLOGUE \
        const int ui = uu >> 8, slot = uu & 255; \
        const int bg = 2 * (slot >> 5) + (slot & 1), x = (slot & 31) >> 1, qb = (ui == 0) ? x : (ui == 1) ? 31 - x : (ui == 2) ? 32 + x : 63 - x;   \
        const int b = bg >> 2, g = bg & 3, t0 = qb * 64; \
        bf16x8 Qf[2][4]; int grow[2]; int tq[2], hcol[2]; \
        _Pragma("unroll") for (int mi = 0; mi < 2; ++mi) { const int qrow = 32 * c.wave + 16 * mi + l15, tl = qrow >> 2, j = qrow & 3; tq[mi] = t0 + tl; grow[mi] = b * SEQ + tq[mi]; hcol[mi] = (g * 4 + j) * 128; \
            _Pragma("unroll") for (int ks = 0; ks < 4; ++ks) Qf[mi][ks] = *(const bf16x8*)(Q + (size_t)grow[mi] * 2048 + hcol[mi] + 32 * ks + 8 * lg); }
__device__ __forceinline__ void nsa_attn_cmp(const Ctx& c, const bf16* Q, const bf16* KCb, const bf16* VCT, const float* Gt, float* NACC, unsigned long long* SMg) {
    const int l15 = c.lane & 15, lg = c.lane >> 4, lane = c.lane;
    LAS float* PS = (LAS float*)(c.lds + fa::PS_OFF);
#if PROBE == 9
#pragma unroll 1
    for (int rep_ = 0; rep_ < 2; ++rep_)
#endif
    for (int uu = c.vcu; uu < 1024; uu += c.G) {
        NSA_UNIT_PROLOGUE
        f32x4 O[8][2]; float m[2], l[2], invl[2] = {0.f, 0.f};
        const int tmax = t0 + 63, nvmax = tmax >= 31 ? ((tmax - 31) >> 4) + 1 : 0, ntile = (nvmax + 63) >> 6;
        { const unsigned long long tiles = (1ull << ntile) - 1ull;
          fa::CmpMask mk; mk.nvq[0] = tq[0] >= 31 ? ((tq[0] - 31) >> 4) + 1 : 0; mk.nvq[1] = tq[1] >= 31 ? ((tq[1] - 31) >> 4) + 1 : 0;
          fa::Src src{KCb + (size_t)bg * 256 * 128, 128, VCT + (size_t)bg * 128 * 256, 256};
          m[0] = m[1] = -1e30f; l[0] = l[1] = 0.f;
          fa::run<1>(c.lds, src, tiles, Qf, O, m, l, invl, mk, c.tid, c.wave, l15, lg);
#pragma unroll
          for (int mi = 0; mi < 2; ++mi) { float lt = l[mi]; lt += __shfl_xor(lt, 16); lt += __shfl_xor(lt, 32); invl[mi] = lt > 0.f ? 1.f / lt : 0.f; }
#pragma unroll
          for (int dt = 0; dt < 8; ++dt) { O[dt][0] = (f32x4){0.f, 0.f, 0.f, 0.f}; O[dt][1] = (f32x4){0.f, 0.f, 0.f, 0.f}; }
          fa::run<2>(c.lds, src, tiles, Qf, O, m, l, invl, mk, c.tid, c.wave, l15, lg);
#pragma unroll
          for (int mi = 0; mi < 2; ++mi) { const float g0 = sigmoidf_(Gt[(size_t)grow[mi] * 48 + (hcol[mi] >> 7) * 3 + 0]);
#pragma unroll
              for (int dt = 0; dt < 8; ++dt) *(f32x4*)(NACC + (size_t)grow[mi] * 2048 + hcol[mi] + 16 * dt + 4 * lg) = O[dt][mi] * g0; }
        }
        __syncthreads();
        for (int i = 0; i < 8; ++i) { const int tl = 8 * c.wave + i; const LAS float* pr = PS + tl * fa::PS_STRIDE; float imp = 0.f;
            { const int i0 = (4 * lane - 1) < 0 ? 0 : 4 * lane - 1; int i1 = (4 * lane + 3) > 254 ? 254 : 4 * lane + 3; if (i1 > 64 * ntile - 1) i1 = 64 * ntile - 1; for (int q = i0; q <= i1; ++q) imp += pr[q]; }
            const bool forced = (lane == 0) || (lane <= qb && lane > qb - 3), future = lane > qb;
            const float score = forced ? 1e30f : (future ? -1e30f : imp); int rank = 0;
            for (int k = 0; k < 64; ++k) { const float sk = __shfl(score, k); rank += (sk > score || (sk == score && k < lane)) ? 1 : 0; }
            const unsigned long long sel = __ballot(rank < 16); if (lane == 0) SMg[(size_t)bg * SEQ + t0 + tl] = sel; }
        __syncthreads();
    }
}
__device__ __forceinline__ void nsa_attn_sw(const Ctx& c, const bf16* Q, const bf16* T, const bf16* VT, const float* Gt, const float* NACC, float* NACC2, const unsigned long long* SMg, bf16* OUT) {
    const int l15 = c.lane & 15, lg = c.lane >> 4, lane = c.lane;
    for (int uu_ = c.vcu; uu_ < (PROBE == 21 ? 2048 : 1024); uu_ += c.G) { const int uu = uu_ & 1023;
        NSA_UNIT_PROLOGUE
        unsigned long long um = SMg[(size_t)bg * SEQ + t0 + lane];
#pragma unroll
        for (int o = 1; o < 64; o <<= 1) { const unsigned lo_ = __shfl_xor((unsigned)um, o), hi_ = __shfl_xor((unsigned)(um >> 32), o); um |= ((unsigned long long)hi_ << 32) | lo_; }
        const unsigned long long umu = ((unsigned long long)__builtin_amdgcn_readfirstlane((unsigned)(um >> 32)) << 32) | (unsigned)__builtin_amdgcn_readfirstlane((unsigned)um);
        f32x4 O[8][2]; float m[2], l[2]; const float invl[2] = {0.f, 0.f};
        { fa::SelMask mk; mk.qb = qb; mk.tq[0] = tq[0]; mk.tq[1] = tq[1]; mk.sm[0] = SMg[(size_t)bg * SEQ + tq[0]]; mk.sm[1] = SMg[(size_t)bg * SEQ + tq[1]];
          const unsigned long long tiles = umu & ((2ull << qb) - 1ull);
          fa::Src src{T + 2 * NT_STRIDE + (size_t)bg * 4096 * 128, 128, VT + (size_t)bg * 128 * 4096, 4096};
          m[0] = m[1] = -1e30f; l[0] = l[1] = 0.f;
#pragma unroll
          for (int dt = 0; dt < 8; ++dt) { O[dt][0] = (f32x4){0.f, 0.f, 0.f, 0.f}; O[dt][1] = (f32x4){0.f, 0.f, 0.f, 0.f}; }
          fa::run<0>(c.lds, src, tiles, Qf, O, m, l, invl, mk, c.tid, c.wave, l15, lg);
#pragma unroll
          for (int mi = 0; mi < 2; ++mi) { float lt = l[mi]; lt += __shfl_xor(lt, 16); lt += __shfl_xor(lt, 32); const float sc = sigmoidf_(Gt[(size_t)grow[mi] * 48 + (hcol[mi] >> 7) * 3 + 1]) / lt;
#pragma unroll
              for (int dt = 0; dt < 8; ++dt) { const size_t off = (size_t)grow[mi] * 2048 + hcol[mi] + 16 * dt + 4 * lg; *(f32x4*)(NACC2 + off) = *(const f32x4*)(NACC + off) + O[dt][mi] * sc; } }
        }
        { fa::WinMask mk; mk.qb = qb; mk.tq[0] = tq[0]; mk.tq[1] = tq[1];
          const int kb0 = qb - 8 < 0 ? 0 : qb - 8; const unsigned long long tiles = ((2ull << qb) - 1ull) & ~((1ull << kb0) - 1ull);
          fa::Src src{T + 4 * NT_STRIDE + (size_t)bg * 4096 * 128, 128, VT + (size_t)(16 + bg) * 128 * 4096, 4096};
          m[0] = m[1] = -1e30f; l[0] = l[1] = 0.f;
#pragma unroll
          for (int dt = 0; dt < 8; ++dt) { O[dt][0] = (f32x4){0.f, 0.f, 0.f, 0.f}; O[dt][1] = (f32x4){0.f, 0.f, 0.f, 0.f}; }
          fa::run<0>(c.lds, src, tiles, Qf, O, m, l, invl, mk, c.tid, c.wave, l15, lg);
#pragma unroll
          for (int mi = 0; mi < 2; ++mi) { float lt = l[mi]; lt += __shfl_xor(lt, 16); lt += __shfl_xor(lt, 32); const float sc = sigmoidf_(Gt[(size_t)grow[mi] * 48 + (hcol[mi] >> 7) * 3 + 2]) / lt;
#pragma unroll
              for (int dt = 0; dt < 8; ++dt) { const f32x4 a = *(const f32x4*)(NACC2 + (size_t)grow[mi] * 2048 + hcol[mi] + 16 * dt + 4 * lg) + O[dt][mi] * sc; v2u w_; w_.x = pk2(a[0], a[1]); w_.y = pk2(a[2], a[3]);
                  *(v2u*)(OUT + (size_t)grow[mi] * 2048 + hcol[mi] + 16 * dt + 4 * lg) = w_; } }
        }
    }
}

struct Args { const float* in[35]; float* out; unsigned char* ws; int ph_lo, ph_hi; };
constexpr int NPH = 16, N_PHASES = 4 * NPH;


#define IN(k) (lo <= (k) && (k) < hi)
#if MK_MULTI
#define SEAM(k) do { } while (0)
#else
#if PROBE == 4
#define SEAM(k) do { if (IN(k) && IN((k) + 1)) { xcd_barrier(bar); xcd_barrier(bar); } } while (0)
#else
#define SEAM(k) do { if (IN(k) && IN((k) + 1)) xcd_barrier(bar); } while (0)
#endif
#endif
template <int L>
__device__ __forceinline__ void layer_body(const Ctx& c, const Args& args, const XcdBarrier& bar, int lo, int hi) {
    constexpr int P0 = L * NPH;
    unsigned char* ws = args.ws;
    const float* x_in = args.in[0]; const float* mem = args.in[1]; const float* norm_pre = args.in[2]; const float* norm_post = args.in[3]; const float* norm_mem = args.in[4];
    float* X = args.out;
    bf16* XB = (bf16*)(ws + WS_H); float* RS = (float*)(ws + WS_PB + 256 * 1024); bf16* POOLED = (bf16*)(ws + WS_ACT + 64 * MiB); (void)POOLED; bf16* PROJ = (bf16*)(ws + WS_PROJ); float* MF = (float*)(ws + WS_PROJ); bf16* MFb = (bf16*)(ws + WS_PROJ); bf16* ACT = (bf16*)(ws + WS_ACT);
    bf16* XQ = (bf16*)(ws + WS_Q); bf16* XO = (bf16*)(ws + WS_O); bf16* KV = (bf16*)(ws + WS_KV); bf16* MEMN = (bf16*)(ws + WS_MEMN); float* DT = (float*)(ws + WS_DT); float* PB = (float*)(ws + WS_PB); float* PBP = (float*)(ws + WS_PB + 4096); (void)PBP;
    bf16* NQ = (bf16*)(ws + WS_NQ); bf16* NT = (bf16*)(ws + WS_NT); bf16* NHID = (bf16*)(ws + WS_NHID); float* NKC = (float*)(ws + WS_NKC); float* NG = (float*)(ws + WS_NG);
    bf16* Wmi = (bf16*)(ws + W_MIX_IN); bf16* Wmo = (bf16*)(ws + W_MIX_OUT); bf16* Wmx = (bf16*)(ws + W_MIX_X);
    bf16* Wxq = (bf16*)(ws + W_XQ); bf16* Wxkv = (bf16*)(ws + W_XKV); bf16* Wxo = (bf16*)(ws + W_XO); bf16* Wup = (bf16*)(ws + W_UP); bf16* Wdn = (bf16*)(ws + W_DOWN);
    const int cid = (int)blockIdx.x;
    bf16* NVT = (bf16*)(ws + WS_NVT); bf16* XVT = (bf16*)(ws + WS_XVT); bf16* KCb = (bf16*)(ws + WS_NKC); bf16* VCT = (bf16*)(ws + WS_NKC + 1 * MiB); unsigned long long* SMg = (unsigned long long*)(ws + WS_NKC + 2 * MiB);
    (void)x_in; (void)DT; (void)PB; (void)NQ; (void)NT; (void)NHID; (void)NKC; (void)NG; (void)Wmx; (void)NVT; (void)KCb; (void)VCT; (void)SMg;

        if (IN(P0 + 0))
#if PROBE == 11
#pragma unroll 1
        for (int rep_ = 0; rep_ < 2; ++rep_)
#endif
        {
            if constexpr (L == 0) { conv_w(c, args.in[5], 2048, SSD_IN, SSD_NP, Wmi, norm_pre + (L * 3) * DM); conv_w(c, args.in[12], 4096, 2048, 2048, Wmo); }
            if constexpr (L == 1) nsa_posbias(c, args.in[14], args.in[15], PBP);
            conv_w(c, args.in[28] + (size_t)L * 2048 * 512, 2048, 512, 512, Wxq, norm_pre + (L * 3 + 1) * DM, false, c.gw, c.NGW);
            conv_w(c, args.in[29] + (size_t)L * 2048 * 1024, 2048, 1024, 1024, Wxkv, nullptr, false, (c.gw + c.NGW - 256) % c.NGW, c.NGW);
            conv_w(c, args.in[30] + (size_t)L * 512 * 2048, 512, 2048, 2048, Wxo, nullptr, false, (c.gw + c.NGW - 768) % c.NGW, c.NGW);
            for (int r = (c.gw + c.NGW - 1024) % c.NGW; r < 1024; r += c.NGW) rms_row_bf16(c, mem + (size_t)r * DM, norm_mem + L * DM, MEMN + (size_t)r * DM, nullptr);
            if constexpr (L == 0) x_to_xb(c, x_in, XB, RS);
        }
        SEAM(P0 + 0);
        if (IN(P0 + 1)) {
            constexpr int NA = (L == 0) ? 11 : (L == 1) ? 6 : (L == 2) ? 8 : 2, NBU = (L == 0) ? 10 : (L == 1) ? 5 : (L == 2) ? 8 : 2;
            if ((cid >> 3) & 1) { const int ga = ((cid & 7) | ((cid >> 4) << 3)) * 8 + c.wave;
                conv_w(c, args.in[31] + (size_t)L * 2048 * FF2, 2048, FF2, FF2, Wup, norm_pre + (L * 3 + 2) * DM, true, ga, 1024);
                conv_w(c, args.in[34] + (size_t)L * FFH * 2048, FFH, 2048, 2048, Wdn, nullptr, false, ga, 1024); __syncthreads(); }
            if constexpr (L == 0) { pg8::ProbSplit S; S.init(XB, Wmi, 2048, 2048, 2048, 64, SSD_NP / 256, c.G, cid); S.nA = NA; S.nB = NBU; pg8::EpiP<StBf16> E{{PROJ, SSD_NP}, RS}; pg8::gemm_phase(c.lds, S, E); }
            else if constexpr (L == 1) { nsa_posbias_reduce(c, PBP, PB); pg8::ProbSplit S; S.init(XB, Wmi, 2048, 2048, 2048, 64, NSA_NP / 256, c.G, cid); S.nA = NA; S.nB = NBU; pg8::EpiP<StNsa> E{{NQ, NT, NG}, RS}; pg8::gemm_phase(c.lds, S, E); }
            else if constexpr (L == 2) { pg8::ProbSplit S; S.init(XB, Wmi, 2048, 2048, 2048, 64, 32, c.G, cid); S.nA = NA; S.nB = NBU; pg8::EpiP<StBf16BiasGelu> E{{PROJ, 8192, args.in[19]}, RS}; pg8::gemm_phase(c.lds, S, E); }
            else { pg8::ProbSplit S; S.init(XB, Wmi, 2048, 2048, 2048, 64, 8, c.G, cid); S.nA = NA; S.nB = NBU; pg8::EpiN<StF32> E{{MF, 2048}, RS}; pg8::gemm_phase(c.lds, S, E); }
        }
        SEAM(P0 + 1);
        if (IN(P0 + 2)) {
            if constexpr (L == 0) { ssd_conv(c, PROJ, args.in[6], args.in[7], args.in[8], ACT, DT);
#if PROBE == 11
                ssd_conv(c, PROJ, args.in[6], args.in[7], args.in[8], ACT, DT);
#endif
            }
            else if constexpr (L == 1) { pg8::ProbC S; S.init(NT, Wmx, 2048, 4096, 512, 32, 8, c.G, cid); S.a_tile_stride = (size_t)4096 * 128;
                pg8::EpiN<StF32> E{{(float*)(ws + WS_ACT), 2048}, nullptr}; pg8::gemm_phase(c.lds, S, E); nsa_vt(c, NT, NVT);
#if PROBE == 11
                nsa_vt(c, NT, NVT);
#endif
            }
            else if constexpr (L == 2) sgu_ln(c, PROJ, args.in[20]);
            else { pool_pool(c, MF, POOLED);
#if PROBE == 11
                pool_pool(c, MF, POOLED);
#endif
            }
        }
        SEAM(P0 + 2);
        if (IN(P0 + 3)) {
            if constexpr (L == 0) {
#if PROBE == 10
                ssd_scan_mfma(c, ACT, DT, args.in[9], args.in[10], lo < 0);
#endif
                ssd_scan_mfma(c, ACT, DT, args.in[9], args.in[10], true); }
            else if constexpr (L == 1) { nsa_hidreduce(c, (const float*)(ws + WS_ACT), PB, NHID); if (IN(P0 + 3) && IN(P0 + 4)) xcd_barrier(bar); nsa_w2b(c, NHID, args.in[16], KCb, VCT);
#if PROBE == 11
                nsa_hidreduce(c, (const float*)(ws + WS_ACT), PB, NHID); if (IN(P0 + 3) && IN(P0 + 4)) xcd_barrier(bar); nsa_w2b(c, NHID, args.in[16], KCb, VCT);
#endif
            }
            else if constexpr (L == 2) sgu_spatial_mfma(c, PROJ, args.in[21], args.in[22], ACT);
            else { pg8::Prob S; S.init(POOLED, Wmx, 2048, 512, 512, 64, 8, c.G, cid); S.a_group_shift = 1; S.a_group_cols = 512; pg8::EpiP<StBf16Scale> E{{ACT, 2048, args.in[26]}, nullptr}; pg8::gemm_phase(c.lds, S, E); }
        }
        SEAM(P0 + 3);
        if (IN(P0 + 4)) {
            if constexpr (L == 0) ssd_gnorm(c, ACT, PROJ, args.in[11]);
            else if constexpr (L == 1) nsa_attn_cmp(c, NQ, KCb, VCT, NG, MF, SMg);
        }
        if constexpr (L <= 1) SEAM(P0 + 4);
        if (IN(P0 + 5)) {
            if constexpr (L == 1) { nsa_attn_sw(c, NQ, NT, NVT, NG, MF, (float*)(ws + WS_ACT + 64 * MiB), SMg, ACT);
#if PROBE == 1
                nsa_attn_sw(c, NQ, NT, NVT, NG, MF, (float*)(ws + WS_ACT + 64 * MiB), SMg, ACT);
#endif
            }
        }
        if constexpr (L == 1) SEAM(P0 + 5);
        if (IN(P0 + 6)) {
            if constexpr (L == 0) { pg8::Prob S; S.init(ACT, Wmo, 6144, 4096, 4096, 64, 8, c.G, cid); pg8::EpiP<StBf16> E{{MFb, 2048}, nullptr}; pg8::gemm_phase(c.lds, S, E); }
            else if constexpr (L == 2) { pg8::Prob S; S.init(ACT, Wmo, 4096, 4096, 4096, 64, 8, c.G, cid); pg8::EpiP<StBf16> E{{MFb, 2048}, nullptr}; pg8::gemm_phase(c.lds, S, E); }
            else { pg8::Prob S; S.init(ACT, Wmo, 2048, 2048, 2048, 64, 8, c.G, cid); pg8::EpiP<StBf16> E{{MFb, 2048}, nullptr}; pg8::gemm_phase(c.lds, S, E); }
        }
        SEAM(P0 + 6);
        if (IN(P0 + 7)) postnorm(c, MFb, XB, RS, norm_post + (L * 3 + 0) * DM, nullptr);
        SEAM(P0 + 7);
        if (IN(P0 + 8)) {
            { pg8::Prob S; S.init(XB, Wxq, 2048, 2048, 2048, 64, 2, c.G, cid); pg8::EpiP<StBf16> E{{XQ, 512}, RS}; pg8::gemm_phase(c.lds, S, E); }
            { pg8::Prob S; S.init(MEMN, Wxkv, 2048, 2048, 2048, 4, 4, c.G, (cid + c.G - 128) % c.G); pg8::EpiP<StKv> E{{KV, XVT}, nullptr}; pg8::gemm_phase(c.lds, S, E); }
            if (cid >= 144 && c.G == 256) { const int ga = (cid - 144) * 8 + c.wave; constexpr int NG_ = 112 * 8;
                if constexpr (L == 0) { conv_w(c, args.in[13], 2048, NSA_IN, NSA_NP, Wmi, norm_pre + ((L + 1) * 3) * DM, false, ga, NG_); conv_w(c, args.in[17], 2048, 2048, 2048, Wmo, nullptr, false, ga, NG_);
                    conv_w(c, args.in[15], 4096, 256, 256, Wmx, nullptr, false, ga, NG_); conv_w(c, args.in[15] + (size_t)4096 * 256, 4096, 256, 256, Wmx + (size_t)256 * 4096, nullptr, false, ga, NG_); }
                else if constexpr (L == 1) { conv_w(c, args.in[18], 2048, 8192, 8192, Wmi, norm_pre + ((L + 1) * 3) * DM, false, ga, NG_); conv_w(c, args.in[23], 4096, 2048, 2048, Wmo, nullptr, false, ga, NG_); }
                else if constexpr (L == 2) { conv_w(c, args.in[24], 2048, 2048, 2048, Wmi, norm_pre + ((L + 1) * 3) * DM, false, ga, NG_); conv_w(c, args.in[27], 2048, 2048, 2048, Wmo, nullptr, false, ga, NG_);
#pragma unroll 1
                    for (int g = 0; g < 4; ++g) conv_w(c, args.in[25] + (size_t)g * 512 * 512, 512, 512, 512, Wmx + (size_t)g * 512 * 512, nullptr, false, ga, NG_); }
            }
        }
        SEAM(P0 + 8);
        if (IN(P0 + 9)) xa_attn_fa(c, XQ, KV, XVT, XO);
        SEAM(P0 + 9);
        if (IN(P0 + 10)) { pg8::Prob S; S.init(XO, Wxo, 512, 512, 512, 64, 8, c.G, cid); pg8::EpiP<StBf16> E{{MFb, 2048}, nullptr}; pg8::gemm_phase(c.lds, S, E); }
        SEAM(P0 + 10);
        if (IN(P0 + 11)) postnorm(c, MFb, XB, RS, norm_post + (L * 3 + 1) * DM, nullptr);
        SEAM(P0 + 11);
        if (IN(P0 + 12)) { pg8::ProbR S; S.init(XB, Wup, 2048, 2048, 2048, 64, 44, c.G, cid); EpiFfn E{ACT, (bf16*)(ws + WS_SXT), RS, args.in[32] + (size_t)L * 3 * FF2, args.in[33] + (size_t)L * FF2}; pg8::gemm_phase(c.lds, S, E); }
        SEAM(P0 + 12);
        if (IN(P0 + 13)) ffn_fixup(c, (const bf16*)(ws + WS_SXT), args.in[32] + (size_t)L * 3 * FF2, args.in[33] + (size_t)L * FF2, ACT);
        SEAM(P0 + 13);
        if (IN(P0 + 14)) { pg8::Prob S; S.init(ACT, Wdn, FFH, FFH, FFH, 64, 8, c.G, cid); pg8::EpiP<StBf16> E{{MFb, 2048}, nullptr}; pg8::gemm_phase(c.lds, S, E); }
        SEAM(P0 + 14);
        if (IN(P0 + 15)) postnorm(c, MFb, XB, RS, norm_post + (L * 3 + 2) * DM, (L == 3) ? X : nullptr);
    }
#undef IN
#undef SEAM

__global__ void __launch_bounds__(512, 2) mega_fwd(Args args) {
    extern __shared__ __attribute__((aligned(16))) unsigned char lds_raw[];
    Ctx c; c.lds = (LAS unsigned char*)lds_raw; c.tid = threadIdx.x; c.lane = c.tid & 63; c.wave = __builtin_amdgcn_readfirstlane(c.tid >> 6);
    c.G = gridDim.x; { const int bx = blockIdx.x; c.vcu = (c.G % 8 == 0) ? (bx % 8) * (c.G / 8) + bx / 8 : bx; }
    c.gw = c.vcu * 8 + c.wave; c.NGW = c.G * 8;
    volatile LAS unsigned* MISC = (volatile LAS unsigned*)(c.lds + MISC_OFF);
    if (c.tid < 64) MISC[c.tid] = 0u;
    __syncthreads();
    unsigned char* ws = args.ws;
    unsigned* ctl = (unsigned*)(ws + WS_CTL);
    XcdBarrier bar; bar.bar = ctl + CW_BAR; bar.x = 0; bar.st = nullptr;
#if !MK_MULTI
    bar = xcd_barrier_post(ctl + CW_BAR, MISC + 8);
#endif
    const int lo = args.ph_lo, hi = args.ph_hi;
    layer_body<0>(c, args, bar, lo, hi);
    layer_body<1>(c, args, bar, lo, hi);
    layer_body<2>(c, args, bar, lo, hi);
    layer_body<3>(c, args, bar, lo, hi);
}

extern "C" void kernel_launch(void* const* d_in, const int* in_sizes, int n_in, void* d_out, int out_size, void* d_ws, size_t ws_size, hipStream_t stream) {
    static int grid = 0;
    if (grid == 0) {
        if (n_in != 35 || out_size != MT * DM || ws_size < WS_END) { fprintf(stderr, "kernel_launch: unexpected shapes: n_in %d out %d ws %zu (need %zu)\n", n_in, out_size, ws_size, (size_t)WS_END); grid = -1; return; }
        int dev = 0, cus = 0, per_cu = 0;
        if (hipGetDevice(&dev) != hipSuccess || hipDeviceGetAttribute(&cus, hipDeviceAttributeMultiprocessorCount, dev) != hipSuccess) { grid = -1; return; }
        if (hipFuncSetAttribute((const void*)mega_fwd, hipFuncAttributeMaxDynamicSharedMemorySize, LDS_BYTES) != hipSuccess) { fprintf(stderr, "kernel_launch: hipFuncSetAttribute failed\n"); grid = -1; return; }
        if (hipOccupancyMaxActiveBlocksPerMultiprocessor(&per_cu, (const void*)mega_fwd, 512, LDS_BYTES) != hipSuccess || per_cu < 1) { fprintf(stderr, "kernel_launch: occupancy query says %d\n", per_cu); grid = -1; return; }
        (void)hipGetLastError();
        if (cus < 256) { fprintf(stderr, "kernel_launch: needs >= 256 CUs (got %d)\n", cus); grid = -1; return; }
        grid = 256;
    }
    if (grid < 0) return;
    (void)hipMemsetAsync((char*)d_ws + WS_CTL, 0, CTL_ZERO_BYTES, stream);
    Args a{};
    for (int i = 0; i < 35; ++i) a.in[i] = (const float*)d_in[i];
    a.out = (float*)d_out; a.ws = (unsigned char*)d_ws;
#if MK_MULTI
    for (int p = 0; p < N_PHASES; ++p) { a.ph_lo = p; a.ph_hi = p + 1; hipLaunchKernelGGL(mega_fwd, dim3(grid), dim3(512), LDS_BYTES, stream, a); }
#else
    a.ph_lo = 0; a.ph_hi = N_PHASES;
    hipLaunchKernelGGL(mega_fwd, dim3(grid), dim3(512), LDS_BYTES, stream, a);
#endif
}
```
